# Optimizing an MI355X kernel written in HIP

```python
import math
import jax, jax.numpy as jnp
from jax import lax
import numpy as np

D_MODEL = 1024
BATCH = 8
SEQ = 2048
DEPTH = 4
DEC_BATCH = 1
DEC_SEQ = 16384
PAST_LEN = 128

N_Q_HEADS = 8
N_KV_HEADS = 2
Q_PER_KV = N_Q_HEADS // N_KV_HEADS
HEAD_DIM = D_MODEL // N_Q_HEADS
DIFF_DIM = HEAD_DIM // 2
D_FF = 2816
BLOCK_Q = 128
WINDOW = 128
GRID_W = 64
N_BUCKETS = 32
MAX_DISTANCE = 128
ROPE_THETA = 10000.0
EPS = 1e-6
N_SUBLAYERS = 3
N_BRANCH = 3
N_BIAS_HEADS = 2 * N_Q_HEADS
Q_W = N_Q_HEADS * HEAD_DIM
KV_W = N_KV_HEADS * HEAD_DIM
BRANCH_IN = Q_W + 2 * KV_W
W_IN_COLS = N_BRANCH * BRANCH_IN + N_BRANCH * D_MODEL
NEG = -1e30

kernel_name = "hybrid_axial_window_diff_encoder"

F32 = jnp.float32


def rms_norm(x, g):
    x32 = x.astype(F32)
    y = x32 * lax.rsqrt(jnp.mean(x32 * x32, axis=-1, keepdims=True) + EPS)
    return (y * g.astype(F32)).astype(x.dtype)


def t5_bucket(rel):
    half = N_BUCKETS // 2
    max_exact = half // 2
    ret = jnp.where(rel > 0, half, 0)
    n = jnp.abs(rel)
    large = max_exact + (jnp.log(jnp.maximum(n, 1).astype(F32) / max_exact)
                         / math.log(MAX_DISTANCE / max_exact) * (half - max_exact)).astype(jnp.int32)
    large = jnp.minimum(large, half - 1)
    return ret + jnp.where(n < max_exact, n, large)


def axial_rope_tables(seq):
    rows = seq // GRID_W
    row = jnp.repeat(jnp.arange(rows), GRID_W).astype(F32)
    col = jnp.tile(jnp.arange(GRID_W), rows).astype(F32)
    nfreq = HEAD_DIM // 4
    inv = ROPE_THETA ** (-jnp.arange(nfreq, dtype=F32) / nfreq)
    ang_r = row[:, None] * inv
    ang_c = col[:, None] * inv
    ang = jnp.concatenate([ang_r, ang_r, ang_c, ang_c], axis=-1)
    return jnp.cos(ang), jnp.sin(ang)


def rotate_half(u):
    u1, u2 = jnp.split(u, 2, axis=-1)
    return jnp.concatenate([-u2, u1], axis=-1)


def apply_axial_rope(x, cos, sin):
    x32 = x.astype(F32)
    xr, xc = jnp.split(x32, 2, axis=-1)
    rot = jnp.concatenate([rotate_half(xr), rotate_half(xc)], axis=-1)
    return (x32 * cos[None, :, None, :] + rot * sin[None, :, None, :]).astype(x.dtype)


def to_blocks(q):
    b, s = q.shape[:2]
    return q.reshape(b, s // BLOCK_Q, BLOCK_Q, N_KV_HEADS, Q_PER_KV, -1).transpose(1, 0, 2, 3, 4, 5)


def from_blocks(o):
    nb, b = o.shape[:2]
    return o.transpose(1, 0, 2, 3, 4, 5).reshape(b, nb * BLOCK_Q, -1)


def axial_rope_attention(q, k, v, cos, sin):
    q = apply_axial_rope(q, cos, sin)
    k = apply_axial_rope(k, cos, sin)
    scale = HEAD_DIM ** -0.5

    def block(qb):
        sc = jnp.einsum('bqgrd,bkgd->bgrqk', qb, k).astype(F32) * scale
        p = jax.nn.softmax(sc, axis=-1).astype(v.dtype)
        return jnp.einsum('bgrqk,bkgd->bqgrd', p, v)

    return from_blocks(lax.map(block, to_blocks(q)))


def sink_window_attention(q, k, v, sink, bias_table):
    b, s = q.shape[:2]
    nb = s // BLOCK_Q
    pad = ((0, 0), (BLOCK_Q, BLOCK_Q), (0, 0), (0, 0))

    def band(t):
        tp = jnp.pad(t, pad).reshape(b, nb + 2, BLOCK_Q, N_KV_HEADS, HEAD_DIM)
        return jnp.concatenate([tp[:, :-2], tp[:, 1:-1], tp[:, 2:]], axis=2)

    kb, vb = band(k), band(v)
    qb = q.reshape(b, nb, BLOCK_Q, N_KV_HEADS, Q_PER_KV, HEAD_DIM)
    i = jnp.arange(BLOCK_Q)
    j = jnp.arange(3 * BLOCK_Q)
    rel = j[None, :] - BLOCK_Q - i[:, None]
    kpos = jnp.arange(nb)[:, None] * BLOCK_Q - BLOCK_Q + j[None, :]
    allowed = (jnp.abs(rel) <= WINDOW)[None] & ((kpos >= 0) & (kpos < s))[:, None, :]
    bias = bias_table[:, :N_Q_HEADS][t5_bucket(rel)]
    bias = bias.transpose(2, 0, 1).reshape(N_KV_HEADS, Q_PER_KV, BLOCK_Q, 3 * BLOCK_Q).astype(F32)
    scale = HEAD_DIM ** -0.5
    sc = jnp.einsum('bnqgrd,bnkgd->bngrqk', qb, kb).astype(F32) * scale + bias
    sc = jnp.where(allowed[None, :, None, None], sc, NEG)
    sink_col = jnp.broadcast_to(sink.astype(F32).reshape(N_KV_HEADS, Q_PER_KV, 1, 1), sc.shape[:-1] + (1,))
    p = jax.nn.softmax(jnp.concatenate([sc, sink_col], axis=-1), axis=-1)[..., :-1].astype(v.dtype)
    o = jnp.einsum('bngrqk,bnkgd->bnqgrd', p, vb)
    return o.reshape(b, s, -1)


def diff_attention(q, k, v, lam, lam_init, g_subln, bias_table):
    b, s = q.shape[:2]
    nb = s // BLOCK_Q
    q1, q2 = jnp.split(q, 2, axis=-1)
    k1, k2 = jnp.split(k, 2, axis=-1)
    scale = DIFF_DIM ** -0.5
    keypos = jnp.arange(s)
    table_c = bias_table[:, N_Q_HEADS:]

    def block(args):
        idx, q1b, q2b = args
        qpos = idx * BLOCK_Q + jnp.arange(BLOCK_Q)
        rel = keypos[None, :] - qpos[:, None]
        bias = table_c[t5_bucket(rel)]
        bias = bias.transpose(2, 0, 1).reshape(N_KV_HEADS, Q_PER_KV, BLOCK_Q, s).astype(F32)
        p1 = jax.nn.softmax(jnp.einsum('bqgrd,bkgd->bgrqk', q1b, k1).astype(F32) * scale + bias, axis=-1)
        p2 = jax.nn.softmax(jnp.einsum('bqgrd,bkgd->bgrqk', q2b, k2).astype(F32) * scale + bias, axis=-1)
        w = (p1 - lam * p2).astype(v.dtype)
        return jnp.einsum('bgrqk,bkgd->bqgrd', w, v)

    o = from_blocks(lax.map(block, (jnp.arange(nb), to_blocks(q1), to_blocks(q2))))
    o = rms_norm(o.reshape(b, s, N_Q_HEADS, HEAD_DIM), g_subln) * (1.0 - lam_init)
    return o.reshape(b, s, -1)


def swiglu(h, w_in_ff, w_out_ff):
    gate, up = jnp.split(h @ w_in_ff, 2, axis=-1)
    return (jax.nn.silu(gate) * up) @ w_out_ff


def trunk(x, c, p):
    b, s, _ = x.shape
    cos, sin = axial_rope_tables(s)
    split_idx = [int(v) for v in np.cumsum([Q_W, KV_W, KV_W] * N_BRANCH)]
    for l in range(DEPTH):
        mod = (jax.nn.silu(c) @ p['w_ada'][l] + p['b_ada'][l]).reshape(b, 3 * N_SUBLAYERS, 1, D_MODEL)

        def modulate(h, jj):
            return rms_norm(h, p['g_norm'][l, jj]) * (1.0 + mod[:, 3 * jj + 1]) + mod[:, 3 * jj]

        x = x + 0.5 * mod[:, 2] * swiglu(modulate(x, 0), p['w_ff_in'][l, 0], p['w_ff_out'][l, 0])

        n = modulate(x, 1)
        qa, ka, va, qb, kb, vb, qc, kc, vc, gates = jnp.split(n @ p['w_in'][l], split_idx, axis=-1)
        hq = (b, s, N_Q_HEADS, HEAD_DIM)
        hk = (b, s, N_KV_HEADS, HEAD_DIM)
        qa = rms_norm(qa.reshape(hq), p['g_qa'][l])
        ka = rms_norm(ka.reshape(hk), p['g_ka'][l])
        out_a = axial_rope_attention(qa, ka, va.reshape(hk), cos, sin)

        qb = rms_norm(qb.reshape(hq), p['g_qb'][l])
        kb = rms_norm(kb.reshape(hk), p['g_kb'][l])
        out_b = sink_window_attention(qb, kb, vb.reshape(hk), p['sink'][l], p['rel_bias'])

        qc = rms_norm(qc.reshape(b, s, N_Q_HEADS, 2, DIFF_DIM), p['g_qc'][l]).reshape(hq)
        kc = rms_norm(kc.reshape(b, s, N_KV_HEADS, 2, DIFF_DIM), p['g_kc'][l]).reshape(hk)
        lam_init = 0.8 - 0.6 * math.exp(-0.3 * l)
        lam = (jnp.exp(jnp.sum(p['lam_q1'][l].astype(F32) * p['lam_k1'][l].astype(F32)))
               - jnp.exp(jnp.sum(p['lam_q2'][l].astype(F32) * p['lam_k2'][l].astype(F32))) + lam_init)
        out_c = diff_attention(qc, kc, vc.reshape(hk), lam, lam_init, p['g_subln'][l], p['rel_bias'])

        g_a, g_b, g_c = jnp.split(jax.nn.sigmoid(gates), N_BRANCH, axis=-1)
        merged = g_a * out_a + g_b * out_b + g_c * out_c
        x = x + mod[:, 5] * (merged @ p['w_o'][l])

        x = x + 0.5 * mod[:, 8] * swiglu(modulate(x, 2), p['w_ff_in'][l, 1], p['w_ff_out'][l, 1])
    return x


def setup_inputs(seed: int = 0) -> dict:
    key = jax.random.key(seed)
    ks = jax.random.split(key, 24)

    def nrm(k, shape, scale):
        return jax.random.normal(k, shape, F32) * scale

    return {
        'x_prompt': nrm(ks[0], (BATCH, SEQ, D_MODEL), 1.0),
        'x_sample': nrm(ks[1], (DEC_BATCH, DEC_SEQ, D_MODEL), 1.0),
        'c_prompt': nrm(ks[2], (BATCH, D_MODEL), 1.0),
        'c_sample': nrm(ks[3], (DEC_BATCH, D_MODEL), 1.0),
        'w_ada': nrm(ks[4], (DEPTH, D_MODEL, 3 * N_SUBLAYERS * D_MODEL), 0.5 * D_MODEL ** -0.5),
        'b_ada': nrm(ks[5], (DEPTH, 3 * N_SUBLAYERS * D_MODEL), 0.02),
        'g_norm': 1.0 + nrm(ks[6], (DEPTH, N_SUBLAYERS, D_MODEL), 0.02),
        'w_ff_in': nrm(ks[7], (DEPTH, 2, D_MODEL, 2 * D_FF), D_MODEL ** -0.5),
        'w_ff_out': nrm(ks[8], (DEPTH, 2, D_FF, D_MODEL), D_FF ** -0.5),
        'w_in': nrm(ks[9], (DEPTH, D_MODEL, W_IN_COLS), D_MODEL ** -0.5),
        'w_o': nrm(ks[10], (DEPTH, D_MODEL, D_MODEL), D_MODEL ** -0.5),
        'g_qa': 1.0 + nrm(ks[11], (DEPTH, HEAD_DIM), 0.02),
        'g_ka': 1.0 + nrm(ks[12], (DEPTH, HEAD_DIM), 0.02),
        'g_qb': 1.0 + nrm(ks[13], (DEPTH, HEAD_DIM), 0.02),
        'g_kb': 1.0 + nrm(ks[14], (DEPTH, HEAD_DIM), 0.02),
        'g_qc': 1.0 + nrm(ks[15], (DEPTH, DIFF_DIM), 0.02),
        'g_kc': 1.0 + nrm(ks[16], (DEPTH, DIFF_DIM), 0.02),
        'sink': nrm(ks[17], (DEPTH, N_Q_HEADS), 0.5),
        'lam_q1': nrm(ks[18], (DEPTH, DIFF_DIM), 0.1),
        'lam_k1': nrm(ks[19], (DEPTH, DIFF_DIM), 0.1),
        'lam_q2': nrm(ks[20], (DEPTH, DIFF_DIM), 0.1),
        'lam_k2': nrm(ks[21], (DEPTH, DIFF_DIM), 0.1),
        'g_subln': 1.0 + nrm(ks[22], (DEPTH, HEAD_DIM), 0.02),
        'rel_bias': nrm(ks[23], (N_BUCKETS, N_BIAS_HEADS), 0.5),
    }


def reference(x_prompt, x_sample, c_prompt, c_sample, w_ada, b_ada, g_norm, w_ff_in, w_ff_out,
              w_in, w_o, g_qa, g_ka, g_qb, g_kb, g_qc, g_kc, sink, lam_q1, lam_k1, lam_q2, lam_k2,
              g_subln, rel_bias):
    params = dict(w_ada=w_ada, b_ada=b_ada, g_norm=g_norm, w_ff_in=w_ff_in, w_ff_out=w_ff_out,
                  w_in=w_in, w_o=w_o, g_qa=g_qa, g_ka=g_ka, g_qb=g_qb, g_kb=g_kb, g_qc=g_qc,
                  g_kc=g_kc, sink=sink, lam_q1=lam_q1, lam_k1=lam_k1, lam_q2=lam_q2, lam_k2=lam_k2,
                  g_subln=g_subln, rel_bias=rel_bias)
    y_prompt = trunk(x_prompt, c_prompt, params)
    y_sample = trunk(x_sample, c_sample, params)
    return (y_prompt, y_sample)
```

```cpp
#include <hip/hip_runtime.h>
#include <hip/hip_bf16.h>
#include <hip/hip_cooperative_groups.h>
#include <cstdio>
#include <cstdint>
#define N_LAUNCH_MODE 1
namespace cg = cooperative_groups;

typedef unsigned short bf16_t;
typedef short bf16x8 __attribute__((ext_vector_type(8)));
typedef short s16x4 __attribute__((ext_vector_type(4)));
typedef float f32x4 __attribute__((ext_vector_type(4)));
typedef float f32x16 __attribute__((ext_vector_type(16)));
typedef unsigned u32x4 __attribute__((ext_vector_type(4)));
typedef unsigned u32x2 __attribute__((ext_vector_type(2)));
#define LAS __attribute__((address_space(3)))

constexpr int T_TOK = 32768, DM = 1024, DFF = 2816, NFF2 = 5632, WINC = 7680, QKVW = 4608, GW = 3072;
constexpr float EPS = 1e-6f, LOG2E = 1.4426950408889634f, NEGBIG = -1e30f;
constexpr size_t WB_FFIN0 = 0, WB_FFIN1 = 11534336, WB_FFOUT0 = 23068672, WB_FFOUT1 = 28835840, WB_WIN = 34603008, WB_WO = 50331648;
constexpr size_t WS_MOD = 52428800, WS_ROPE = 53755904, WS_LUT = 53821440, WS_LAM = 53854208, WS_XN = 53854464;
constexpr size_t WS_QKV = WS_XN + 67108864, WS_GATES = WS_QKV + 301989888, WS_PARK = WS_GATES + 201326592, WS_END = WS_PARK + 67108864;
constexpr int LDS_BYTES = 131072;

struct Params { const float* in[24]; float* out; unsigned char* ws; };

typedef __bf16 bf16v2 __attribute__((ext_vector_type(2)));
typedef float f32x2 __attribute__((ext_vector_type(2)));
__device__ __forceinline__ unsigned cvtpk(float lo, float hi) { f32x2 v = {lo, hi}; bf16v2 b = __builtin_convertvector(v, bf16v2); return __builtin_bit_cast(unsigned, b); }
__device__ __forceinline__ float bf_lo(unsigned u) { return __uint_as_float(u << 16); }
__device__ __forceinline__ float bf_hi(unsigned u) { return __uint_as_float(u & 0xffff0000u); }
__device__ __forceinline__ float bf2f(bf16_t v) { return __uint_as_float(((unsigned)v) << 16); }

namespace pg8 {
constexpr int BM = 256, BK = 64, HALF = 128, HTB = HALF * BK * 2, STAGE_BYTES = 8 * HTB, NXCD = 8, WGM = 8;
__device__ __forceinline__ int lds_byte(int r, int c) { const int st = (r >> 4) * 2 + (c >> 5), rr = r & 15, cc = c & 31, ob = rr * 64 + cc * 2; return st * 1024 + (ob ^ (((ob >> 9) & 1) << 5)); }
__device__ __forceinline__ void stage_rc(int b, int& R, int& C) { const int st = b / 1024, sb = b % 1024, swz = sb ^ (((sb >> 9) & 1) << 5); R = (st >> 1) * 16 + swz / 64; C = (st & 1) * 32 + (swz % 64) / 2; }
__device__ __forceinline__ int perm32(int rho) { const int n = rho >> 4, i = rho & 15; return 8 * (i >> 2) + 4 * n + (i & 3); }
struct Unit { int pm, pn; };
struct Gemm { const bf16_t* A; const bf16_t* Bt; int M, N, K; };
struct StaticOrder {
    int nM, nN, nwg, G, c;
    __device__ void init(int M, int N, int G_, int c_) { nM = M / BM; nN = N / BM; nwg = nM * nN; G = G_; c = c_; }
    __device__ bool next(int i, Unit& u) const {
        const long L = (long)i * G + c; if (L >= nwg) return false;
        int wgid = (int)L; { const int q = nwg / NXCD, r = nwg % NXCD, xcd = wgid % NXCD, off = wgid / NXCD; wgid = (xcd < r ? xcd * (q + 1) : r * (q + 1) + (xcd - r) * q) + off; }
        const int nig = WGM * nN, gid = wgid / nig, fm = gid * WGM, gsz = (nM - fm) < WGM ? (nM - fm) : WGM;
        u.pm = fm + ((wgid % nig) % gsz); u.pn = (wgid % nig) / gsz; return true;
    }
};

template <class Epi>
__device__ __forceinline__ void gemm_phase(LAS unsigned char* lds, const Gemm g, const StaticOrder& S, const Epi& E) {
    int tid_ = threadIdx.x; asm volatile("" : "+v"(tid_));
    const int tid = tid_, wid = __builtin_amdgcn_readfirstlane(tid >> 6), lane = tid & 63, wr = wid >> 2, wc = wid & 3, fr = lane & 15, fq = lane >> 4;
    const int K = g.K, nt = K / BK;
    unsigned voffA[2], voffB[2];
#pragma unroll
    for (int i = 0; i < 2; ++i) { int R, C; stage_rc(tid * 16 + i * 8192, R, C); const int Rb = Epi::PERM ? ((R & ~31) + perm32(R & 31)) : R;
        voffA[i] = (unsigned)(R * K + C) * 2u; voffB[i] = (unsigned)(Rb * K + C) * 2u; }
    const size_t kstep = (size_t)(BK * 2);
    const size_t hstep = (size_t)HALF * K * 2;
    const size_t tstep = 2 * hstep;
    const unsigned ldsw = (unsigned)wid * 1024u;
    const int aoff = lds_byte(wr * 64 + fr, fq * 8), boff = lds_byte(wc * 32 + fr, fq * 8);
#define PG8_SA(b, h) (((b) * 2 + (h)) * HTB)
#define PG8_SB(b, h) ((4 + (b) * 2 + (h)) * HTB)
#define PG8_STAGE(bufoff, gbase, voff) do { _Pragma("unroll") for (int _i = 0; _i < 2; ++_i) \
        __builtin_amdgcn_global_load_lds((const unsigned*)((const char*)(gbase) + (voff)[_i]), (LAS unsigned*)(lds + (bufoff) + ldsw + _i * 8192), 16, 0, 0); } while (0)
#define PG8_LDA(dst, b, h) do { _Pragma("unroll") for (int m = 0; m < 4; ++m) _Pragma("unroll") for (int k = 0; k < 2; ++k) dst[m][k] = *(const LAS bf16x8*)(lds + PG8_SA(b, h) + aoff + m * 2048 + k * 1024); } while (0)
#define PG8_LDB(dst, b, h) do { _Pragma("unroll") for (int n = 0; n < 2; ++n) _Pragma("unroll") for (int k = 0; k < 2; ++k) dst[n][k] = *(const LAS bf16x8*)(lds + PG8_SB(b, h) + boff + n * 2048 + k * 1024); } while (0)
#define PG8_MMA(ai, bj, At, Bt) do { __builtin_amdgcn_s_setprio(1); _Pragma("unroll") for (int m = 0; m < 4; ++m) _Pragma("unroll") for (int n = 0; n < 2; ++n) _Pragma("unroll") for (int k = 0; k < 2; ++k) \
        acc[ai][bj][m][n] = __builtin_amdgcn_mfma_f32_16x16x32_bf16(Bt[n][k], At[m][k], acc[ai][bj][m][n], 0, 0, 0); __builtin_amdgcn_s_setprio(0); } while (0)
#define PG8_WAIT_V(n) asm volatile("s_waitcnt vmcnt(" #n ")" ::: "memory")
#define PG8_WAIT_L(n) asm volatile("s_waitcnt lgkmcnt(" #n ")" ::: "memory")
#define PG8_BAR __builtin_amdgcn_s_barrier()
#define PG8_SCHED __builtin_amdgcn_sched_barrier(0)
    Unit cur, nxt; int ui = 0;
    if (!S.next(0, cur)) return;
    f32x4 acc[2][2][4][2];
#pragma unroll
    for (int a = 0; a < 2; ++a)
#pragma unroll
        for (int b = 0; b < 2; ++b)
#pragma unroll
            for (int m = 0; m < 4; ++m)
#pragma unroll
                for (int n = 0; n < 2; ++n) acc[a][b][m][n] = (f32x4){0.f, 0.f, 0.f, 0.f};
    bf16x8 At[4][2], B0[2][2], B1[2][2];
    const char* cA = (const char*)g.A + (size_t)cur.pm * tstep; const char* cB = (const char*)g.Bt + (size_t)cur.pn * tstep;
    PG8_STAGE(PG8_SB(0, 0), cB, voffB); PG8_STAGE(PG8_SA(0, 0), cA, voffA); PG8_STAGE(PG8_SB(0, 1), cB + hstep, voffB); PG8_STAGE(PG8_SA(0, 1), cA + hstep, voffA);
    if (wr == 1) PG8_BAR;
    PG8_WAIT_V(4); PG8_BAR;
    PG8_STAGE(PG8_SB(1, 0), cB + kstep, voffB); PG8_STAGE(PG8_SA(1, 0), cA + kstep, voffA); PG8_STAGE(PG8_SB(1, 1), cB + hstep + kstep, voffB);
    PG8_WAIT_V(6); PG8_BAR;
    for (;;) {
        const bool has_next = S.next(ui + 1, nxt);
        const char* nA = has_next ? (const char*)g.A + (size_t)nxt.pm * tstep : cA; const char* nB = has_next ? (const char*)g.Bt + (size_t)nxt.pn * tstep : cB;
        for (int t = 0; t < nt; t += 2) {
            const bool last = (t == nt - 2);
            const char* a1 = cA + (size_t)(t + 1) * kstep;
            const char* a2 = last ? nA : cA + (size_t)(t + 2) * kstep; const char* b2 = last ? nB : cB + (size_t)(t + 2) * kstep;
            const char* a3 = a2 + kstep; const char* b3 = b2 + kstep;
            PG8_LDB(B0, 0, 0); PG8_SCHED; PG8_LDA(At, 0, 0); PG8_STAGE(PG8_SA(1, 1), a1 + hstep, voffA);
            PG8_WAIT_L(8); PG8_BAR; PG8_WAIT_L(0); PG8_MMA(0, 0, At, B0); PG8_BAR; PG8_SCHED;
            PG8_LDB(B1, 0, 1); PG8_STAGE(PG8_SB(0, 0), b2, voffB);
            PG8_BAR; PG8_WAIT_L(0); PG8_MMA(0, 1, At, B1); PG8_BAR;
            PG8_LDA(At, 0, 1); PG8_STAGE(PG8_SA(0, 0), a2, voffA);
            PG8_BAR; PG8_WAIT_L(0); PG8_MMA(1, 0, At, B0); PG8_BAR; PG8_SCHED;
            PG8_STAGE(PG8_SB(0, 1), b2 + hstep, voffB);
            PG8_WAIT_V(6); PG8_BAR; PG8_MMA(1, 1, At, B1); PG8_BAR;
            PG8_LDB(B0, 1, 0); PG8_SCHED; PG8_LDA(At, 1, 0); PG8_STAGE(PG8_SA(0, 1), a2 + hstep, voffA);
            PG8_WAIT_L(8); PG8_BAR; PG8_WAIT_L(0); PG8_MMA(0, 0, At, B0); PG8_BAR; PG8_SCHED;
            PG8_LDB(B1, 1, 1); PG8_STAGE(PG8_SB(1, 0), b3, voffB);
            PG8_BAR; PG8_WAIT_L(0); PG8_MMA(0, 1, At, B1); PG8_BAR;
            PG8_LDA(At, 1, 1); PG8_STAGE(PG8_SA(1, 0), a3, voffA);
            PG8_BAR; PG8_WAIT_L(0); PG8_MMA(1, 0, At, B0); PG8_BAR; PG8_SCHED;
            PG8_STAGE(PG8_SB(1, 1), b3 + hstep, voffB);
            PG8_WAIT_V(6); PG8_BAR; PG8_MMA(1, 1, At, B1); PG8_BAR;
        }
        E(acc, cur, wr, wc, fr, fq);
        if (!has_next) break;
#pragma unroll
        for (int a = 0; a < 2; ++a)
#pragma unroll
            for (int b = 0; b < 2; ++b)
#pragma unroll
                for (int m = 0; m < 4; ++m)
#pragma unroll
                    for (int n = 0; n < 2; ++n) acc[a][b][m][n] = (f32x4){0.f, 0.f, 0.f, 0.f};
        cur = nxt; cA = nA; cB = nB; ++ui;
    }
    PG8_WAIT_V(0);
    if (wr == 0) PG8_BAR;
    PG8_BAR;
#undef PG8_SA
#undef PG8_SB
#undef PG8_STAGE
#undef PG8_LDA
#undef PG8_LDB
#undef PG8_MMA
#undef PG8_WAIT_V
#undef PG8_WAIT_L
#undef PG8_BAR
#undef PG8_SCHED
}

__device__ __forceinline__ float silu_f(float g) { return g * __builtin_amdgcn_rcpf(1.f + __expf(-g)); }
__device__ __forceinline__ float sigm_f(float g) { return __builtin_amdgcn_rcpf(1.f + __expf(-g)); }
struct EpiSwiGLU {
    static constexpr bool PERM = true;
    bf16_t* H;
    __device__ __forceinline__ void operator()(const f32x4 (&acc)[2][2][4][2], const Unit& u, int wr, int wc, int fr, int fq) const {
        const int row0 = u.pm * BM + wr * 64 + fr, col0 = u.pn * 128 + wc * 32 + 8 * fq;
#pragma unroll
        for (int ai = 0; ai < 2; ++ai)
#pragma unroll
            for (int m = 0; m < 4; ++m) { bf16_t* rowp = H + (size_t)(row0 + ai * HALF + m * 16) * DFF + col0;
                const f32x4 g0 = acc[ai][0][m][0], g1 = acc[ai][0][m][1], u0 = acc[ai][1][m][0], u1 = acc[ai][1][m][1];
                u32x4 w; w.x = cvtpk(silu_f(g0[0]) * u0[0], silu_f(g0[1]) * u0[1]); w.y = cvtpk(silu_f(g0[2]) * u0[2], silu_f(g0[3]) * u0[3]);
                w.z = cvtpk(silu_f(g1[0]) * u1[0], silu_f(g1[1]) * u1[1]); w.w = cvtpk(silu_f(g1[2]) * u1[2], silu_f(g1[3]) * u1[3]);
                *(u32x4*)rowp = w; }
    }
};
struct EpiResid {
    static constexpr bool PERM = false;
    float* X; const float* modg; float gs;
    __device__ __forceinline__ void operator()(const f32x4 (&acc)[2][2][4][2], const Unit& u, int wr, int wc, int fr, int fq) const {
        const int row0 = u.pm * BM + wr * 64 + fr, col0 = u.pn * BM + wc * 32 + 4 * fq;
        const int bi = u.pm < 64 ? (u.pm >> 3) : 8;
        const float* mg = modg + (size_t)bi * 9216 + col0;
        f32x4 gv[2][2];
#pragma unroll
        for (int bj = 0; bj < 2; ++bj)
#pragma unroll
            for (int n = 0; n < 2; ++n) gv[bj][n] = *(const f32x4*)(mg + bj * HALF + n * 16) * gs;
#pragma unroll
        for (int ai = 0; ai < 2; ++ai)
#pragma unroll
            for (int m = 0; m < 4; ++m) { float* rowp = X + (size_t)(row0 + ai * HALF + m * 16) * DM + col0;
#pragma unroll
                for (int bj = 0; bj < 2; ++bj)
#pragma unroll
                    for (int n = 0; n < 2; ++n) { f32x4* q = (f32x4*)(rowp + bj * HALF + n * 16); *q = *q + gv[bj][n] * acc[ai][bj][m][n]; } }
    }
};
struct EpiQKV {
    static constexpr bool PERM = true;
    bf16_t* QKV; bf16_t* GATES;
    __device__ __forceinline__ void operator()(const f32x4 (&acc)[2][2][4][2], const Unit& u, int wr, int wc, int fr, int fq) const {
        const int row0 = u.pm * BM + wr * 64 + fr;
        if (u.pn < 18) {
            const int col0 = u.pn * BM + wc * 32 + 8 * fq;
#pragma unroll
            for (int ai = 0; ai < 2; ++ai)
#pragma unroll
                for (int m = 0; m < 4; ++m) { bf16_t* rowp = QKV + (size_t)(row0 + ai * HALF + m * 16) * QKVW + col0;
#pragma unroll
                    for (int bj = 0; bj < 2; ++bj) { const f32x4 v0 = acc[ai][bj][m][0], v1 = acc[ai][bj][m][1];
                        u32x4 w; w.x = cvtpk(v0[0], v0[1]); w.y = cvtpk(v0[2], v0[3]); w.z = cvtpk(v1[0], v1[1]); w.w = cvtpk(v1[2], v1[3]);
                        *(u32x4*)(rowp + bj * HALF) = w; } }
        } else {
            const int col0 = (u.pn - 18) * BM + wc * 32 + 8 * fq;
#pragma unroll
            for (int ai = 0; ai < 2; ++ai)
#pragma unroll
                for (int m = 0; m < 4; ++m) { bf16_t* rowp = GATES + (size_t)(row0 + ai * HALF + m * 16) * GW + col0;
#pragma unroll
                    for (int bj = 0; bj < 2; ++bj) { const f32x4 v0 = acc[ai][bj][m][0], v1 = acc[ai][bj][m][1];
                        u32x4 w; w.x = cvtpk(sigm_f(v0[0]), sigm_f(v0[1])); w.y = cvtpk(sigm_f(v0[2]), sigm_f(v0[3])); w.z = cvtpk(sigm_f(v1[0]), sigm_f(v1[1])); w.w = cvtpk(sigm_f(v1[2]), sigm_f(v1[3]));
                        *(u32x4*)(rowp + bj * HALF) = w; } }
        }
    }
};
}

constexpr int LDQK = QKVW;
constexpr int SHM_V = 64 * 128 * 2, SHM_K = 64 * 128 * 2;
constexpr int ATT_WS_OFF = 2 * SHM_V + 2 * SHM_K, ATT_LUT_OFF = ATT_WS_OFF + 8 * 64 * 4;
#define KSWZ(row, colB) ((row) * 256 + ((colB) ^ (((row) & 7) << 4)))
#define SBAR() __builtin_amdgcn_sched_barrier(0)
__device__ __forceinline__ int crow(int r, int hi) { return (r & 3) + 8 * (r >> 2) + 4 * hi; }

template <int MODE>
__device__ __forceinline__ void partialSM(f32x16& p0, f32x16& p1, float& m_reg, float& mn, float& alpha, int relh, int relw_min, int relw_max, const float* lut) {
  if constexpr (MODE == 0) {
    constexpr float SCALE = 0.088388347648318440f, C = SCALE * LOG2E, THR = 8.f;
    float pmax = p0[0];
#pragma unroll
    for (int r = 1; r < 16; ++r) pmax = fmaxf(pmax, p0[r]);
#pragma unroll
    for (int r = 0; r < 16; ++r) pmax = fmaxf(pmax, p1[r]);
    { auto rr = __builtin_amdgcn_permlane32_swap(__float_as_uint(pmax), __float_as_uint(pmax), false, false);
      pmax = fmaxf(__uint_as_float(rr[0]), __uint_as_float(rr[1])); }
    if (__builtin_expect(__all(pmax - m_reg <= THR / SCALE), 1)) { mn = m_reg; alpha = 1.f; }
    else { mn = fmaxf(m_reg, pmax); alpha = __builtin_amdgcn_exp2f((m_reg - mn) * C); m_reg = mn; }
    const float mnC = -mn * C;
#pragma unroll
    for (int r = 0; r < 16; ++r) p0[r] = fmaf(p0[r], C, mnC);
#pragma unroll
    for (int r = 0; r < 16; ++r) p1[r] = fmaf(p1[r], C, mnC);
#pragma unroll
    for (int r = 0; r < 16; ++r) p0[r] = __builtin_amdgcn_exp2f(p0[r]);
  } else {
    constexpr float C = (MODE == 1 ? 0.088388347648318440f : 0.125f) * LOG2E, THR2 = 8.f * LOG2E;
    bool nearT = true; float cfar = 0.f;
    if constexpr (MODE >= 2) {
      if (relw_max <= -128) { nearT = false; cfar = lut[0]; }
      else if (relw_min >= 128) { nearT = false; cfar = lut[258]; }
    }
    if (nearT) {
#pragma unroll
      for (int r = 0; r < 16; ++r) { const int i0 = relh + (r & 3) + 8 * (r >> 2);
        const int a0 = min(max(i0, -129), 129) + 129, a1 = min(max(i0 + 32, -129), 129) + 129;
        p0[r] = fmaf(p0[r], C, lut[a0]); p1[r] = fmaf(p1[r], C, lut[a1]); }
    } else {
#pragma unroll
      for (int r = 0; r < 16; ++r) { p0[r] = fmaf(p0[r], C, cfar); p1[r] = fmaf(p1[r], C, cfar); }
    }
    float pmax = p0[0];
#pragma unroll
    for (int r = 1; r < 16; ++r) pmax = fmaxf(pmax, p0[r]);
#pragma unroll
    for (int r = 0; r < 16; ++r) pmax = fmaxf(pmax, p1[r]);
    { auto rr = __builtin_amdgcn_permlane32_swap(__float_as_uint(pmax), __float_as_uint(pmax), false, false);
      pmax = fmaxf(__uint_as_float(rr[0]), __uint_as_float(rr[1])); }
    if (__builtin_expect(__all(pmax - m_reg <= THR2), 1)) { mn = m_reg; alpha = 1.f; }
    else { mn = fmaxf(m_reg, pmax); alpha = __builtin_amdgcn_exp2f(m_reg - mn); m_reg = mn; }
#pragma unroll
    for (int r = 0; r < 16; ++r) p0[r] = __builtin_amdgcn_exp2f(p0[r] - mn);
#pragma unroll
    for (int r = 0; r < 16; ++r) p1[r] = p1[r] - mn;
  }
}
__device__ __forceinline__ void finishSM(f32x16& p0, f32x16& p1, float alpha, float& l_reg, bf16x8& pa0, bf16x8& pa1, bf16x8& pa2, bf16x8& pa3) {
#pragma unroll
  for (int r = 0; r < 16; ++r) p1[r] = __builtin_amdgcn_exp2f(p1[r]);
  float ps = 0;
#pragma unroll
  for (int r = 0; r < 16; ++r) ps += p0[r];
#pragma unroll
  for (int r = 0; r < 16; ++r) ps += p1[r];
  { auto rr = __builtin_amdgcn_permlane32_swap(__float_as_uint(ps), __float_as_uint(ps), false, false);
    ps = __uint_as_float(rr[0]) + __uint_as_float(rr[1]); }
  l_reg = l_reg * alpha + ps;
#define PK4(P, BASE, OUT) do { unsigned a0 = cvtpk(P[BASE + 0], P[BASE + 1]), a1 = cvtpk(P[BASE + 2], P[BASE + 3]);   \
    unsigned b0 = cvtpk(P[BASE + 4], P[BASE + 5]), b1 = cvtpk(P[BASE + 6], P[BASE + 7]);                              \
    auto r0 = __builtin_amdgcn_permlane32_swap(a0, b0, false, false); auto r1 = __builtin_amdgcn_permlane32_swap(a1, b1, false, false); \
    u32x4 w = {r0[0], r1[0], r0[1], r1[1]}; OUT = *reinterpret_cast<bf16x8*>(&w); } while (0)
  PK4(p0, 0, pa0); PK4(p0, 8, pa1); PK4(p1, 0, pa2); PK4(p1, 8, pa3);
#undef PK4
}
template <int ND0, int DOFF>
__device__ __forceinline__ void qkt(f32x16& p0, f32x16& p1, const char* Ks, const bf16x8* qr, int r32, int hi) {
  p0 = f32x16{}; p1 = f32x16{};
#pragma unroll
  for (int d0 = 0; d0 < ND0; ++d0) { const int cb = ((d0 + DOFF) * 16 + hi * 8) * 2;
    bf16x8 b0 = *reinterpret_cast<const bf16x8*>(Ks + KSWZ(r32, cb));
    bf16x8 b1 = *reinterpret_cast<const bf16x8*>(Ks + KSWZ(32 + r32, cb));
    p0 = __builtin_amdgcn_mfma_f32_32x32x16_bf16(b0, qr[d0], p0, 0, 0, 0);
    p1 = __builtin_amdgcn_mfma_f32_32x32x16_bf16(b1, qr[d0], p1, 0, 0, 0); }
}
__device__ __forceinline__ int v_st(int k, int c) { const int kk = (k & ~0xC) | ((k & 4) << 1) | ((k & 8) >> 1); return ((kk >> 3) * 4 + (c >> 5)) * 512 + ((kk & 7) * 32 + (c & 31)) * 2; }
__device__ __forceinline__ int v_rd_base(int lane) { return ((lane & 3) << 3) | (((lane >> 2) & 3) << 6) | (((lane >> 4) & 1) << 5) | (((lane >> 5) & 1) << 8); }
constexpr int v_rd_off(int d0, int ks, int half) { return d0 * 512 + ks * 4096 + half * 2048; }
template <int OFF> __device__ __forceinline__ s16x4 tr_read(int vb) {
  s16x4 r; asm volatile("ds_read_b64_tr_b16 %0, %1 offset:%2" : "=&v"(r) : "v"(vb), "i"(OFF) : "memory"); return r;
}
template <int D0> __device__ __forceinline__ void pv_one(f32x16& od, int vb, bf16x8 pa0, bf16x8 pa1, bf16x8 pa2, bf16x8 pa3) {
  const s16x4 l0 = tr_read<v_rd_off(D0, 0, 0)>(vb), h0 = tr_read<v_rd_off(D0, 0, 1)>(vb), l1 = tr_read<v_rd_off(D0, 1, 0)>(vb), h1 = tr_read<v_rd_off(D0, 1, 1)>(vb);
  const s16x4 l2 = tr_read<v_rd_off(D0, 2, 0)>(vb), h2 = tr_read<v_rd_off(D0, 2, 1)>(vb), l3 = tr_read<v_rd_off(D0, 3, 0)>(vb), h3 = tr_read<v_rd_off(D0, 3, 1)>(vb);
  asm volatile("s_waitcnt lgkmcnt(0)" ::: "memory"); SBAR();
#define PK(L, H) (bf16x8){L[0], L[1], L[2], L[3], H[0], H[1], H[2], H[3]}
  od = __builtin_amdgcn_mfma_f32_32x32x16_bf16(pa0, PK(l0, h0), od, 0, 0, 0);
  od = __builtin_amdgcn_mfma_f32_32x32x16_bf16(pa1, PK(l1, h1), od, 0, 0, 0);
  od = __builtin_amdgcn_mfma_f32_32x32x16_bf16(pa2, PK(l2, h2), od, 0, 0, 0);
  od = __builtin_amdgcn_mfma_f32_32x32x16_bf16(pa3, PK(l3, h3), od, 0, 0, 0);
#undef PK
}
__device__ __forceinline__ void pv_d0(f32x16* o, int vb, bf16x8 pa0, bf16x8 pa1, bf16x8 pa2, bf16x8 pa3) {
  pv_one<0>(o[0], vb, pa0, pa1, pa2, pa3); pv_one<1>(o[1], vb, pa0, pa1, pa2, pa3); pv_one<2>(o[2], vb, pa0, pa1, pa2, pa3); pv_one<3>(o[3], vb, pa0, pa1, pa2, pa3);
}

struct AttnEpi {
  const bf16_t* gate;
  float* park;
  bf16_t* merged;
  const float* gsub;
  float lam, oml;
  float sinkl2;
};

template <int MODE>
__device__ __forceinline__ void attn_body(const bf16_t* __restrict__ Qb, const bf16_t* __restrict__ Kh, const bf16_t* __restrict__ Vh, int NT, int krel0,
                                          char* lds, const float* __restrict__ lutg, const AttnEpi& E) {
  constexpr int ND0 = (MODE < 2) ? 8 : 4, DOFF = (MODE == 3) ? 4 : 0;
  int tid_ = threadIdx.x; asm volatile("" : "+v"(tid_));
  const int tid = tid_, wid = tid >> 6, lane = tid & 63, r32 = lane & 31, hi = lane >> 5;
  char* V_lds = lds; char* K_lds = lds + 2 * SHM_V;
  float* wsm = (float*)(lds + ATT_WS_OFF) + wid * 64; float* li_l = wsm; float* al_l = wsm + 32;
  float* lut = (float*)(lds + ATT_LUT_OFF);
  __syncthreads();
  if constexpr (MODE != 0) { if (tid < 259) lut[tid] = lutg[tid]; }
  float m_reg = -1e30f, l_reg = 0; f32x16 o[4] = {}; bf16x8 qr[ND0];
  const bf16_t* Qw = Qb + (size_t)(wid * 32 + r32) * LDQK + hi * 8;
#pragma unroll
  for (int d0 = 0; d0 < ND0; ++d0) qr[d0] = *reinterpret_cast<const bf16x8*>(Qw + d0 * 16);
  const int sr = tid >> 4, sc = (tid & 15) * 8, vst0 = v_st(sr, sc), vst1 = v_st(32 + sr, sc);
  const int vb0 = (int)(uintptr_t)V_lds + v_rd_base(lane);
  struct { bf16x8 vs0, vs1, ks0, ks1; } sr_[2];
#define SLOAD(i, k0) do { sr_[i].vs0 = *reinterpret_cast<const bf16x8*>(&Vh[(size_t)((k0) + sr) * LDQK + sc]); sr_[i].vs1 = *reinterpret_cast<const bf16x8*>(&Vh[(size_t)((k0) + 32 + sr) * LDQK + sc]); \
    sr_[i].ks0 = *reinterpret_cast<const bf16x8*>(&Kh[(size_t)((k0) + sr) * LDQK + sc]); sr_[i].ks1 = *reinterpret_cast<const bf16x8*>(&Kh[(size_t)((k0) + 32 + sr) * LDQK + sc]); } while (0)
#define SWRITE(b, i) do { *(bf16x8*)(V_lds + (b) * SHM_V + vst0) = sr_[i].vs0;          \
    *(bf16x8*)(V_lds + (b) * SHM_V + vst1) = sr_[i].vs1; int kc = sc * 2;               \
    *(bf16x8*)(K_lds + (b) * SHM_K + KSWZ(sr, kc)) = sr_[i].ks0;                       \
    *(bf16x8*)(K_lds + (b) * SHM_K + KSWZ(32 + sr, kc)) = sr_[i].ks1; } while (0)
#define SWAIT() asm volatile("s_waitcnt vmcnt(4)" ::: "memory")
#define RESC(a) do { if (__any((a) < 1.f)) { if (hi == 0) al_l[r32] = (a); asm volatile("s_waitcnt lgkmcnt(0)" ::: "memory"); \
    _Pragma("unroll") for (int d = 0; d < 4; ++d) _Pragma("unroll") for (int r = 0; r < 16; ++r) o[d][r] *= al_l[crow(r, hi)]; } } while (0)
  const int relq = krel0 - (wid * 32 + r32) + 4 * hi, relwmin = krel0 - (wid * 32 + 31), relwmax = krel0 + 63 - wid * 32;
#define PSM(P0, P1, MN, AL, J) partialSM<MODE>(P0, P1, m_reg, MN, AL, relq + 64 * (J), relwmin + 64 * (J), relwmax + 64 * (J), lut)
  f32x16 pA0, pA1, pB0, pB1; float mnA, mnB, alA, alB; bf16x8 pa0, pa1, pa2, pa3;
  constexpr int SE = 0, SO = 1;
  SLOAD(SE, 0); asm volatile("s_waitcnt vmcnt(0)" ::: "memory"); SWRITE(0, SE); __syncthreads();
  qkt<ND0, DOFF>(pA0, pA1, K_lds, qr, r32, hi); PSM(pA0, pA1, mnA, alA, 0);
  SLOAD(SO, 64); if (2 < NT) SLOAD(SE, 2 * 64);
  SWAIT(); SWRITE(1, SO); __syncthreads();
  for (int j = 1; j + 1 < NT; j += 2) {
    SBAR(); qkt<ND0, DOFF>(pB0, pB1, K_lds + SHM_K, qr, r32, hi);
    finishSM(pA0, pA1, alA, l_reg, pa0, pa1, pa2, pa3); SBAR();
    SLOAD(SO, (j + 2) * 64); SBAR();
    pv_d0(o, vb0, pa0, pa1, pa2, pa3); PSM(pB0, pB1, mnB, alB, j);
    __syncthreads(); SWAIT(); SWRITE(0, SE);
    RESC(alB); __syncthreads();
    SBAR(); qkt<ND0, DOFF>(pA0, pA1, K_lds, qr, r32, hi);
    finishSM(pB0, pB1, alB, l_reg, pa0, pa1, pa2, pa3); SBAR();
    if (j + 3 < NT) SLOAD(SE, (j + 3) * 64); SBAR();
    pv_d0(o, vb0 + SHM_V, pa0, pa1, pa2, pa3); PSM(pA0, pA1, mnA, alA, j + 1);
    __syncthreads(); SWAIT(); SWRITE(1, SO);
    RESC(alA); __syncthreads();
  }
  SBAR(); qkt<ND0, DOFF>(pB0, pB1, K_lds + SHM_K, qr, r32, hi);
  finishSM(pA0, pA1, alA, l_reg, pa0, pa1, pa2, pa3); SBAR();
  pv_d0(o, vb0, pa0, pa1, pa2, pa3); PSM(pB0, pB1, mnB, alB, NT - 1);
  __syncthreads(); RESC(alB);
  finishSM(pB0, pB1, alB, l_reg, pa0, pa1, pa2, pa3); SBAR();
  pv_d0(o, vb0 + SHM_V, pa0, pa1, pa2, pa3);
  if constexpr (MODE == 1) l_reg += __builtin_amdgcn_exp2f(E.sinkl2 - m_reg);
  if (hi == 0) li_l[r32] = l_reg; asm volatile("s_waitcnt lgkmcnt(0)" ::: "memory");
  float rli[16];
#pragma unroll
  for (int r = 0; r < 16; ++r) rli[r] = __builtin_amdgcn_rcpf(li_l[crow(r, hi)]);
  float* pk0 = E.park; float* pk1 = E.park + 64 * 512;
  const int rowb = wid * 32;
  if constexpr (MODE == 0 || MODE == 1) {
#pragma unroll
    for (int r = 0; r < 16; ++r) { const int row = rowb + crow(r, hi);
#pragma unroll
      for (int d0 = 0; d0 < 4; ++d0) { const int idx = (d0 * 16 + r) * 512 + tid;
        const float g = bf2f(E.gate[(size_t)row * GW + d0 * 32 + r32]);
        const float v = o[d0][r] * rli[r] * g;
        if constexpr (MODE == 0) pk0[idx] = v; else pk0[idx] += v; } }
  } else if constexpr (MODE == 2) {
#pragma unroll
    for (int r = 0; r < 16; ++r)
#pragma unroll
      for (int d0 = 0; d0 < 4; ++d0) pk1[(d0 * 16 + r) * 512 + tid] = o[d0][r] * rli[r];
  } else {
    float gs[4];
#pragma unroll
    for (int d0 = 0; d0 < 4; ++d0) gs[d0] = E.gsub[d0 * 32 + r32] * E.oml;
#pragma unroll
    for (int r = 0; r < 16; ++r) { const int row = rowb + crow(r, hi);
      float ss = 0.f;
#pragma unroll
      for (int d0 = 0; d0 < 4; ++d0) { const float c = pk1[(d0 * 16 + r) * 512 + tid] - E.lam * (o[d0][r] * rli[r]); o[d0][r] = c; ss += c * c; }
      ss += __shfl_xor(ss, 1); ss += __shfl_xor(ss, 2); ss += __shfl_xor(ss, 4); ss += __shfl_xor(ss, 8); ss += __shfl_xor(ss, 16);
      const float rs = rsqrtf(ss * (1.f / 128.f) + EPS);
#pragma unroll
      for (int d0 = 0; d0 < 4; ++d0) { const int col = d0 * 32 + r32;
        const float g = bf2f(E.gate[(size_t)row * GW + col]);
        const float y = o[d0][r] * rs * gs[d0] * g + pk0[(d0 * 16 + r) * 512 + tid];
        E.merged[(size_t)row * DM + col] = (bf16_t)(cvtpk(y, y) & 0xffffu); } }
  }
#undef SLOAD
#undef SWRITE
#undef SWAIT
#undef RESC
#undef PSM
}

__device__ __forceinline__ int t5bucket(int rel) {
  const int n = rel < 0 ? -rel : rel;
  const int b = n < 8 ? n : 8 + (n >= 12) + (n >= 16) + (n >= 23) + (n >= 32) + (n >= 46) + (n >= 64) + (n >= 91);
  return b + (rel > 0 ? 16 : 0);
}
__device__ __forceinline__ float wave_sum(float v) {
  v += __shfl_xor(v, 1); v += __shfl_xor(v, 2); v += __shfl_xor(v, 4); v += __shfl_xor(v, 8); v += __shfl_xor(v, 16); v += __shfl_xor(v, 32); return v;
}

__device__ __forceinline__ void phase_setup(const Params& p, unsigned char* shm) {
  int tid_ = threadIdx.x; asm volatile("" : "+v"(tid_)); const int tid = tid_, nb = gridDim.x, bid = blockIdx.x, wid = tid >> 6, lane = tid & 63;
  {
    const float4* s0 = (const float4*)p.in[0]; const float4* s1 = (const float4*)p.in[1]; float4* o = (float4*)p.out;
    const size_t n4 = (size_t)16384 * 1024 / 4;
    for (size_t i = (size_t)bid * 512 + tid; i < 2 * n4; i += (size_t)nb * 512) o[i] = i < n4 ? s0[i] : s1[i - n4];
  }
  {
    float* rope = (float*)(p.ws + WS_ROPE);
    for (int i = bid * 512 + tid; i < 256 * 32; i += nb * 512) { const int pos = i >> 5, f = i & 31;
      const float inv = powf(10000.f, -(float)f / 32.f); const float ang = (float)pos * inv; rope[2 * i] = cosf(ang); rope[2 * i + 1] = sinf(ang); }
    float* lut = (float*)(p.ws + WS_LUT);
    for (int i = bid * 512 + tid; i < 16 * 259; i += nb * 512) { const int hh = i / 259, e = i % 259; int rel = e - 129; float v;
      if (hh < 8) { v = (rel < -128 || rel > 128) ? NEGBIG : p.in[23][t5bucket(rel) * 16 + hh] * LOG2E; }
      else { rel = rel < -128 ? -128 : (rel > 128 ? 128 : rel); v = p.in[23][t5bucket(rel) * 16 + hh] * LOG2E; }
      lut[i] = v; }
    if (bid == 0 && tid < 4) { const int l = tid; float s1 = 0.f, s2 = 0.f;
      for (int i = 0; i < 64; ++i) { s1 += p.in[18][l * 64 + i] * p.in[19][l * 64 + i]; s2 += p.in[20][l * 64 + i] * p.in[21][l * 64 + i]; }
      const float lam_init = 0.8f - 0.6f * expf(-0.3f * (float)l);
      float* lam = (float*)(p.ws + WS_LAM); lam[2 * l] = expf(s1) - expf(s2) + lam_init; lam[2 * l + 1] = 1.f - lam_init; }
  }
  {
    float* sc = (float*)shm; float* red = sc + 9 * 1024;
    for (int i = tid; i < 9 * 1024; i += 512) { const float c = i < 8192 ? p.in[2][i] : p.in[3][i - 8192]; sc[i] = c / (1.f + expf(-c)); }
    __syncthreads();
    float* mod = (float*)(p.ws + WS_MOD);
    for (int task = bid; task < 576; task += nb) {
      const int l = task / 144, j0 = (task % 144) * 64;
      const float* w = p.in[4] + (size_t)l * 1024 * 9216 + j0 + lane;
      float a0 = 0, a1 = 0, a2 = 0, a3 = 0, a4 = 0, a5 = 0, a6 = 0, a7 = 0, a8 = 0;
#pragma unroll 4
      for (int k = wid * 128; k < wid * 128 + 128; ++k) { const float wv = w[(size_t)k * 9216];
        a0 += sc[k] * wv; a1 += sc[1024 + k] * wv; a2 += sc[2048 + k] * wv; a3 += sc[3072 + k] * wv; a4 += sc[4096 + k] * wv;
        a5 += sc[5120 + k] * wv; a6 += sc[6144 + k] * wv; a7 += sc[7168 + k] * wv; a8 += sc[8192 + k] * wv; }
      float* rw = red + wid * 9 * 64 + lane;
      rw[0] = a0; rw[64] = a1; rw[128] = a2; rw[192] = a3; rw[256] = a4; rw[320] = a5; rw[384] = a6; rw[448] = a7; rw[512] = a8;
      __syncthreads();
      for (int i = tid; i < 9 * 64; i += 512) { const int b = i >> 6, ln = i & 63; float s = 0.f;
#pragma unroll
        for (int w8 = 0; w8 < 8; ++w8) s += red[w8 * 9 * 64 + b * 64 + ln];
        mod[((size_t)l * 9 + b) * 9216 + j0 + ln] = s + p.in[5][l * 9216 + j0 + ln]; }
      __syncthreads();
    }
  }
}

__device__ __forceinline__ void phase_convert(const Params& p, int l, unsigned char* shm) {
  float* tile = (float*)shm;
  int tid_ = threadIdx.x; asm volatile("" : "+v"(tid_)); const int tid = tid_;
  for (int q = blockIdx.x; q < 6400; q += gridDim.x) {
    const float* W; bf16_t* Bt; int N, K, k0, n0d, n0s;
    if (q < 2816) { const int i = q / 1408, qq = q % 1408; W = p.in[7] + (size_t)(l * 2 + i) * 1024 * 5632; Bt = (bf16_t*)(p.ws + (i ? WB_FFIN1 : WB_FFIN0)); N = 5632; K = 1024;
      k0 = (qq & 15) * 64; n0d = (qq >> 4) * 64; n0s = ((n0d >> 7) & 1) * 2816 + (n0d >> 8) * 128 + (n0d & 127); }
    else if (q < 4224) { const int i = (q - 2816) / 704, qq = (q - 2816) % 704; W = p.in[8] + (size_t)(l * 2 + i) * 2816 * 1024; Bt = (bf16_t*)(p.ws + (i ? WB_FFOUT1 : WB_FFOUT0)); N = 1024; K = 2816;
      k0 = (qq % 44) * 64; n0d = (qq / 44) * 64; n0s = n0d; }
    else if (q < 6144) { const int qq = q - 4224; W = p.in[9] + (size_t)l * 1024 * 7680; Bt = (bf16_t*)(p.ws + WB_WIN); N = 7680; K = 1024;
      k0 = (qq & 15) * 64; n0d = (qq >> 4) * 64; n0s = n0d; }
    else { const int qq = q - 6144; W = p.in[10] + (size_t)l * 1024 * 1024; Bt = (bf16_t*)(p.ws + WB_WO); N = 1024; K = 1024;
      k0 = (qq & 15) * 64; n0d = (qq >> 4) * 64; n0s = n0d; }
    { const int nl = tid & 63, ks = tid >> 6;
#pragma unroll
      for (int i = 0; i < 8; ++i) { const int k = ks + 8 * i; tile[nl * 65 + k] = W[(size_t)(k0 + k) * N + n0s + nl]; } }
    __syncthreads();
    { const int n = tid >> 3, kc = (tid & 7) * 8; const float* tr = tile + n * 65 + kc;
      u32x4 w; w.x = cvtpk(tr[0], tr[1]); w.y = cvtpk(tr[2], tr[3]); w.z = cvtpk(tr[4], tr[5]); w.w = cvtpk(tr[6], tr[7]);
      *(u32x4*)(Bt + (size_t)(n0d + n) * K + k0 + kc) = w; }
    __syncthreads();
  }
}

__device__ __forceinline__ void phase_norm(const float* __restrict__ x, const float* __restrict__ g, const float* __restrict__ modl, int jj, bf16_t* __restrict__ xn) {
  int tid_ = threadIdx.x; asm volatile("" : "+v"(tid_)); const int tid = tid_, wid = tid >> 6, lane = tid & 63;
  for (int row = blockIdx.x * 8 + wid; row < T_TOK; row += gridDim.x * 8) {
    const int bi = row < 16384 ? (row >> 11) : 8;
    const float* shift = modl + (size_t)bi * 9216 + (3 * jj) * 1024; const float* scale = shift + 1024;
    const float4* xr = (const float4*)(x + (size_t)row * DM);
    float4 v[4]; float ss = 0.f;
#pragma unroll
    for (int i = 0; i < 4; ++i) { v[i] = xr[lane + 64 * i]; ss += v[i].x * v[i].x + v[i].y * v[i].y + v[i].z * v[i].z + v[i].w * v[i].w; }
    ss = wave_sum(ss);
    const float rs = rsqrtf(ss * (1.f / 1024.f) + EPS);
#pragma unroll
    for (int i = 0; i < 4; ++i) { const int c4 = lane + 64 * i;
      const float4 gg = ((const float4*)g)[c4], sc = ((const float4*)scale)[c4], sh = ((const float4*)shift)[c4];
      const float y0 = v[i].x * rs * gg.x * (1.f + sc.x) + sh.x, y1 = v[i].y * rs * gg.y * (1.f + sc.y) + sh.y;
      const float y2 = v[i].z * rs * gg.z * (1.f + sc.z) + sh.z, y3 = v[i].w * rs * gg.w * (1.f + sc.w) + sh.w;
      u32x2 w; w.x = cvtpk(y0, y1); w.y = cvtpk(y2, y3);
      *(u32x2*)(xn + (size_t)row * DM + c4 * 4) = w; }
  }
}

__device__ __forceinline__ void phase_qknorm(const Params& p, int l) {
  bf16_t* qkv = (bf16_t*)(p.ws + WS_QKV); const float* rope = (const float*)(p.ws + WS_ROPE);
  int tid_ = threadIdx.x; asm volatile("" : "+v"(tid_)); const int tid = tid_, wid = tid >> 6, lane = tid & 63;
  const long total = (long)T_TOK * 30;
  for (long task = (long)blockIdx.x * 8 + wid; task < total; task += (long)gridDim.x * 8) {
    const int tok = (int)(task / 30), slot = (int)(task % 30), br = slot / 10, hs = slot % 10;
    const bool isq = hs < 8;
    const int col0 = br * 1536 + (isq ? hs * 128 : 1024 + (hs - 8) * 128);
    unsigned* ptr = (unsigned*)(qkv + (size_t)tok * QKVW + col0) + lane;
    const unsigned u = *ptr; float a = bf_lo(u), b = bf_hi(u);
    float ss = a * a + b * b;
    ss += __shfl_xor(ss, 1); ss += __shfl_xor(ss, 2); ss += __shfl_xor(ss, 4); ss += __shfl_xor(ss, 8); ss += __shfl_xor(ss, 16);
    float rs; const float* g; int gi;
    if (br < 2) { ss += __shfl_xor(ss, 32); rs = rsqrtf(ss * (1.f / 128.f) + EPS); gi = 2 * lane;
      g = p.in[(br == 0 ? 11 : 13) + (isq ? 0 : 1)] + l * 128; }
    else { rs = rsqrtf(ss * (1.f / 64.f) + EPS); gi = (2 * lane) & 63; g = p.in[isq ? 15 : 16] + l * 64; }
    a = a * rs * g[gi]; b = b * rs * g[gi + 1];
    if (br == 0) {
      const int s = tok < 16384 ? (tok & 2047) : (tok - 16384);
      const int pos = lane < 32 ? (s >> 6) : (s & 63);
      const int f0 = (2 * lane) & 31;
      const float4 cs = *(const float4*)(rope + (size_t)(pos * 32 + f0) * 2);
      const float pa = __shfl_xor(a, 16), pb = __shfl_xor(b, 16);
      const float sg = (lane & 16) ? 1.f : -1.f;
      a = a * cs.x + sg * pa * cs.y; b = b * cs.z + sg * pb * cs.w;
    }
    *ptr = cvtpk(a, b);
  }
}

__device__ __forceinline__ void phase_attn(const Params& p, int l, unsigned char* shm) {
  const bf16_t* qkv = (const bf16_t*)(p.ws + WS_QKV); const bf16_t* gates = (const bf16_t*)(p.ws + WS_GATES);
  bf16_t* merged = (bf16_t*)(p.ws + WS_XN);
  const float* lutall = (const float*)(p.ws + WS_LUT); const float* lamp = (const float*)(p.ws + WS_LAM);
  AttnEpi E; E.park = (float*)(p.ws + WS_PARK) + (size_t)blockIdx.x * 65536; E.gsub = p.in[22] + l * 128; E.lam = lamp[2 * l]; E.oml = lamp[2 * l + 1];
  for (int it = blockIdx.x; it < 1024; it += gridDim.x) {
    int S, tok0, h, qb;
    if (it < 512) { S = 16384; tok0 = 16384; h = it & 7; qb = it >> 3; }
    else { const int j = it - 512; S = 2048; h = j & 7; qb = (j >> 3) & 7; tok0 = (j >> 6) * 2048; }
    const int g = h >> 2, q0 = qb * 256;
    const bf16_t* rowQ = qkv + (size_t)(tok0 + q0) * QKVW; const bf16_t* seqK = qkv + (size_t)tok0 * QKVW;
    const bf16_t* grow = gates + (size_t)(tok0 + q0) * GW + h * 128;
    E.merged = merged + (size_t)(tok0 + q0) * DM + h * 128; E.sinkl2 = p.in[17][l * 8 + h] * LOG2E;
    E.gate = grow;
    attn_body<0>(rowQ + h * 128, seqK + 1024 + g * 128, seqK + 1280 + g * 128, S / 64, 0, (char*)shm, lutall, E);
    { const int t_lo = max(0, 4 * qb - 2), t_hi = min(S / 64, 4 * qb + 6);
      const bf16_t* kb = seqK + (size_t)t_lo * 64 * QKVW;
      E.gate = grow + 1024;
      attn_body<1>(rowQ + 1536 + h * 128, kb + 2560 + g * 128, kb + 2816 + g * 128, t_hi - t_lo, t_lo * 64 - q0, (char*)shm, lutall + h * 259, E); }
    E.gate = grow + 2048;
    attn_body<2>(rowQ + 3072 + h * 128, seqK + 4096 + g * 128, seqK + 4352 + g * 128, S / 64, -q0, (char*)shm, lutall + (8 + h) * 259, E);
    attn_body<3>(rowQ + 3072 + h * 128 + 64, seqK + 4096 + g * 128, seqK + 4352 + g * 128, S / 64, -q0, (char*)shm, lutall + (8 + h) * 259, E);
  }
}

__device__ __forceinline__ void gsync(cg::grid_group& g) {
  asm volatile("s_waitcnt vmcnt(0) lgkmcnt(0)" ::: "memory");
  __syncthreads();
  if (threadIdx.x == 0) { __builtin_amdgcn_fence(__ATOMIC_RELEASE, "agent"); asm volatile("s_waitcnt vmcnt(0)" ::: "memory"); }
  g.sync();
  __builtin_amdgcn_fence(__ATOMIC_ACQUIRE, "agent");
  asm volatile("s_waitcnt vmcnt(0)" ::: "memory");
}
constexpr int N_PHASES = 45;
__global__ void __launch_bounds__(512) mega_fwd(Params p, int ph_lo, int ph_hi) {
  extern __shared__ __attribute__((aligned(16))) unsigned char shm[];
  cg::grid_group grid = cg::this_grid();
  LAS unsigned char* lds3 = (LAS unsigned char*)shm;
  float* X = p.out;
  bf16_t* XN = (bf16_t*)(p.ws + WS_XN); bf16_t* Hb = (bf16_t*)(p.ws + WS_QKV);
  pg8::StaticOrder S;
#pragma unroll 1
  for (int ph = ph_lo; ph < ph_hi; ++ph) {
    if (ph == 0) { phase_setup(p, shm); }
    else {
      const int l = (ph - 1) / 11, k = (ph - 1) % 11;
      const float* modl = (const float*)(p.ws + WS_MOD) + (size_t)l * 9 * 9216;
      if (k == 0 || k == 3 || k == 8) {
        if (k == 0) phase_convert(p, l, shm);
        const int jj = k == 0 ? 0 : (k == 3 ? 1 : 2);
        phase_norm(X, p.in[6] + (size_t)(l * 3 + jj) * 1024, modl, jj, XN);
      } else if (k == 1 || k == 9) {
        pg8::Gemm g{XN, (const bf16_t*)(p.ws + (k == 9 ? WB_FFIN1 : WB_FFIN0)), T_TOK, NFF2, DM};
        S.init(T_TOK, NFF2, gridDim.x, blockIdx.x); pg8::EpiSwiGLU E{Hb}; pg8::gemm_phase(lds3, g, S, E);
      } else if (k == 2 || k == 10 || k == 7) {
        const bool wo = (k == 7);
        pg8::Gemm g{wo ? XN : Hb, (const bf16_t*)(p.ws + (wo ? WB_WO : (k == 10 ? WB_FFOUT1 : WB_FFOUT0))), T_TOK, DM, wo ? DM : DFF};
        S.init(T_TOK, DM, gridDim.x, blockIdx.x); pg8::EpiResid E{X, modl + (wo ? 5 : (k == 10 ? 8 : 2)) * 1024, wo ? 1.0f : 0.5f}; pg8::gemm_phase(lds3, g, S, E);
      } else if (k == 4) {
        pg8::Gemm g{XN, (const bf16_t*)(p.ws + WB_WIN), T_TOK, WINC, DM};
        S.init(T_TOK, WINC, gridDim.x, blockIdx.x); pg8::EpiQKV E{(bf16_t*)(p.ws + WS_QKV), (bf16_t*)(p.ws + WS_GATES)}; pg8::gemm_phase(lds3, g, S, E);
      } else if (k == 5) { phase_qknorm(p, l); }
      else { phase_attn(p, l, shm); }
    }
    if (ph + 1 < ph_hi) gsync(grid);
  }
}

#ifndef N_LAUNCH_MODE
#define N_LAUNCH_MODE 1
#endif
extern "C" void kernel_launch(void* const* d_in, const int* in_sizes, int n_in, void* d_out, int out_size, void* d_ws, size_t ws_size, hipStream_t stream) {
  static int grid = 0;
  if (grid == 0) {
    if (n_in != 24 || out_size != T_TOK * DM || ws_size < WS_END) { fprintf(stderr, "kernel_launch: unexpected shapes (n_in %d out %d ws %zu need %zu)\n", n_in, out_size, ws_size, (size_t)WS_END); grid = -1; return; }
    int dev = 0, cus = 0, per_cu = 0;
    (void)hipGetDevice(&dev); (void)hipDeviceGetAttribute(&cus, hipDeviceAttributeMultiprocessorCount, dev);
    if (hipFuncSetAttribute((const void*)mega_fwd, hipFuncAttributeMaxDynamicSharedMemorySize, LDS_BYTES) != hipSuccess) { fprintf(stderr, "kernel_launch: hipFuncSetAttribute failed\n"); grid = -1; return; }
    if (hipOccupancyMaxActiveBlocksPerMultiprocessor(&per_cu, (const void*)mega_fwd, 512, LDS_BYTES) != hipSuccess || per_cu < 1) { fprintf(stderr, "kernel_launch: occupancy query gave %d\n", per_cu); per_cu = 1; }
    (void)hipGetLastError();
    grid = cus;
  }
  if (grid < 0) return;
  Params p{};
  for (int i = 0; i < 24; ++i) p.in[i] = (const float*)d_in[i];
  p.out = (float*)d_out; p.ws = (unsigned char*)d_ws;
#if N_LAUNCH_MODE == 1
  int lo = 0, hi = N_PHASES;
  void* args[] = {&p, &lo, &hi};
  hipError_t e = hipLaunchCooperativeKernel((const void*)mega_fwd, dim3(grid), dim3(512), args, LDS_BYTES, stream);
  if (e != hipSuccess) fprintf(stderr, "kernel_launch: cooperative launch failed: %s (grid %d)\n", hipGetErrorString(e), grid);
#else
  for (int ph = 0; ph < N_PHASES; ++ph) hipLaunchKernelGGL(mega_fwd, dim3(grid), dim3(512), LDS_BYTES, stream, p, ph, ph + 1);
#endif
}
```

```cpp
#include <hip/hip_runtime.h>
#include <hip/hip_bf16.h>
#include <hip/hip_cooperative_groups.h>
#include <cstdio>
#include <cstdint>
#define N_LAUNCH_MODE 1
namespace cg = cooperative_groups;

typedef unsigned short bf16_t;
typedef short bf16x8 __attribute__((ext_vector_type(8)));
typedef short s16x4 __attribute__((ext_vector_type(4)));
typedef float f32x4 __attribute__((ext_vector_type(4)));
typedef float f32x16 __attribute__((ext_vector_type(16)));
typedef unsigned u32x4 __attribute__((ext_vector_type(4)));
typedef unsigned u32x2 __attribute__((ext_vector_type(2)));
#define LAS __attribute__((address_space(3)))

constexpr int T_TOK = 32768, DM = 1024, DFF = 2816, NFF2 = 5632, WINC = 7680, QKVW = 4608, GW = 3072;
constexpr float EPS = 1e-6f, LOG2E = 1.4426950408889634f, NEGBIG = -1e30f;
constexpr size_t WB_FFIN0 = 0, WB_FFIN1 = 11534336, WB_FFOUT0 = 23068672, WB_FFOUT1 = 28835840, WB_WIN = 34603008, WB_WO = 50331648;
constexpr size_t WS_MOD = 52428800, WS_ROPE = 53755904, WS_LUT = 53821440, WS_LAM = 53854208, WS_XN = 53854464;
constexpr size_t WS_QKV = WS_XN + 67108864, WS_GATES = WS_QKV + 301989888, WS_PARK = WS_GATES + 201326592, WS_END = WS_PARK + 67108864;
constexpr int LDS_BYTES = 131072;

struct Params { const float* in[24]; float* out; unsigned char* ws; };

typedef __bf16 bf16v2 __attribute__((ext_vector_type(2)));
typedef float f32x2 __attribute__((ext_vector_type(2)));
__device__ __forceinline__ unsigned cvtpk(float lo, float hi) { f32x2 v = {lo, hi}; bf16v2 b = __builtin_convertvector(v, bf16v2); return __builtin_bit_cast(unsigned, b); }
__device__ __forceinline__ float bf_lo(unsigned u) { return __uint_as_float(u << 16); }
__device__ __forceinline__ float bf_hi(unsigned u) { return __uint_as_float(u & 0xffff0000u); }
__device__ __forceinline__ float bf2f(bf16_t v) { return __uint_as_float(((unsigned)v) << 16); }

namespace pg8 {
constexpr int BM = 256, BK = 64, HALF = 128, HTB = HALF * BK * 2, STAGE_BYTES = 8 * HTB, NXCD = 8, WGM = 8;
__device__ __forceinline__ int lds_byte(int r, int c) { const int st = (r >> 4) * 2 + (c >> 5), rr = r & 15, cc = c & 31, ob = rr * 64 + cc * 2; return st * 1024 + (ob ^ (((ob >> 9) & 1) << 5)); }
__device__ __forceinline__ void stage_rc(int b, int& R, int& C) { const int st = b / 1024, sb = b % 1024, swz = sb ^ (((sb >> 9) & 1) << 5); R = (st >> 1) * 16 + swz / 64; C = (st & 1) * 32 + (swz % 64) / 2; }
__device__ __forceinline__ int perm32(int rho) { const int n = rho >> 4, i = rho & 15; return 8 * (i >> 2) + 4 * n + (i & 3); }
struct Unit { int pm, pn; };
struct Gemm { const bf16_t* A; const bf16_t* Bt; int M, N, K; };
struct StaticOrder {
    int nM, nN, nwg, G, c;
    __device__ void init(int M, int N, int G_, int c_) { nM = M / BM; nN = N / BM; nwg = nM * nN; G = G_; c = c_; }
    __device__ bool next(int i, Unit& u) const {
        const long L = (long)i * G + c; if (L >= nwg) return false;
        int wgid = (int)L; { const int q = nwg / NXCD, r = nwg % NXCD, xcd = wgid % NXCD, off = wgid / NXCD; wgid = (xcd < r ? xcd * (q + 1) : r * (q + 1) + (xcd - r) * q) + off; }
        const int nig = WGM * nN, gid = wgid / nig, fm = gid * WGM, gsz = (nM - fm) < WGM ? (nM - fm) : WGM;
        u.pm = fm + ((wgid % nig) % gsz); u.pn = (wgid % nig) / gsz; return true;
    }
};

template <class Epi>
__device__ __forceinline__ void gemm_phase(LAS unsigned char* lds, const Gemm g, const StaticOrder& S, const Epi& E) {
    int tid_ = threadIdx.x; asm volatile("" : "+v"(tid_));
    const int tid = tid_, wid = __builtin_amdgcn_readfirstlane(tid >> 6), lane = tid & 63, wr = wid >> 2, wc = wid & 3, fr = lane & 15, fq = lane >> 4;
    const int K = g.K, nt = K / BK;
    unsigned voffA[2], voffB[2];
#pragma unroll
    for (int i = 0; i < 2; ++i) { int R, C; stage_rc(tid * 16 + i * 8192, R, C); const int Rb = Epi::PERM ? ((R & ~31) + perm32(R & 31)) : R;
        voffA[i] = (unsigned)(R * K + C) * 2u; voffB[i] = (unsigned)(Rb * K + C) * 2u; }
    const size_t kstep = (size_t)(BK * 2);
    const size_t hstep = (size_t)HALF * K * 2;
    const size_t tstep = 2 * hstep;
    const unsigned ldsw = (unsigned)wid * 1024u;
    const int aoff = lds_byte(wr * 64 + fr, fq * 8), boff = lds_byte(wc * 32 + fr, fq * 8);
#define PG8_SA(b, h) (((b) * 2 + (h)) * HTB)
#define PG8_SB(b, h) ((4 + (b) * 2 + (h)) * HTB)
#define PG8_STAGE(bufoff, gbase, voff) do { _Pragma("unroll") for (int _i = 0; _i < 2; ++_i) \
        __builtin_amdgcn_global_load_lds((const unsigned*)((const char*)(gbase) + (voff)[_i]), (LAS unsigned*)(lds + (bufoff) + ldsw + _i * 8192), 16, 0, 0); } while (0)
#define PG8_LDA(dst, b, h) do { _Pragma("unroll") for (int m = 0; m < 4; ++m) _Pragma("unroll") for (int k = 0; k < 2; ++k) dst[m][k] = *(const LAS bf16x8*)(lds + PG8_SA(b, h) + aoff + m * 2048 + k * 1024); } while (0)
#define PG8_LDB(dst, b, h) do { _Pragma("unroll") for (int n = 0; n < 2; ++n) _Pragma("unroll") for (int k = 0; k < 2; ++k) dst[n][k] = *(const LAS bf16x8*)(lds + PG8_SB(b, h) + boff + n * 2048 + k * 1024); } while (0)
#define PG8_MMA(ai, bj, At, Bt) do { __builtin_amdgcn_s_setprio(1); _Pragma("unroll") for (int m = 0; m < 4; ++m) _Pragma("unroll") for (int n = 0; n < 2; ++n) _Pragma("unroll") for (int k = 0; k < 2; ++k) \
        acc[ai][bj][m][n] = __builtin_amdgcn_mfma_f32_16x16x32_bf16(Bt[n][k], At[m][k], acc[ai][bj][m][n], 0, 0, 0); __builtin_amdgcn_s_setprio(0); } while (0)
#define PG8_WAIT_V(n) asm volatile("s_waitcnt vmcnt(" #n ")" ::: "memory")
#define PG8_WAIT_L(n) asm volatile("s_waitcnt lgkmcnt(" #n ")" ::: "memory")
#define PG8_BAR __builtin_amdgcn_s_barrier()
#define PG8_SCHED __builtin_amdgcn_sched_barrier(0)
    Unit cur, nxt; int ui = 0;
    if (!S.next(0, cur)) return;
    f32x4 acc[2][2][4][2];
#pragma unroll
    for (int a = 0; a < 2; ++a)
#pragma unroll
        for (int b = 0; b < 2; ++b)
#pragma unroll
            for (int m = 0; m < 4; ++m)
#pragma unroll
                for (int n = 0; n < 2; ++n) acc[a][b][m][n] = (f32x4){0.f, 0.f, 0.f, 0.f};
    bf16x8 At[4][2], B0[2][2], B1[2][2];
    const char* cA = (const char*)g.A + (size_t)cur.pm * tstep; const char* cB = (const char*)g.Bt + (size_t)cur.pn * tstep;
    PG8_STAGE(PG8_SB(0, 0), cB, voffB); PG8_STAGE(PG8_SA(0, 0), cA, voffA); PG8_STAGE(PG8_SB(0, 1), cB + hstep, voffB); PG8_STAGE(PG8_SA(0, 1), cA + hstep, voffA);
    if (wr == 1) PG8_BAR;
    PG8_WAIT_V(4); PG8_BAR;
    PG8_STAGE(PG8_SB(1, 0), cB + kstep, voffB); PG8_STAGE(PG8_SA(1, 0), cA + kstep, voffA); PG8_STAGE(PG8_SB(1, 1), cB + hstep + kstep, voffB);
    PG8_WAIT_V(6); PG8_BAR;
    for (;;) {
        const bool has_next = S.next(ui + 1, nxt);
        const char* nA = has_next ? (const char*)g.A + (size_t)nxt.pm * tstep : cA; const char* nB = has_next ? (const char*)g.Bt + (size_t)nxt.pn * tstep : cB;
        for (int t = 0; t < nt; t += 2) {
            const bool last = (t == nt - 2);
            const char* a1 = cA + (size_t)(t + 1) * kstep;
            const char* a2 = last ? nA : cA + (size_t)(t + 2) * kstep; const char* b2 = last ? nB : cB + (size_t)(t + 2) * kstep;
            const char* a3 = a2 + kstep; const char* b3 = b2 + kstep;
            PG8_LDB(B0, 0, 0); PG8_SCHED; PG8_LDA(At, 0, 0); PG8_STAGE(PG8_SA(1, 1), a1 + hstep, voffA);
            PG8_WAIT_L(8); PG8_BAR; PG8_WAIT_L(0); PG8_MMA(0, 0, At, B0); PG8_BAR; PG8_SCHED;
            PG8_LDB(B1, 0, 1); PG8_STAGE(PG8_SB(0, 0), b2, voffB);
            PG8_BAR; PG8_WAIT_L(0); PG8_MMA(0, 1, At, B1); PG8_BAR;
            PG8_LDA(At, 0, 1); PG8_STAGE(PG8_SA(0, 0), a2, voffA);
            PG8_BAR; PG8_WAIT_L(0); PG8_MMA(1, 0, At, B0); PG8_BAR; PG8_SCHED;
            PG8_STAGE(PG8_SB(0, 1), b2 + hstep, voffB);
            PG8_WAIT_V(6); PG8_BAR; PG8_MMA(1, 1, At, B1); PG8_BAR;
            PG8_LDB(B0, 1, 0); PG8_SCHED; PG8_LDA(At, 1, 0); PG8_STAGE(PG8_SA(0, 1), a2 + hstep, voffA);
            PG8_WAIT_L(8); PG8_BAR; PG8_WAIT_L(0); PG8_MMA(0, 0, At, B0); PG8_BAR; PG8_SCHED;
            PG8_LDB(B1, 1, 1); PG8_STAGE(PG8_SB(1, 0), b3, voffB);
            PG8_BAR; PG8_WAIT_L(0); PG8_MMA(0, 1, At, B1); PG8_BAR;
            PG8_LDA(At, 1, 1); PG8_STAGE(PG8_SA(1, 0), a3, voffA);
            PG8_BAR; PG8_WAIT_L(0); PG8_MMA(1, 0, At, B0); PG8_BAR; PG8_SCHED;
            PG8_STAGE(PG8_SB(1, 1), b3 + hstep, voffB);
            PG8_WAIT_V(6); PG8_BAR; PG8_MMA(1, 1, At, B1); PG8_BAR;
        }
        E(acc, cur, wr, wc, fr, fq);
        if (!has_next) break;
#pragma unroll
        for (int a = 0; a < 2; ++a)
#pragma unroll
            for (int b = 0; b < 2; ++b)
#pragma unroll
                for (int m = 0; m < 4; ++m)
#pragma unroll
                    for (int n = 0; n < 2; ++n) acc[a][b][m][n] = (f32x4){0.f, 0.f, 0.f, 0.f};
        cur = nxt; cA = nA; cB = nB; ++ui;
    }
    PG8_WAIT_V(0);
    if (wr == 0) PG8_BAR;
    PG8_BAR;
#undef PG8_SA
#undef PG8_SB
#undef PG8_STAGE
#undef PG8_LDA
#undef PG8_LDB
#undef PG8_MMA
#undef PG8_WAIT_V
#undef PG8_WAIT_L
#undef PG8_BAR
#undef PG8_SCHED
}

__device__ __forceinline__ float silu_f(float g) { return g * __builtin_amdgcn_rcpf(1.f + __expf(-g)); }
__device__ __forceinline__ float sigm_f(float g) { return __builtin_amdgcn_rcpf(1.f + __expf(-g)); }
struct EpiSwiGLU {
    static constexpr bool PERM = true;
    bf16_t* H;
    __device__ __forceinline__ void operator()(const f32x4 (&acc)[2][2][4][2], const Unit& u, int wr, int wc, int fr, int fq) const {
        const int row0 = u.pm * BM + wr * 64 + fr, col0 = u.pn * 128 + wc * 32 + 8 * fq;
#pragma unroll
        for (int ai = 0; ai < 2; ++ai)
#pragma unroll
            for (int m = 0; m < 4; ++m) { bf16_t* rowp = H + (size_t)(row0 + ai * HALF + m * 16) * DFF + col0;
                const f32x4 g0 = acc[ai][0][m][0], g1 = acc[ai][0][m][1], u0 = acc[ai][1][m][0], u1 = acc[ai][1][m][1];
                u32x4 w; w.x = cvtpk(silu_f(g0[0]) * u0[0], silu_f(g0[1]) * u0[1]); w.y = cvtpk(silu_f(g0[2]) * u0[2], silu_f(g0[3]) * u0[3]);
                w.z = cvtpk(silu_f(g1[0]) * u1[0], silu_f(g1[1]) * u1[1]); w.w = cvtpk(silu_f(g1[2]) * u1[2], silu_f(g1[3]) * u1[3]);
                *(u32x4*)rowp = w; }
    }
};
struct EpiResid {
    static constexpr bool PERM = false;
    float* X; const float* modg; float gs;
    __device__ __forceinline__ void operator()(const f32x4 (&acc)[2][2][4][2], const Unit& u, int wr, int wc, int fr, int fq) const {
        const int row0 = u.pm * BM + wr * 64 + fr, col0 = u.pn * BM + wc * 32 + 4 * fq;
        const int bi = u.pm < 64 ? (u.pm >> 3) : 8;
        const float* mg = modg + (size_t)bi * 9216 + col0;
        f32x4 gv[2][2];
#pragma unroll
        for (int bj = 0; bj < 2; ++bj)
#pragma unroll
            for (int n = 0; n < 2; ++n) gv[bj][n] = *(const f32x4*)(mg + bj * HALF + n * 16) * gs;
#pragma unroll
        for (int ai = 0; ai < 2; ++ai)
#pragma unroll
            for (int m = 0; m < 4; ++m) { float* rowp = X + (size_t)(row0 + ai * HALF + m * 16) * DM + col0;
#pragma unroll
                for (int bj = 0; bj < 2; ++bj)
#pragma unroll
                    for (int n = 0; n < 2; ++n) { f32x4* q = (f32x4*)(rowp + bj * HALF + n * 16); *q = *q + gv[bj][n] * acc[ai][bj][m][n]; } }
    }
};
struct EpiQKV {
    static constexpr bool PERM = true;
    bf16_t* QKV; bf16_t* GATES;
    __device__ __forceinline__ void operator()(const f32x4 (&acc)[2][2][4][2], const Unit& u, int wr, int wc, int fr, int fq) const {
        const int row0 = u.pm * BM + wr * 64 + fr;
        if (u.pn < 18) {
            const int col0 = u.pn * BM + wc * 32 + 8 * fq;
#pragma unroll
            for (int ai = 0; ai < 2; ++ai)
#pragma unroll
                for (int m = 0; m < 4; ++m) { bf16_t* rowp = QKV + (size_t)(row0 + ai * HALF + m * 16) * QKVW + col0;
#pragma unroll
                    for (int bj = 0; bj < 2; ++bj) { const f32x4 v0 = acc[ai][bj][m][0], v1 = acc[ai][bj][m][1];
                        u32x4 w; w.x = cvtpk(v0[0], v0[1]); w.y = cvtpk(v0[2], v0[3]); w.z = cvtpk(v1[0], v1[1]); w.w = cvtpk(v1[2], v1[3]);
                        *(u32x4*)(rowp + bj * HALF) = w; } }
        } else {
            const int col0 = (u.pn - 18) * BM + wc * 32 + 8 * fq;
#pragma unroll
            for (int ai = 0; ai < 2; ++ai)
#pragma unroll
                for (int m = 0; m < 4; ++m) { bf16_t* rowp = GATES + (size_t)(row0 + ai * HALF + m * 16) * GW + col0;
#pragma unroll
                    for (int bj = 0; bj < 2; ++bj) { const f32x4 v0 = acc[ai][bj][m][0], v1 = acc[ai][bj][m][1];
                        u32x4 w; w.x = cvtpk(sigm_f(v0[0]), sigm_f(v0[1])); w.y = cvtpk(sigm_f(v0[2]), sigm_f(v0[3])); w.z = cvtpk(sigm_f(v1[0]), sigm_f(v1[1])); w.w = cvtpk(sigm_f(v1[2]), sigm_f(v1[3]));
                        *(u32x4*)(rowp + bj * HALF) = w; } }
        }
    }
};
}

constexpr int LDQK = QKVW;
constexpr int SHM_V = 64 * 128 * 2, SHM_K = 64 * 128 * 2;
constexpr int ATT_WS_OFF = 2 * SHM_V + 2 * SHM_K, ATT_LUT_OFF = ATT_WS_OFF + 8 * 64 * 4;
#define KSWZ(row, colB) ((row) * 256 + ((colB) ^ (((row) & 7) << 4)))
#define SBAR() __builtin_amdgcn_sched_barrier(0)
__device__ __forceinline__ int crow(int r, int hi) { return (r & 3) + 8 * (r >> 2) + 4 * hi; }

template <int MODE>
__device__ __forceinline__ void partialSM(f32x16& p0, f32x16& p1, float& m_reg, float& mn, float& alpha, int relh, int relw_min, int relw_max, const float* lut) {
  if constexpr (MODE == 0) {
    constexpr float SCALE = 0.088388347648318440f, C = SCALE * LOG2E, THR = 8.f;
    float pmax = p0[0];
#pragma unroll
    for (int r = 1; r < 16; ++r) pmax = fmaxf(pmax, p0[r]);
#pragma unroll
    for (int r = 0; r < 16; ++r) pmax = fmaxf(pmax, p1[r]);
    { auto rr = __builtin_amdgcn_permlane32_swap(__float_as_uint(pmax), __float_as_uint(pmax), false, false);
      pmax = fmaxf(__uint_as_float(rr[0]), __uint_as_float(rr[1])); }
    if (__builtin_expect(__all(pmax - m_reg <= THR / SCALE), 1)) { mn = m_reg; alpha = 1.f; }
    else { mn = fmaxf(m_reg, pmax); alpha = __builtin_amdgcn_exp2f((m_reg - mn) * C); m_reg = mn; }
    const float mnC = -mn * C;
#pragma unroll
    for (int r = 0; r < 16; ++r) p0[r] = fmaf(p0[r], C, mnC);
#pragma unroll
    for (int r = 0; r < 16; ++r) p1[r] = fmaf(p1[r], C, mnC);
#pragma unroll
    for (int r = 0; r < 16; ++r) p0[r] = __builtin_amdgcn_exp2f(p0[r]);
  } else {
    constexpr float C = (MODE == 1 ? 0.088388347648318440f : 0.125f) * LOG2E, THR2 = 8.f * LOG2E;
    bool nearT = true; float cfar = 0.f;
    if constexpr (MODE >= 2) {
      if (relw_max <= -128) { nearT = false; cfar = lut[0]; }
      else if (relw_min >= 128) { nearT = false; cfar = lut[258]; }
    }
    if (nearT) {
#pragma unroll
      for (int r = 0; r < 16; ++r) { const int i0 = relh + (r & 3) + 8 * (r >> 2);
        const int a0 = min(max(i0, -129), 129) + 129, a1 = min(max(i0 + 32, -129), 129) + 129;
        p0[r] = fmaf(p0[r], C, lut[a0]); p1[r] = fmaf(p1[r], C, lut[a1]); }
    } else {
#pragma unroll
      for (int r = 0; r < 16; ++r) { p0[r] = fmaf(p0[r], C, cfar); p1[r] = fmaf(p1[r], C, cfar); }
    }
    float pmax = p0[0];
#pragma unroll
    for (int r = 1; r < 16; ++r) pmax = fmaxf(pmax, p0[r]);
#pragma unroll
    for (int r = 0; r < 16; ++r) pmax = fmaxf(pmax, p1[r]);
    { auto rr = __builtin_amdgcn_permlane32_swap(__float_as_uint(pmax), __float_as_uint(pmax), false, false);
      pmax = fmaxf(__uint_as_float(rr[0]), __uint_as_float(rr[1])); }
    if (__builtin_expect(__all(pmax - m_reg <= THR2), 1)) { mn = m_reg; alpha = 1.f; }
    else { mn = fmaxf(m_reg, pmax); alpha = __builtin_amdgcn_exp2f(m_reg - mn); m_reg = mn; }
#pragma unroll
    for (int r = 0; r < 16; ++r) p0[r] = __builtin_amdgcn_exp2f(p0[r] - mn);
#pragma unroll
    for (int r = 0; r < 16; ++r) p1[r] = p1[r] - mn;
  }
}
__device__ __forceinline__ void finishSM(f32x16& p0, f32x16& p1, float alpha, float& l_reg, bf16x8& pa0, bf16x8& pa1, bf16x8& pa2, bf16x8& pa3) {
#pragma unroll
  for (int r = 0; r < 16; ++r) p1[r] = __builtin_amdgcn_exp2f(p1[r]);
  float ps = 0;
#pragma unroll
  for (int r = 0; r < 16; ++r) ps += p0[r];
#pragma unroll
  for (int r = 0; r < 16; ++r) ps += p1[r];
  { auto rr = __builtin_amdgcn_permlane32_swap(__float_as_uint(ps), __float_as_uint(ps), false, false);
    ps = __uint_as_float(rr[0]) + __uint_as_float(rr[1]); }
  l_reg = l_reg * alpha + ps;
#define PK4(P, BASE, OUT) do { unsigned a0 = cvtpk(P[BASE + 0], P[BASE + 1]), a1 = cvtpk(P[BASE + 2], P[BASE + 3]);   \
    unsigned b0 = cvtpk(P[BASE + 4], P[BASE + 5]), b1 = cvtpk(P[BASE + 6], P[BASE + 7]);                              \
    auto r0 = __builtin_amdgcn_permlane32_swap(a0, b0, false, false); auto r1 = __builtin_amdgcn_permlane32_swap(a1, b1, false, false); \
    u32x4 w = {r0[0], r1[0], r0[1], r1[1]}; OUT = *reinterpret_cast<bf16x8*>(&w); } while (0)
  PK4(p0, 0, pa0); PK4(p0, 8, pa1); PK4(p1, 0, pa2); PK4(p1, 8, pa3);
#undef PK4
}
template <int ND0, int DOFF>
__device__ __forceinline__ void qkt(f32x16& p0, f32x16& p1, const char* Ks, const bf16x8* qr, int r32, int hi) {
  p0 = f32x16{}; p1 = f32x16{};
#pragma unroll
  for (int d0 = 0; d0 < ND0; ++d0) { const int cb = ((d0 + DOFF) * 16 + hi * 8) * 2;
    bf16x8 b0 = *reinterpret_cast<const bf16x8*>(Ks + KSWZ(r32, cb));
    bf16x8 b1 = *reinterpret_cast<const bf16x8*>(Ks + KSWZ(32 + r32, cb));
    p0 = __builtin_amdgcn_mfma_f32_32x32x16_bf16(b0, qr[d0], p0, 0, 0, 0);
    p1 = __builtin_amdgcn_mfma_f32_32x32x16_bf16(b1, qr[d0], p1, 0, 0, 0); }
}
__device__ __forceinline__ int v_st(int k, int c) { const int kk = (k & ~0xC) | ((k & 4) << 1) | ((k & 8) >> 1); return ((kk >> 3) * 4 + (c >> 5)) * 512 + ((kk & 7) * 32 + (c & 31)) * 2; }
__device__ __forceinline__ int v_rd_base(int lane) { return ((lane & 3) << 3) | (((lane >> 2) & 3) << 6) | (((lane >> 4) & 1) << 5) | (((lane >> 5) & 1) << 8); }
constexpr int v_rd_off(int d0, int ks, int half) { return d0 * 512 + ks * 4096 + half * 2048; }
template <int OFF> __device__ __forceinline__ s16x4 tr_read(int vb) {
  s16x4 r; asm volatile("ds_read_b64_tr_b16 %0, %1 offset:%2" : "=&v"(r) : "v"(vb), "i"(OFF) : "memory"); return r;
}
template <int D0> __device__ __forceinline__ void pv_one(f32x16& od, int vb, bf16x8 pa0, bf16x8 pa1, bf16x8 pa2, bf16x8 pa3) {
  const s16x4 l0 = tr_read<v_rd_off(D0, 0, 0)>(vb), h0 = tr_read<v_rd_off(D0, 0, 1)>(vb), l1 = tr_read<v_rd_off(D0, 1, 0)>(vb), h1 = tr_read<v_rd_off(D0, 1, 1)>(vb);
  const s16x4 l2 = tr_read<v_rd_off(D0, 2, 0)>(vb), h2 = tr_read<v_rd_off(D0, 2, 1)>(vb), l3 = tr_read<v_rd_off(D0, 3, 0)>(vb), h3 = tr_read<v_rd_off(D0, 3, 1)>(vb);
  asm volatile("s_waitcnt lgkmcnt(0)" ::: "memory"); SBAR();
#define PK(L, H) (bf16x8){L[0], L[1], L[2], L[3], H[0], H[1], H[2], H[3]}
  od = __builtin_amdgcn_mfma_f32_32x32x16_bf16(pa0, PK(l0, h0), od, 0, 0, 0);
  od = __builtin_amdgcn_mfma_f32_32x32x16_bf16(pa1, PK(l1, h1), od, 0, 0, 0);
  od = __builtin_amdgcn_mfma_f32_32x32x16_bf16(pa2, PK(l2, h2), od, 0, 0, 0);
  od = __builtin_amdgcn_mfma_f32_32x32x16_bf16(pa3, PK(l3, h3), od, 0, 0, 0);
#undef PK
}
__device__ __forceinline__ void pv_d0(f32x16* o, int vb, bf16x8 pa0, bf16x8 pa1, bf16x8 pa2, bf16x8 pa3) {
  pv_one<0>(o[0], vb, pa0, pa1, pa2, pa3); pv_one<1>(o[1], vb, pa0, pa1, pa2, pa3); pv_one<2>(o[2], vb, pa0, pa1, pa2, pa3); pv_one<3>(o[3], vb, pa0, pa1, pa2, pa3);
}

struct AttnEpi {
  const bf16_t* gate;
  float* park;
  bf16_t* merged;
  const float* gsub;
  float lam, oml;
  float sinkl2;
};

template <int MODE>
__device__ __forceinline__ void attn_body(const bf16_t* __restrict__ Qb, const bf16_t* __restrict__ Kh, const bf16_t* __restrict__ Vh, int NT, int krel0,
                                          char* lds, const float* __restrict__ lutg, const AttnEpi& E) {
  constexpr int ND0 = (MODE < 2) ? 8 : 4, DOFF = (MODE == 3) ? 4 : 0;
  int tid_ = threadIdx.x; asm volatile("" : "+v"(tid_));
  const int tid = tid_, wid = tid >> 6, lane = tid & 63, r32 = lane & 31, hi = lane >> 5;
  char* V_lds = lds; char* K_lds = lds + 2 * SHM_V;
  float* wsm = (float*)(lds + ATT_WS_OFF) + wid * 64; float* li_l = wsm; float* al_l = wsm + 32;
  float* lut = (float*)(lds + ATT_LUT_OFF);
  __syncthreads();
  if constexpr (MODE != 0) { if (tid < 259) lut[tid] = lutg[tid]; }
  float m_reg = -1e30f, l_reg = 0; f32x16 o[4] = {}; bf16x8 qr[ND0];
  const bf16_t* Qw = Qb + (size_t)(wid * 32 + r32) * LDQK + hi * 8;
#pragma unroll
  for (int d0 = 0; d0 < ND0; ++d0) qr[d0] = *reinterpret_cast<const bf16x8*>(Qw + d0 * 16);
  const int sr = tid >> 4, sc = (tid & 15) * 8, vst0 = v_st(sr, sc), vst1 = v_st(32 + sr, sc);
  const int vb0 = (int)(uintptr_t)V_lds + v_rd_base(lane);
  struct { bf16x8 vs0, vs1, ks0, ks1; } sr_[2];
#define SLOAD(i, k0) do { sr_[i].vs0 = *reinterpret_cast<const bf16x8*>(&Vh[(size_t)((k0) + sr) * LDQK + sc]); sr_[i].vs1 = *reinterpret_cast<const bf16x8*>(&Vh[(size_t)((k0) + 32 + sr) * LDQK + sc]); \
    sr_[i].ks0 = *reinterpret_cast<const bf16x8*>(&Kh[(size_t)((k0) + sr) * LDQK + sc]); sr_[i].ks1 = *reinterpret_cast<const bf16x8*>(&Kh[(size_t)((k0) + 32 + sr) * LDQK + sc]); } while (0)
#define SWRITE(b, i) do { *(bf16x8*)(V_lds + (b) * SHM_V + vst0) = sr_[i].vs0;          \
    *(bf16x8*)(V_lds + (b) * SHM_V + vst1) = sr_[i].vs1; int kc = sc * 2;               \
    *(bf16x8*)(K_lds + (b) * SHM_K + KSWZ(sr, kc)) = sr_[i].ks0;                       \
    *(bf16x8*)(K_lds + (b) * SHM_K + KSWZ(32 + sr, kc)) = sr_[i].ks1; } while (0)
#define SWAIT() asm volatile("s_waitcnt vmcnt(4)" ::: "memory")
#define RESC(a) do { if (__any((a) < 1.f)) { if (hi == 0) al_l[r32] = (a); asm volatile("s_waitcnt lgkmcnt(0)" ::: "memory"); \
    _Pragma("unroll") for (int d = 0; d < 4; ++d) _Pragma("unroll") for (int r = 0; r < 16; ++r) o[d][r] *= al_l[crow(r, hi)]; } } while (0)
  const int relq = krel0 - (wid * 32 + r32) + 4 * hi, relwmin = krel0 - (wid * 32 + 31), relwmax = krel0 + 63 - wid * 32;
#define PSM(P0, P1, MN, AL, J) partialSM<MODE>(P0, P1, m_reg, MN, AL, relq + 64 * (J), relwmin + 64 * (J), relwmax + 64 * (J), lut)
  f32x16 pA0, pA1, pB0, pB1; float mnA, mnB, alA, alB; bf16x8 pa0, pa1, pa2, pa3;
  constexpr int SE = 0, SO = 1;
  SLOAD(SE, 0); asm volatile("s_waitcnt vmcnt(0)" ::: "memory"); SWRITE(0, SE); __syncthreads();
  qkt<ND0, DOFF>(pA0, pA1, K_lds, qr, r32, hi); PSM(pA0, pA1, mnA, alA, 0);
  SLOAD(SO, 64); if (2 < NT) SLOAD(SE, 2 * 64);
  SWAIT(); SWRITE(1, SO); __syncthreads();
  for (int j = 1; j + 1 < NT; j += 2) {
    SBAR(); qkt<ND0, DOFF>(pB0, pB1, K_lds + SHM_K, qr, r32, hi);
    finishSM(pA0, pA1, alA, l_reg, pa0, pa1, pa2, pa3); SBAR();
    SLOAD(SO, (j + 2) * 64); SBAR();
    pv_d0(o, vb0, pa0, pa1, pa2, pa3); PSM(pB0, pB1, mnB, alB, j);
    __syncthreads(); SWAIT(); SWRITE(0, SE);
    RESC(alB); __syncthreads();
    SBAR(); qkt<ND0, DOFF>(pA0, pA1, K_lds, qr, r32, hi);
    finishSM(pB0, pB1, alB, l_reg, pa0, pa1, pa2, pa3); SBAR();
    if (j + 3 < NT) SLOAD(SE, (j + 3) * 64); SBAR();
    pv_d0(o, vb0 + SHM_V, pa0, pa1, pa2, pa3); PSM(pA0, pA1, mnA, alA, j + 1);
    __syncthreads(); SWAIT(); SWRITE(1, SO);
    RESC(alA); __syncthreads();
  }
  SBAR(); qkt<ND0, DOFF>(pB0, pB1, K_lds + SHM_K, qr, r32, hi);
  finishSM(pA0, pA1, alA, l_reg, pa0, pa1, pa2, pa3); SBAR();
  pv_d0(o, vb0, pa0, pa1, pa2, pa3); PSM(pB0, pB1, mnB, alB, NT - 1);
  __syncthreads(); RESC(alB);
  finishSM(pB0, pB1, alB, l_reg, pa0, pa1, pa2, pa3); SBAR();
  pv_d0(o, vb0 + SHM_V, pa0, pa1, pa2, pa3);
  if constexpr (MODE == 1) l_reg += __builtin_amdgcn_exp2f(E.sinkl2 - m_reg);
  if (hi == 0) li_l[r32] = l_reg; asm volatile("s_waitcnt lgkmcnt(0)" ::: "memory");
  float rli[16];
#pragma unroll
  for (int r = 0; r < 16; ++r) rli[r] = __builtin_amdgcn_rcpf(li_l[crow(r, hi)]);
  float* pk0 = E.park; float* pk1 = E.park + 64 * 512;
  const int rowb = wid * 32;
  if constexpr (MODE == 0 || MODE == 1) {
#pragma unroll
    for (int r = 0; r < 16; ++r) { const int row = rowb + crow(r, hi);
#pragma unroll
      for (int d0 = 0; d0 < 4; ++d0) { const int idx = (d0 * 16 + r) * 512 + tid;
        const float g = bf2f(E.gate[(size_t)row * GW + d0 * 32 + r32]);
        const float v = o[d0][r] * rli[r] * g;
        if constexpr (MODE == 0) pk0[idx] = v; else pk0[idx] += v; } }
  } else if constexpr (MODE == 2) {
#pragma unroll
    for (int r = 0; r < 16; ++r)
#pragma unroll
      for (int d0 = 0; d0 < 4; ++d0) pk1[(d0 * 16 + r) * 512 + tid] = o[d0][r] * rli[r];
  } else {
    float gs[4];
#pragma unroll
    for (int d0 = 0; d0 < 4; ++d0) gs[d0] = E.gsub[d0 * 32 + r32] * E.oml;
#pragma unroll
    for (int r = 0; r < 16; ++r) { const int row = rowb + crow(r, hi);
      float ss = 0.f;
#pragma unroll
      for (int d0 = 0; d0 < 4; ++d0) { const float c = pk1[(d0 * 16 + r) * 512 + tid] - E.lam * (o[d0][r] * rli[r]); o[d0][r] = c; ss += c * c; }
      ss += __shfl_xor(ss, 1); ss += __shfl_xor(ss, 2); ss += __shfl_xor(ss, 4); ss += __shfl_xor(ss, 8); ss += __shfl_xor(ss, 16);
      const float rs = rsqrtf(ss * (1.f / 128.f) + EPS);
#pragma unroll
      for (int d0 = 0; d0 < 4; ++d0) { const int col = d0 * 32 + r32;
        const float g = bf2f(E.gate[(size_t)row * GW + col]);
        const float y = o[d0][r] * rs * gs[d0] * g + pk0[(d0 * 16 + r) * 512 + tid];
        E.merged[(size_t)row * DM + col] = (bf16_t)(cvtpk(y, y) & 0xffffu); } }
  }
#undef SLOAD
#undef SWRITE
#undef SWAIT
#undef RESC
#undef PSM
}

__device__ __forceinline__ int t5bucket(int rel) {
  const int n = rel < 0 ? -rel : rel;
  const int b = n < 8 ? n : 8 + (n >= 12) + (n >= 16) + (n >= 23) + (n >= 32) + (n >= 46) + (n >= 64) + (n >= 91);
  return b + (rel > 0 ? 16 : 0);
}
__device__ __forceinline__ float wave_sum(float v) {
  v += __shfl_xor(v, 1); v += __shfl_xor(v, 2); v += __shfl_xor(v, 4); v += __shfl_xor(v, 8); v += __shfl_xor(v, 16); v += __shfl_xor(v, 32); return v;
}

__device__ __forceinline__ void phase_setup(const Params& p, unsigned char* shm) {
  int tid_ = threadIdx.x; asm volatile("" : "+v"(tid_)); const int tid = tid_, nb = gridDim.x, bid = blockIdx.x, wid = tid >> 6, lane = tid & 63;
  {
    const float4* s0 = (const float4*)p.in[0]; const float4* s1 = (const float4*)p.in[1]; float4* o = (float4*)p.out;
    const size_t n4 = (size_t)16384 * 1024 / 4;
    for (size_t i = (size_t)bid * 512 + tid; i < 2 * n4; i += (size_t)nb * 512) o[i] = i < n4 ? s0[i] : s1[i - n4];
  }
  {
    float* rope = (float*)(p.ws + WS_ROPE);
    for (int i = bid * 512 + tid; i < 256 * 32; i += nb * 512) { const int pos = i >> 5, f = i & 31;
      const float inv = powf(10000.f, -(float)f / 32.f); const float ang = (float)pos * inv; rope[2 * i] = cosf(ang); rope[2 * i + 1] = sinf(ang); }
    float* lut = (float*)(p.ws + WS_LUT);
    for (int i = bid * 512 + tid; i < 16 * 259; i += nb * 512) { const int hh = i / 259, e = i % 259; int rel = e - 129; float v;
      if (hh < 8) { v = (rel < -128 || rel > 128) ? NEGBIG : p.in[23][t5bucket(rel) * 16 + hh] * LOG2E; }
      else { rel = rel < -128 ? -128 : (rel > 128 ? 128 : rel); v = p.in[23][t5bucket(rel) * 16 + hh] * LOG2E; }
      lut[i] = v; }
    if (bid == 0 && tid < 4) { const int l = tid; float s1 = 0.f, s2 = 0.f;
      for (int i = 0; i < 64; ++i) { s1 += p.in[18][l * 64 + i] * p.in[19][l * 64 + i]; s2 += p.in[20][l * 64 + i] * p.in[21][l * 64 + i]; }
      const float lam_init = 0.8f - 0.6f * expf(-0.3f * (float)l);
      float* lam = (float*)(p.ws + WS_LAM); lam[2 * l] = expf(s1) - expf(s2) + lam_init; lam[2 * l + 1] = 1.f - lam_init; }
  }
  {
    float* sc = (float*)shm; float* red = sc + 9 * 1024;
    for (int i = tid; i < 9 * 1024; i += 512) { const float c = i < 8192 ? p.in[2][i] : p.in[3][i - 8192]; sc[i] = c / (1.f + expf(-c)); }
    __syncthreads();
    float* mod = (float*)(p.ws + WS_MOD);
    for (int task = bid; task < 576; task += nb) {
      const int l = task / 144, j0 = (task % 144) * 64;
      const float* w = p.in[4] + (size_t)l * 1024 * 9216 + j0 + lane;
      float a0 = 0, a1 = 0, a2 = 0, a3 = 0, a4 = 0, a5 = 0, a6 = 0, a7 = 0, a8 = 0;
#pragma unroll 4
      for (int k = wid * 128; k < wid * 128 + 128; ++k) { const float wv = w[(size_t)k * 9216];
        a0 += sc[k] * wv; a1 += sc[1024 + k] * wv; a2 += sc[2048 + k] * wv; a3 += sc[3072 + k] * wv; a4 += sc[4096 + k] * wv;
        a5 += sc[5120 + k] * wv; a6 += sc[6144 + k] * wv; a7 += sc[7168 + k] * wv; a8 += sc[8192 + k] * wv; }
      float* rw = red + wid * 9 * 64 + lane;
      rw[0] = a0; rw[64] = a1; rw[128] = a2; rw[192] = a3; rw[256] = a4; rw[320] = a5; rw[384] = a6; rw[448] = a7; rw[512] = a8;
      __syncthreads();
      for (int i = tid; i < 9 * 64; i += 512) { const int b = i >> 6, ln = i & 63; float s = 0.f;
#pragma unroll
        for (int w8 = 0; w8 < 8; ++w8) s += red[w8 * 9 * 64 + b * 64 + ln];
        mod[((size_t)l * 9 + b) * 9216 + j0 + ln] = s + p.in[5][l * 9216 + j0 + ln]; }
      __syncthreads();
    }
  }
}

__device__ __forceinline__ void phase_convert(const Params& p, int l, unsigned char* shm) {
  float* tile = (float*)shm;
  int tid_ = threadIdx.x; asm volatile("" : "+v"(tid_)); const int tid = tid_;
  for (int q = blockIdx.x; q < 6400; q += gridDim.x) {
    const float* W; bf16_t* Bt; int N, K, k0, n0d, n0s;
    if (q < 2816) { const int i = q / 1408, qq = q % 1408; W = p.in[7] + (size_t)(l * 2 + i) * 1024 * 5632; Bt = (bf16_t*)(p.ws + (i ? WB_FFIN1 : WB_FFIN0)); N = 5632; K = 1024;
      k0 = (qq & 15) * 64; n0d = (qq >> 4) * 64; n0s = ((n0d >> 7) & 1) * 2816 + (n0d >> 8) * 128 + (n0d & 127); }
    else if (q < 4224) { const int i = (q - 2816) / 704, qq = (q - 2816) % 704; W = p.in[8] + (size_t)(l * 2 + i) * 2816 * 1024; Bt = (bf16_t*)(p.ws + (i ? WB_FFOUT1 : WB_FFOUT0)); N = 1024; K = 2816;
      k0 = (qq % 44) * 64; n0d = (qq / 44) * 64; n0s = n0d; }
    else if (q < 6144) { const int qq = q - 4224; W = p.in[9] + (size_t)l * 1024 * 7680; Bt = (bf16_t*)(p.ws + WB_WIN); N = 7680; K = 1024;
      k0 = (qq & 15) * 64; n0d = (qq >> 4) * 64; n0s = n0d; }
    else { const int qq = q - 6144; W = p.in[10] + (size_t)l * 1024 * 1024; Bt = (bf16_t*)(p.ws + WB_WO); N = 1024; K = 1024;
      k0 = (qq & 15) * 64; n0d = (qq >> 4) * 64; n0s = n0d; }
    { const int nl = tid & 63, ks = tid >> 6;
#pragma unroll
      for (int i = 0; i < 8; ++i) { const int k = ks + 8 * i; tile[nl * 65 + k] = W[(size_t)(k0 + k) * N + n0s + nl]; } }
    __syncthreads();
    { const int n = tid >> 3, kc = (tid & 7) * 8; const float* tr = tile + n * 65 + kc;
      u32x4 w; w.x = cvtpk(tr[0], tr[1]); w.y = cvtpk(tr[2], tr[3]); w.z = cvtpk(tr[4], tr[5]); w.w = cvtpk(tr[6], tr[7]);
      *(u32x4*)(Bt + (size_t)(n0d + n) * K + k0 + kc) = w; }
    __syncthreads();
  }
}

__device__ __forceinline__ void phase_norm(const float* __restrict__ x, const float* __restrict__ g, const float* __restrict__ modl, int jj, bf16_t* __restrict__ xn) {
  int tid_ = threadIdx.x; asm volatile("" : "+v"(tid_)); const int tid = tid_, wid = tid >> 6, lane = tid & 63;
  for (int row = blockIdx.x * 8 + wid; row < T_TOK; row += gridDim.x * 8) {
    const int bi = row < 16384 ? (row >> 11) : 8;
    const float* shift = modl + (size_t)bi * 9216 + (3 * jj) * 1024; const float* scale = shift + 1024;
    const float4* xr = (const float4*)(x + (size_t)row * DM);
    float4 v[4]; float ss = 0.f;
#pragma unroll
    for (int i = 0; i < 4; ++i) { v[i] = xr[lane + 64 * i]; ss += v[i].x * v[i].x + v[i].y * v[i].y + v[i].z * v[i].z + v[i].w * v[i].w; }
    ss = wave_sum(ss);
    const float rs = rsqrtf(ss * (1.f / 1024.f) + EPS);
#pragma unroll
    for (int i = 0; i < 4; ++i) { const int c4 = lane + 64 * i;
      const float4 gg = ((const float4*)g)[c4], sc = ((const float4*)scale)[c4], sh = ((const float4*)shift)[c4];
      const float y0 = v[i].x * rs * gg.x * (1.f + sc.x) + sh.x, y1 = v[i].y * rs * gg.y * (1.f + sc.y) + sh.y;
      const float y2 = v[i].z * rs * gg.z * (1.f + sc.z) + sh.z, y3 = v[i].w * rs * gg.w * (1.f + sc.w) + sh.w;
      u32x2 w; w.x = cvtpk(y0, y1); w.y = cvtpk(y2, y3);
      *(u32x2*)(xn + (size_t)row * DM + c4 * 4) = w; }
  }
}

__device__ __forceinline__ void phase_qknorm(const Params& p, int l) {
  bf16_t* qkv = (bf16_t*)(p.ws + WS_QKV); const float* rope = (const float*)(p.ws + WS_ROPE);
  int tid_ = threadIdx.x; asm volatile("" : "+v"(tid_)); const int tid = tid_, wid = tid >> 6, lane = tid & 63;
  f32x2 gq[3], gk[3];
  gq[0] = *(const f32x2*)(p.in[11] + l * 128 + 2 * lane); gk[0] = *(const f32x2*)(p.in[12] + l * 128 + 2 * lane);
  gq[1] = *(const f32x2*)(p.in[13] + l * 128 + 2 * lane); gk[1] = *(const f32x2*)(p.in[14] + l * 128 + 2 * lane);
  gq[2] = *(const f32x2*)(p.in[15] + l * 64 + ((2 * lane) & 63)); gk[2] = *(const f32x2*)(p.in[16] + l * 64 + ((2 * lane) & 63));
  const float sg = (lane & 16) ? 1.f : -1.f;
  for (int tok = blockIdx.x * 8 + wid; tok < T_TOK; tok += gridDim.x * 8) {
    unsigned* base = (unsigned*)(qkv + (size_t)tok * QKVW) + lane;
    unsigned u[30];
#pragma unroll
    for (int s = 0; s < 30; ++s) u[s] = base[((s / 10) * 1536 + (s % 10) * 128) / 2];
    const int sp = tok < 16384 ? (tok & 2047) : (tok - 16384);
    const int pos = lane < 32 ? (sp >> 6) : (sp & 63);
    const f32x4 cs = *(const f32x4*)(rope + (size_t)(pos * 32 + ((2 * lane) & 31)) * 2);
#pragma unroll
    for (int s = 0; s < 30; ++s) {
      const int br = s / 10, hs = s % 10;
      float a = bf_lo(u[s]), b = bf_hi(u[s]);
      float ss = a * a + b * b;
      ss += __shfl_xor(ss, 1); ss += __shfl_xor(ss, 2); ss += __shfl_xor(ss, 4); ss += __shfl_xor(ss, 8); ss += __shfl_xor(ss, 16);
      float rs;
      if (br < 2) { ss += __shfl_xor(ss, 32); rs = rsqrtf(ss * (1.f / 128.f) + EPS); }
      else rs = rsqrtf(ss * (1.f / 64.f) + EPS);
      const f32x2 g = hs < 8 ? gq[br] : gk[br];
      a = a * rs * g[0]; b = b * rs * g[1];
      if (br == 0) {
        const float pa = __shfl_xor(a, 16), pb = __shfl_xor(b, 16);
        a = a * cs[0] + sg * pa * cs[1]; b = b * cs[2] + sg * pb * cs[3];
      }
      base[(br * 1536 + hs * 128) / 2] = cvtpk(a, b);
    }
  }
}

__device__ __forceinline__ void phase_attn(const Params& p, int l, unsigned char* shm) {
  const bf16_t* qkv = (const bf16_t*)(p.ws + WS_QKV); const bf16_t* gates = (const bf16_t*)(p.ws + WS_GATES);
  bf16_t* merged = (bf16_t*)(p.ws + WS_XN);
  const float* lutall = (const float*)(p.ws + WS_LUT); const float* lamp = (const float*)(p.ws + WS_LAM);
  AttnEpi E; E.park = (float*)(p.ws + WS_PARK) + (size_t)blockIdx.x * 65536; E.gsub = p.in[22] + l * 128; E.lam = lamp[2 * l]; E.oml = lamp[2 * l + 1];
  for (int it = blockIdx.x; it < 1024; it += gridDim.x) {
    int S, tok0, h, qb;
    if (it < 512) { S = 16384; tok0 = 16384; h = it & 7; qb = it >> 3; }
    else { const int j = it - 512; S = 2048; h = j & 7; qb = (j >> 3) & 7; tok0 = (j >> 6) * 2048; }
    const int g = h >> 2, q0 = qb * 256;
    const bf16_t* rowQ = qkv + (size_t)(tok0 + q0) * QKVW; const bf16_t* seqK = qkv + (size_t)tok0 * QKVW;
    const bf16_t* grow = gates + (size_t)(tok0 + q0) * GW + h * 128;
    E.merged = merged + (size_t)(tok0 + q0) * DM + h * 128; E.sinkl2 = p.in[17][l * 8 + h] * LOG2E;
    E.gate = grow;
    attn_body<0>(rowQ + h * 128, seqK + 1024 + g * 128, seqK + 1280 + g * 128, S / 64, 0, (char*)shm, lutall, E);
    { const int t_lo = max(0, 4 * qb - 2), t_hi = min(S / 64, 4 * qb + 6);
      const bf16_t* kb = seqK + (size_t)t_lo * 64 * QKVW;
      E.gate = grow + 1024;
      attn_body<1>(rowQ + 1536 + h * 128, kb + 2560 + g * 128, kb + 2816 + g * 128, t_hi - t_lo, t_lo * 64 - q0, (char*)shm, lutall + h * 259, E); }
    E.gate = grow + 2048;
    attn_body<2>(rowQ + 3072 + h * 128, seqK + 4096 + g * 128, seqK + 4352 + g * 128, S / 64, -q0, (char*)shm, lutall + (8 + h) * 259, E);
    attn_body<3>(rowQ + 3072 + h * 128 + 64, seqK + 4096 + g * 128, seqK + 4352 + g * 128, S / 64, -q0, (char*)shm, lutall + (8 + h) * 259, E);
  }
}

__device__ __forceinline__ void gsync(cg::grid_group& g) {
  asm volatile("s_waitcnt vmcnt(0) lgkmcnt(0)" ::: "memory");
  __syncthreads();
  if (threadIdx.x == 0) { __builtin_amdgcn_fence(__ATOMIC_RELEASE, "agent"); asm volatile("s_waitcnt vmcnt(0)" ::: "memory"); }
  g.sync();
  __builtin_amdgcn_fence(__ATOMIC_ACQUIRE, "agent");
  asm volatile("s_waitcnt vmcnt(0)" ::: "memory");
}
constexpr int N_PHASES = 45;
__global__ void __launch_bounds__(512) mega_fwd(Params p, int ph_lo, int ph_hi) {
  extern __shared__ __attribute__((aligned(16))) unsigned char shm[];
  cg::grid_group grid = cg::this_grid();
  LAS unsigned char* lds3 = (LAS unsigned char*)shm;
  float* X = p.out;
  bf16_t* XN = (bf16_t*)(p.ws + WS_XN); bf16_t* Hb = (bf16_t*)(p.ws + WS_QKV);
  pg8::StaticOrder S;
#pragma unroll 1
  for (int ph = ph_lo; ph < ph_hi; ++ph) {
    if (ph == 0) { phase_setup(p, shm); }
    else {
      const int l = (ph - 1) / 11, k = (ph - 1) % 11;
      const float* modl = (const float*)(p.ws + WS_MOD) + (size_t)l * 9 * 9216;
      if (k == 0 || k == 3 || k == 8) {
        if (k == 0) phase_convert(p, l, shm);
        const int jj = k == 0 ? 0 : (k == 3 ? 1 : 2);
        phase_norm(X, p.in[6] + (size_t)(l * 3 + jj) * 1024, modl, jj, XN);
      } else if (k == 1 || k == 9) {
        pg8::Gemm g{XN, (const bf16_t*)(p.ws + (k == 9 ? WB_FFIN1 : WB_FFIN0)), T_TOK, NFF2, DM};
        S.init(T_TOK, NFF2, gridDim.x, blockIdx.x); pg8::EpiSwiGLU E{Hb}; pg8::gemm_phase(lds3, g, S, E);
      } else if (k == 2 || k == 10 || k == 7) {
        const bool wo = (k == 7);
        pg8::Gemm g{wo ? XN : Hb, (const bf16_t*)(p.ws + (wo ? WB_WO : (k == 10 ? WB_FFOUT1 : WB_FFOUT0))), T_TOK, DM, wo ? DM : DFF};
        S.init(T_TOK, DM, gridDim.x, blockIdx.x); pg8::EpiResid E{X, modl + (wo ? 5 : (k == 10 ? 8 : 2)) * 1024, wo ? 1.0f : 0.5f}; pg8::gemm_phase(lds3, g, S, E);
      } else if (k == 4) {
        pg8::Gemm g{XN, (const bf16_t*)(p.ws + WB_WIN), T_TOK, WINC, DM};
        S.init(T_TOK, WINC, gridDim.x, blockIdx.x); pg8::EpiQKV E{(bf16_t*)(p.ws + WS_QKV), (bf16_t*)(p.ws + WS_GATES)}; pg8::gemm_phase(lds3, g, S, E);
      } else if (k == 5) { phase_qknorm(p, l); }
      else { phase_attn(p, l, shm); }
    }
    if (ph + 1 < ph_hi) gsync(grid);
  }
}

#ifndef N_LAUNCH_MODE
#define N_LAUNCH_MODE 1
#endif
extern "C" void kernel_launch(void* const* d_in, const int* in_sizes, int n_in, void* d_out, int out_size, void* d_ws, size_t ws_size, hipStream_t stream) {
  static int grid = 0;
  if (grid == 0) {
    if (n_in != 24 || out_size != T_TOK * DM || ws_size < WS_END) { fprintf(stderr, "kernel_launch: unexpected shapes (n_in %d out %d ws %zu need %zu)\n", n_in, out_size, ws_size, (size_t)WS_END); grid = -1; return; }
    int dev = 0, cus = 0, per_cu = 0;
    (void)hipGetDevice(&dev); (void)hipDeviceGetAttribute(&cus, hipDeviceAttributeMultiprocessorCount, dev);
    if (hipFuncSetAttribute((const void*)mega_fwd, hipFuncAttributeMaxDynamicSharedMemorySize, LDS_BYTES) != hipSuccess) { fprintf(stderr, "kernel_launch: hipFuncSetAttribute failed\n"); grid = -1; return; }
    if (hipOccupancyMaxActiveBlocksPerMultiprocessor(&per_cu, (const void*)mega_fwd, 512, LDS_BYTES) != hipSuccess || per_cu < 1) { fprintf(stderr, "kernel_launch: occupancy query gave %d\n", per_cu); per_cu = 1; }
    (void)hipGetLastError();
    grid = cus;
  }
  if (grid < 0) return;
  Params p{};
  for (int i = 0; i < 24; ++i) p.in[i] = (const float*)d_in[i];
  p.out = (float*)d_out; p.ws = (unsigned char*)d_ws;
#if N_LAUNCH_MODE == 1
  int lo = 0, hi = N_PHASES;
  void* args[] = {&p, &lo, &hi};
  hipError_t e = hipLaunchCooperativeKernel((const void*)mega_fwd, dim3(grid), dim3(512), args, LDS_BYTES, stream);
  if (e != hipSuccess) fprintf(stderr, "kernel_launch: cooperative launch failed: %s (grid %d)\n", hipGetErrorString(e), grid);
#else
  for (int ph = 0; ph < N_PHASES; ++ph) hipLaunchKernelGGL(mega_fwd, dim3(grid), dim3(512), LDS_BYTES, stream, p, ph, ph + 1);
#endif
}
```

```cpp
#include <hip/hip_runtime.h>
#include <hip/hip_bf16.h>
#include <hip/hip_cooperative_groups.h>
#include <cstdio>
#include <cstdint>
#define N_LAUNCH_MODE 1
namespace cg = cooperative_groups;

typedef unsigned short bf16_t;
typedef short bf16x8 __attribute__((ext_vector_type(8)));
typedef short s16x4 __attribute__((ext_vector_type(4)));
typedef float f32x4 __attribute__((ext_vector_type(4)));
typedef float f32x16 __attribute__((ext_vector_type(16)));
typedef unsigned u32x4 __attribute__((ext_vector_type(4)));
typedef unsigned u32x2 __attribute__((ext_vector_type(2)));
#define LAS __attribute__((address_space(3)))

constexpr int T_TOK = 32768, DM = 1024, DFF = 2816, NFF2 = 5632, WINC = 7680, QKVW = 4608, GW = 3072;
constexpr float EPS = 1e-6f, LOG2E = 1.4426950408889634f, NEGBIG = -1e30f;
constexpr size_t WB_FFIN0 = 0, WB_FFIN1 = 11534336, WB_FFOUT0 = 23068672, WB_FFOUT1 = 28835840, WB_WIN = 34603008, WB_WO = 50331648;
constexpr size_t WS_MOD = 52428800, WS_ROPE = 53755904, WS_LUT = 53821440, WS_LAM = 53854208, WS_XN = 53854464;
constexpr size_t WS_QKV = WS_XN + 67108864, WS_GATES = WS_QKV + 301989888, WS_PARK = WS_GATES + 201326592, WS_END = WS_PARK + 67108864;
constexpr int LDS_BYTES = 131072;

struct Params { const float* in[24]; float* out; unsigned char* ws; };

typedef __bf16 bf16v2 __attribute__((ext_vector_type(2)));
typedef float f32x2 __attribute__((ext_vector_type(2)));
__device__ __forceinline__ unsigned cvtpk(float lo, float hi) { f32x2 v = {lo, hi}; bf16v2 b = __builtin_convertvector(v, bf16v2); return __builtin_bit_cast(unsigned, b); }
__device__ __forceinline__ float bf_lo(unsigned u) { return __uint_as_float(u << 16); }
__device__ __forceinline__ float bf_hi(unsigned u) { return __uint_as_float(u & 0xffff0000u); }
__device__ __forceinline__ float bf2f(bf16_t v) { return __uint_as_float(((unsigned)v) << 16); }

namespace pg8 {
constexpr int BM = 256, BK = 64, HALF = 128, HTB = HALF * BK * 2, STAGE_BYTES = 8 * HTB, NXCD = 8, WGM = 8;
__device__ __forceinline__ int lds_byte(int r, int c) { const int st = (r >> 4) * 2 + (c >> 5), rr = r & 15, cc = c & 31, ob = rr * 64 + cc * 2; return st * 1024 + (ob ^ (((ob >> 9) & 1) << 5)); }
__device__ __forceinline__ void stage_rc(int b, int& R, int& C) { const int st = b / 1024, sb = b % 1024, swz = sb ^ (((sb >> 9) & 1) << 5); R = (st >> 1) * 16 + swz / 64; C = (st & 1) * 32 + (swz % 64) / 2; }
__device__ __forceinline__ int perm32(int rho) { const int n = rho >> 4, i = rho & 15; return 8 * (i >> 2) + 4 * n + (i & 3); }
struct Unit { int pm, pn; };
struct Gemm { const bf16_t* A; const bf16_t* Bt; int M, N, K; };
struct StaticOrder {
    int nM, nN, nwg, G, c;
    __device__ void init(int M, int N, int G_, int c_) { nM = M / BM; nN = N / BM; nwg = nM * nN; G = G_; c = c_; }
    __device__ bool next(int i, Unit& u) const {
        const long L = (long)i * G + c; if (L >= nwg) return false;
        int wgid = (int)L; { const int q = nwg / NXCD, r = nwg % NXCD, xcd = wgid % NXCD, off = wgid / NXCD; wgid = (xcd < r ? xcd * (q + 1) : r * (q + 1) + (xcd - r) * q) + off; }
        const int nig = WGM * nN, gid = wgid / nig, fm = gid * WGM, gsz = (nM - fm) < WGM ? (nM - fm) : WGM;
        u.pm = fm + ((wgid % nig) % gsz); u.pn = (wgid % nig) / gsz; return true;
    }
};

template <class Epi>
__device__ __forceinline__ void gemm_phase(LAS unsigned char* lds, const Gemm g, const StaticOrder& S, const Epi& E) {
    int tid_ = threadIdx.x; asm volatile("" : "+v"(tid_));
    const int tid = tid_, wid = __builtin_amdgcn_readfirstlane(tid >> 6), lane = tid & 63, wr = wid >> 2, wc = wid & 3, fr = lane & 15, fq = lane >> 4;
    const int K = g.K, nt = K / BK;
    unsigned voffA[2], voffB[2];
#pragma unroll
    for (int i = 0; i < 2; ++i) { int R, C; stage_rc(tid * 16 + i * 8192, R, C); const int Rb = Epi::PERM ? ((R & ~31) + perm32(R & 31)) : R;
        voffA[i] = (unsigned)(R * K + C) * 2u; voffB[i] = (unsigned)(Rb * K + C) * 2u; }
    const size_t kstep = (size_t)(BK * 2);
    const size_t hstep = (size_t)HALF * K * 2;
    const size_t tstep = 2 * hstep;
    const unsigned ldsw = (unsigned)wid * 1024u;
    const int aoff = lds_byte(wr * 64 + fr, fq * 8), boff = lds_byte(wc * 32 + fr, fq * 8);
#define PG8_SA(b, h) (((b) * 2 + (h)) * HTB)
#define PG8_SB(b, h) ((4 + (b) * 2 + (h)) * HTB)
#define PG8_STAGE(bufoff, gbase, voff) do { _Pragma("unroll") for (int _i = 0; _i < 2; ++_i) \
        __builtin_amdgcn_global_load_lds((const unsigned*)((const char*)(gbase) + (voff)[_i]), (LAS unsigned*)(lds + (bufoff) + ldsw + _i * 8192), 16, 0, 0); } while (0)
#define PG8_LDA(dst, b, h) do { _Pragma("unroll") for (int m = 0; m < 4; ++m) _Pragma("unroll") for (int k = 0; k < 2; ++k) dst[m][k] = *(const LAS bf16x8*)(lds + PG8_SA(b, h) + aoff + m * 2048 + k * 1024); } while (0)
#define PG8_LDB(dst, b, h) do { _Pragma("unroll") for (int n = 0; n < 2; ++n) _Pragma("unroll") for (int k = 0; k < 2; ++k) dst[n][k] = *(const LAS bf16x8*)(lds + PG8_SB(b, h) + boff + n * 2048 + k * 1024); } while (0)
#define PG8_MMA(ai, bj, At, Bt) do { __builtin_amdgcn_s_setprio(1); _Pragma("unroll") for (int m = 0; m < 4; ++m) _Pragma("unroll") for (int n = 0; n < 2; ++n) _Pragma("unroll") for (int k = 0; k < 2; ++k) \
        acc[ai][bj][m][n] = __builtin_amdgcn_mfma_f32_16x16x32_bf16(Bt[n][k], At[m][k], acc[ai][bj][m][n], 0, 0, 0); __builtin_amdgcn_s_setprio(0); } while (0)
#define PG8_WAIT_V(n) asm volatile("s_waitcnt vmcnt(" #n ")" ::: "memory")
#define PG8_WAIT_L(n) asm volatile("s_waitcnt lgkmcnt(" #n ")" ::: "memory")
#define PG8_BAR __builtin_amdgcn_s_barrier()
#define PG8_SCHED __builtin_amdgcn_sched_barrier(0)
    Unit cur, nxt; int ui = 0;
    if (!S.next(0, cur)) return;
    f32x4 acc[2][2][4][2];
#pragma unroll
    for (int a = 0; a < 2; ++a)
#pragma unroll
        for (int b = 0; b < 2; ++b)
#pragma unroll
            for (int m = 0; m < 4; ++m)
#pragma unroll
                for (int n = 0; n < 2; ++n) acc[a][b][m][n] = (f32x4){0.f, 0.f, 0.f, 0.f};
    bf16x8 At[4][2], B0[2][2], B1[2][2];
    const char* cA = (const char*)g.A + (size_t)cur.pm * tstep; const char* cB = (const char*)g.Bt + (size_t)cur.pn * tstep;
    PG8_STAGE(PG8_SB(0, 0), cB, voffB); PG8_STAGE(PG8_SA(0, 0), cA, voffA); PG8_STAGE(PG8_SB(0, 1), cB + hstep, voffB); PG8_STAGE(PG8_SA(0, 1), cA + hstep, voffA);
    if (wr == 1) PG8_BAR;
    PG8_WAIT_V(4); PG8_BAR;
    PG8_STAGE(PG8_SB(1, 0), cB + kstep, voffB); PG8_STAGE(PG8_SA(1, 0), cA + kstep, voffA); PG8_STAGE(PG8_SB(1, 1), cB + hstep + kstep, voffB);
    PG8_WAIT_V(6); PG8_BAR;
    for (;;) {
        const bool has_next = S.next(ui + 1, nxt);
        const char* nA = has_next ? (const char*)g.A + (size_t)nxt.pm * tstep : cA; const char* nB = has_next ? (const char*)g.Bt + (size_t)nxt.pn * tstep : cB;
        for (int t = 0; t < nt; t += 2) {
            const bool last = (t == nt - 2);
            const char* a1 = cA + (size_t)(t + 1) * kstep;
            const char* a2 = last ? nA : cA + (size_t)(t + 2) * kstep; const char* b2 = last ? nB : cB + (size_t)(t + 2) * kstep;
            const char* a3 = a2 + kstep; const char* b3 = b2 + kstep;
            PG8_LDB(B0, 0, 0); PG8_SCHED; PG8_LDA(At, 0, 0); PG8_STAGE(PG8_SA(1, 1), a1 + hstep, voffA);
            PG8_WAIT_L(8); PG8_BAR; PG8_WAIT_L(0); PG8_MMA(0, 0, At, B0); PG8_BAR; PG8_SCHED;
            PG8_LDB(B1, 0, 1); PG8_STAGE(PG8_SB(0, 0), b2, voffB);
            PG8_BAR; PG8_WAIT_L(0); PG8_MMA(0, 1, At, B1); PG8_BAR;
            PG8_LDA(At, 0, 1); PG8_STAGE(PG8_SA(0, 0), a2, voffA);
            PG8_BAR; PG8_WAIT_L(0); PG8_MMA(1, 0, At, B0); PG8_BAR; PG8_SCHED;
            PG8_STAGE(PG8_SB(0, 1), b2 + hstep, voffB);
            PG8_WAIT_V(6); PG8_BAR; PG8_MMA(1, 1, At, B1); PG8_BAR;
            PG8_LDB(B0, 1, 0); PG8_SCHED; PG8_LDA(At, 1, 0); PG8_STAGE(PG8_SA(0, 1), a2 + hstep, voffA);
            PG8_WAIT_L(8); PG8_BAR; PG8_WAIT_L(0); PG8_MMA(0, 0, At, B0); PG8_BAR; PG8_SCHED;
            PG8_LDB(B1, 1, 1); PG8_STAGE(PG8_SB(1, 0), b3, voffB);
            PG8_BAR; PG8_WAIT_L(0); PG8_MMA(0, 1, At, B1); PG8_BAR;
            PG8_LDA(At, 1, 1); PG8_STAGE(PG8_SA(1, 0), a3, voffA);
            PG8_BAR; PG8_WAIT_L(0); PG8_MMA(1, 0, At, B0); PG8_BAR; PG8_SCHED;
            PG8_STAGE(PG8_SB(1, 1), b3 + hstep, voffB);
            PG8_WAIT_V(6); PG8_BAR; PG8_MMA(1, 1, At, B1); PG8_BAR;
        }
        E(acc, cur, wr, wc, fr, fq);
        if (!has_next) break;
#pragma unroll
        for (int a = 0; a < 2; ++a)
#pragma unroll
            for (int b = 0; b < 2; ++b)
#pragma unroll
                for (int m = 0; m < 4; ++m)
#pragma unroll
                    for (int n = 0; n < 2; ++n) acc[a][b][m][n] = (f32x4){0.f, 0.f, 0.f, 0.f};
        cur = nxt; cA = nA; cB = nB; ++ui;
    }
    PG8_WAIT_V(0);
    if (wr == 0) PG8_BAR;
    PG8_BAR;
#undef PG8_SA
#undef PG8_SB
#undef PG8_STAGE
#undef PG8_LDA
#undef PG8_LDB
#undef PG8_MMA
#undef PG8_WAIT_V
#undef PG8_WAIT_L
#undef PG8_BAR
#undef PG8_SCHED
}

__device__ __forceinline__ float silu_f(float g) { return g * __builtin_amdgcn_rcpf(1.f + __expf(-g)); }
__device__ __forceinline__ float sigm_f(float g) { return __builtin_amdgcn_rcpf(1.f + __expf(-g)); }
struct EpiSwiGLU {
    static constexpr bool PERM = true;
    bf16_t* H;
    __device__ __forceinline__ void operator()(const f32x4 (&acc)[2][2][4][2], const Unit& u, int wr, int wc, int fr, int fq) const {
        const int row0 = u.pm * BM + wr * 64 + fr, col0 = u.pn * 128 + wc * 32 + 8 * fq;
#pragma unroll
        for (int ai = 0; ai < 2; ++ai)
#pragma unroll
            for (int m = 0; m < 4; ++m) { bf16_t* rowp = H + (size_t)(row0 + ai * HALF + m * 16) * DFF + col0;
                const f32x4 g0 = acc[ai][0][m][0], g1 = acc[ai][0][m][1], u0 = acc[ai][1][m][0], u1 = acc[ai][1][m][1];
                u32x4 w; w.x = cvtpk(silu_f(g0[0]) * u0[0], silu_f(g0[1]) * u0[1]); w.y = cvtpk(silu_f(g0[2]) * u0[2], silu_f(g0[3]) * u0[3]);
                w.z = cvtpk(silu_f(g1[0]) * u1[0], silu_f(g1[1]) * u1[1]); w.w = cvtpk(silu_f(g1[2]) * u1[2], silu_f(g1[3]) * u1[3]);
                *(u32x4*)rowp = w; }
    }
};
struct EpiResid {
    static constexpr bool PERM = false;
    float* X; const float* modg; float gs;
    __device__ __forceinline__ void operator()(const f32x4 (&acc)[2][2][4][2], const Unit& u, int wr, int wc, int fr, int fq) const {
        const int row0 = u.pm * BM + wr * 64 + fr, col0 = u.pn * BM + wc * 32 + 4 * fq;
        const int bi = u.pm < 64 ? (u.pm >> 3) : 8;
        const float* mg = modg + (size_t)bi * 9216 + col0;
        f32x4 gv[2][2];
#pragma unroll
        for (int bj = 0; bj < 2; ++bj)
#pragma unroll
            for (int n = 0; n < 2; ++n) gv[bj][n] = *(const f32x4*)(mg + bj * HALF + n * 16) * gs;
#pragma unroll
        for (int ai = 0; ai < 2; ++ai)
#pragma unroll
            for (int m = 0; m < 4; ++m) { float* rowp = X + (size_t)(row0 + ai * HALF + m * 16) * DM + col0;
#pragma unroll
                for (int bj = 0; bj < 2; ++bj)
#pragma unroll
                    for (int n = 0; n < 2; ++n) { f32x4* q = (f32x4*)(rowp + bj * HALF + n * 16); *q = *q + gv[bj][n] * acc[ai][bj][m][n]; } }
    }
};
struct EpiQKV {
    static constexpr bool PERM = true;
    bf16_t* QKV; bf16_t* GATES;
    __device__ __forceinline__ void operator()(const f32x4 (&acc)[2][2][4][2], const Unit& u, int wr, int wc, int fr, int fq) const {
        const int row0 = u.pm * BM + wr * 64 + fr;
        if (u.pn < 18) {
            const int col0 = u.pn * BM + wc * 32 + 8 * fq;
#pragma unroll
            for (int ai = 0; ai < 2; ++ai)
#pragma unroll
                for (int m = 0; m < 4; ++m) { bf16_t* rowp = QKV + (size_t)(row0 + ai * HALF + m * 16) * QKVW + col0;
#pragma unroll
                    for (int bj = 0; bj < 2; ++bj) { const f32x4 v0 = acc[ai][bj][m][0], v1 = acc[ai][bj][m][1];
                        u32x4 w; w.x = cvtpk(v0[0], v0[1]); w.y = cvtpk(v0[2], v0[3]); w.z = cvtpk(v1[0], v1[1]); w.w = cvtpk(v1[2], v1[3]);
                        *(u32x4*)(rowp + bj * HALF) = w; } }
        } else {
            const int col0 = (u.pn - 18) * BM + wc * 32 + 8 * fq;
#pragma unroll
            for (int ai = 0; ai < 2; ++ai)
#pragma unroll
                for (int m = 0; m < 4; ++m) { bf16_t* rowp = GATES + (size_t)(row0 + ai * HALF + m * 16) * GW + col0;
#pragma unroll
                    for (int bj = 0; bj < 2; ++bj) { const f32x4 v0 = acc[ai][bj][m][0], v1 = acc[ai][bj][m][1];
                        u32x4 w; w.x = cvtpk(sigm_f(v0[0]), sigm_f(v0[1])); w.y = cvtpk(sigm_f(v0[2]), sigm_f(v0[3])); w.z = cvtpk(sigm_f(v1[0]), sigm_f(v1[1])); w.w = cvtpk(sigm_f(v1[2]), sigm_f(v1[3]));
                        *(u32x4*)(rowp + bj * HALF) = w; } }
        }
    }
};
}

constexpr int LDQK = QKVW;
constexpr int SHM_V = 64 * 128 * 2, SHM_K = 64 * 128 * 2;
constexpr int ATT_WS_OFF = 2 * SHM_V + 2 * SHM_K, ATT_LUT_OFF = ATT_WS_OFF + 8 * 64 * 4;
#define KSWZ(row, colB) ((row) * 256 + ((colB) ^ (((row) & 7) << 4)))
#define SBAR() __builtin_amdgcn_sched_barrier(0)
__device__ __forceinline__ int crow(int r, int hi) { return (r & 3) + 8 * (r >> 2) + 4 * hi; }

template <int MODE>
__device__ __forceinline__ void partialSM(f32x16& p0, f32x16& p1, float& m_reg, float& mn, float& alpha, int relh, int relw_min, int relw_max, const float* lut) {
  if constexpr (MODE == 0) {
    constexpr float SCALE = 0.088388347648318440f, C = SCALE * LOG2E, THR = 8.f;
    float pmax = p0[0];
#pragma unroll
    for (int r = 1; r < 16; ++r) pmax = fmaxf(pmax, p0[r]);
#pragma unroll
    for (int r = 0; r < 16; ++r) pmax = fmaxf(pmax, p1[r]);
    { auto rr = __builtin_amdgcn_permlane32_swap(__float_as_uint(pmax), __float_as_uint(pmax), false, false);
      pmax = fmaxf(__uint_as_float(rr[0]), __uint_as_float(rr[1])); }
    if (__builtin_expect(__all(pmax - m_reg <= THR / SCALE), 1)) { mn = m_reg; alpha = 1.f; }
    else { mn = fmaxf(m_reg, pmax); alpha = __builtin_amdgcn_exp2f((m_reg - mn) * C); m_reg = mn; }
    const float mnC = -mn * C;
#pragma unroll
    for (int r = 0; r < 16; ++r) p0[r] = fmaf(p0[r], C, mnC);
#pragma unroll
    for (int r = 0; r < 16; ++r) p1[r] = fmaf(p1[r], C, mnC);
#pragma unroll
    for (int r = 0; r < 16; ++r) p0[r] = __builtin_amdgcn_exp2f(p0[r]);
  } else {
    constexpr float C = (MODE == 1 ? 0.088388347648318440f : 0.125f) * LOG2E, THR2 = 8.f * LOG2E;
    bool nearT = true; float cfar = 0.f;
    if constexpr (MODE >= 2) {
      if (relw_max <= -128) { nearT = false; cfar = lut[0]; }
      else if (relw_min >= 128) { nearT = false; cfar = lut[258]; }
      if (!nearT) {
        float pmax = p0[0];
#pragma unroll
        for (int r = 1; r < 16; ++r) pmax = fmaxf(pmax, p0[r]);
#pragma unroll
        for (int r = 0; r < 16; ++r) pmax = fmaxf(pmax, p1[r]);
        { auto rr = __builtin_amdgcn_permlane32_swap(__float_as_uint(pmax), __float_as_uint(pmax), false, false);
          pmax = fmaxf(__uint_as_float(rr[0]), __uint_as_float(rr[1])); }
        const float tmax = fmaf(pmax, C, cfar);
        if (__builtin_expect(__all(tmax - m_reg <= THR2), 1)) { mn = m_reg; alpha = 1.f; }
        else { mn = fmaxf(m_reg, tmax); alpha = __builtin_amdgcn_exp2f(m_reg - mn); m_reg = mn; }
        const float off = cfar - mn;
#pragma unroll
        for (int r = 0; r < 16; ++r) p0[r] = fmaf(p0[r], C, off);
#pragma unroll
        for (int r = 0; r < 16; ++r) p1[r] = fmaf(p1[r], C, off);
#pragma unroll
        for (int r = 0; r < 16; ++r) p0[r] = __builtin_amdgcn_exp2f(p0[r]);
        return;
      }
    }
    if (nearT) {
#pragma unroll
      for (int r = 0; r < 16; ++r) { const int i0 = relh + (r & 3) + 8 * (r >> 2);
        const int a0 = min(max(i0, -129), 129) + 129, a1 = min(max(i0 + 32, -129), 129) + 129;
        p0[r] = fmaf(p0[r], C, lut[a0]); p1[r] = fmaf(p1[r], C, lut[a1]); }
    } else {
#pragma unroll
      for (int r = 0; r < 16; ++r) { p0[r] = fmaf(p0[r], C, cfar); p1[r] = fmaf(p1[r], C, cfar); }
    }
    float pmax = p0[0];
#pragma unroll
    for (int r = 1; r < 16; ++r) pmax = fmaxf(pmax, p0[r]);
#pragma unroll
    for (int r = 0; r < 16; ++r) pmax = fmaxf(pmax, p1[r]);
    { auto rr = __builtin_amdgcn_permlane32_swap(__float_as_uint(pmax), __float_as_uint(pmax), false, false);
      pmax = fmaxf(__uint_as_float(rr[0]), __uint_as_float(rr[1])); }
    if (__builtin_expect(__all(pmax - m_reg <= THR2), 1)) { mn = m_reg; alpha = 1.f; }
    else { mn = fmaxf(m_reg, pmax); alpha = __builtin_amdgcn_exp2f(m_reg - mn); m_reg = mn; }
#pragma unroll
    for (int r = 0; r < 16; ++r) p0[r] = __builtin_amdgcn_exp2f(p0[r] - mn);
#pragma unroll
    for (int r = 0; r < 16; ++r) p1[r] = p1[r] - mn;
  }
}
__device__ __forceinline__ void finishSM(f32x16& p0, f32x16& p1, float alpha, float& l_reg, bf16x8& pa0, bf16x8& pa1, bf16x8& pa2, bf16x8& pa3) {
#pragma unroll
  for (int r = 0; r < 16; ++r) p1[r] = __builtin_amdgcn_exp2f(p1[r]);
  float ps = 0;
#pragma unroll
  for (int r = 0; r < 16; ++r) ps += p0[r];
#pragma unroll
  for (int r = 0; r < 16; ++r) ps += p1[r];
  { auto rr = __builtin_amdgcn_permlane32_swap(__float_as_uint(ps), __float_as_uint(ps), false, false);
    ps = __uint_as_float(rr[0]) + __uint_as_float(rr[1]); }
  l_reg = l_reg * alpha + ps;
#define PK4(P, BASE, OUT) do { unsigned a0 = cvtpk(P[BASE + 0], P[BASE + 1]), a1 = cvtpk(P[BASE + 2], P[BASE + 3]);   \
    unsigned b0 = cvtpk(P[BASE + 4], P[BASE + 5]), b1 = cvtpk(P[BASE + 6], P[BASE + 7]);                              \
    auto r0 = __builtin_amdgcn_permlane32_swap(a0, b0, false, false); auto r1 = __builtin_amdgcn_permlane32_swap(a1, b1, false, false); \
    u32x4 w = {r0[0], r1[0], r0[1], r1[1]}; OUT = *reinterpret_cast<bf16x8*>(&w); } while (0)
  PK4(p0, 0, pa0); PK4(p0, 8, pa1); PK4(p1, 0, pa2); PK4(p1, 8, pa3);
#undef PK4
}
template <int ND0, int DOFF>
__device__ __forceinline__ void qkt(f32x16& p0, f32x16& p1, const char* Ks, const bf16x8* qr, int r32, int hi) {
  p0 = f32x16{}; p1 = f32x16{};
#pragma unroll
  for (int d0 = 0; d0 < ND0; ++d0) { const int cb = ((d0 + DOFF) * 16 + hi * 8) * 2;
    bf16x8 b0 = *reinterpret_cast<const bf16x8*>(Ks + KSWZ(r32, cb));
    bf16x8 b1 = *reinterpret_cast<const bf16x8*>(Ks + KSWZ(32 + r32, cb));
    p0 = __builtin_amdgcn_mfma_f32_32x32x16_bf16(b0, qr[d0], p0, 0, 0, 0);
    p1 = __builtin_amdgcn_mfma_f32_32x32x16_bf16(b1, qr[d0], p1, 0, 0, 0); }
}
__device__ __forceinline__ int v_st(int k, int c) { const int kk = (k & ~0xC) | ((k & 4) << 1) | ((k & 8) >> 1); return ((kk >> 3) * 4 + (c >> 5)) * 512 + ((kk & 7) * 32 + (c & 31)) * 2; }
__device__ __forceinline__ int v_rd_base(int lane) { return ((lane & 3) << 3) | (((lane >> 2) & 3) << 6) | (((lane >> 4) & 1) << 5) | (((lane >> 5) & 1) << 8); }
constexpr int v_rd_off(int d0, int ks, int half) { return d0 * 512 + ks * 4096 + half * 2048; }
template <int OFF> __device__ __forceinline__ s16x4 tr_read(int vb) {
  s16x4 r; asm volatile("ds_read_b64_tr_b16 %0, %1 offset:%2" : "=&v"(r) : "v"(vb), "i"(OFF) : "memory"); return r;
}
template <int D0> __device__ __forceinline__ void pv_one(f32x16& od, int vb, bf16x8 pa0, bf16x8 pa1, bf16x8 pa2, bf16x8 pa3) {
  const s16x4 l0 = tr_read<v_rd_off(D0, 0, 0)>(vb), h0 = tr_read<v_rd_off(D0, 0, 1)>(vb), l1 = tr_read<v_rd_off(D0, 1, 0)>(vb), h1 = tr_read<v_rd_off(D0, 1, 1)>(vb);
  const s16x4 l2 = tr_read<v_rd_off(D0, 2, 0)>(vb), h2 = tr_read<v_rd_off(D0, 2, 1)>(vb), l3 = tr_read<v_rd_off(D0, 3, 0)>(vb), h3 = tr_read<v_rd_off(D0, 3, 1)>(vb);
  asm volatile("s_waitcnt lgkmcnt(0)" ::: "memory"); SBAR();
#define PK(L, H) (bf16x8){L[0], L[1], L[2], L[3], H[0], H[1], H[2], H[3]}
  od = __builtin_amdgcn_mfma_f32_32x32x16_bf16(pa0, PK(l0, h0), od, 0, 0, 0);
  od = __builtin_amdgcn_mfma_f32_32x32x16_bf16(pa1, PK(l1, h1), od, 0, 0, 0);
  od = __builtin_amdgcn_mfma_f32_32x32x16_bf16(pa2, PK(l2, h2), od, 0, 0, 0);
  od = __builtin_amdgcn_mfma_f32_32x32x16_bf16(pa3, PK(l3, h3), od, 0, 0, 0);
#undef PK
}
__device__ __forceinline__ void pv_d0(f32x16* o, int vb, bf16x8 pa0, bf16x8 pa1, bf16x8 pa2, bf16x8 pa3) {
  pv_one<0>(o[0], vb, pa0, pa1, pa2, pa3); pv_one<1>(o[1], vb, pa0, pa1, pa2, pa3); pv_one<2>(o[2], vb, pa0, pa1, pa2, pa3); pv_one<3>(o[3], vb, pa0, pa1, pa2, pa3);
}

struct AttnEpi {
  const bf16_t* gate;
  float* park;
  bf16_t* merged;
  const float* gsub;
  float lam, oml;
  float sinkl2;
};

template <int MODE>
__device__ __forceinline__ void attn_body(const bf16_t* __restrict__ Qb, const bf16_t* __restrict__ Kh, const bf16_t* __restrict__ Vh, int NT, int krel0,
                                          char* lds, const float* __restrict__ lutg, const AttnEpi& E) {
  constexpr int ND0 = (MODE < 2) ? 8 : 4, DOFF = (MODE == 3) ? 4 : 0;
  int tid_ = threadIdx.x; asm volatile("" : "+v"(tid_));
  const int tid = tid_, wid = tid >> 6, lane = tid & 63, r32 = lane & 31, hi = lane >> 5;
  char* V_lds = lds; char* K_lds = lds + 2 * SHM_V;
  float* wsm = (float*)(lds + ATT_WS_OFF) + wid * 64; float* li_l = wsm; float* al_l = wsm + 32;
  float* lut = (float*)(lds + ATT_LUT_OFF);
  __syncthreads();
  if constexpr (MODE != 0) { if (tid < 259) lut[tid] = lutg[tid]; }
  float m_reg = -1e30f, l_reg = 0; f32x16 o[4] = {}; bf16x8 qr[ND0];
  const bf16_t* Qw = Qb + (size_t)(wid * 32 + r32) * LDQK + hi * 8;
#pragma unroll
  for (int d0 = 0; d0 < ND0; ++d0) qr[d0] = *reinterpret_cast<const bf16x8*>(Qw + d0 * 16);
  const int sr = tid >> 4, sc = (tid & 15) * 8, vst0 = v_st(sr, sc), vst1 = v_st(32 + sr, sc);
  const int vb0 = (int)(uintptr_t)V_lds + v_rd_base(lane);
  struct { bf16x8 vs0, vs1, ks0, ks1; } sr_[2];
#define SLOAD(i, k0) do { sr_[i].vs0 = *reinterpret_cast<const bf16x8*>(&Vh[(size_t)((k0) + sr) * LDQK + sc]); sr_[i].vs1 = *reinterpret_cast<const bf16x8*>(&Vh[(size_t)((k0) + 32 + sr) * LDQK + sc]); \
    sr_[i].ks0 = *reinterpret_cast<const bf16x8*>(&Kh[(size_t)((k0) + sr) * LDQK + sc]); sr_[i].ks1 = *reinterpret_cast<const bf16x8*>(&Kh[(size_t)((k0) + 32 + sr) * LDQK + sc]); } while (0)
#define SWRITE(b, i) do { *(bf16x8*)(V_lds + (b) * SHM_V + vst0) = sr_[i].vs0;          \
    *(bf16x8*)(V_lds + (b) * SHM_V + vst1) = sr_[i].vs1; int kc = sc * 2;               \
    *(bf16x8*)(K_lds + (b) * SHM_K + KSWZ(sr, kc)) = sr_[i].ks0;                       \
    *(bf16x8*)(K_lds + (b) * SHM_K + KSWZ(32 + sr, kc)) = sr_[i].ks1; } while (0)
#define SWAIT() asm volatile("s_waitcnt vmcnt(4)" ::: "memory")
#define RESC(a) do { if (__any((a) < 1.f)) { if (hi == 0) al_l[r32] = (a); asm volatile("s_waitcnt lgkmcnt(0)" ::: "memory"); \
    _Pragma("unroll") for (int d = 0; d < 4; ++d) _Pragma("unroll") for (int r = 0; r < 16; ++r) o[d][r] *= al_l[crow(r, hi)]; } } while (0)
  const int relq = krel0 - (wid * 32 + r32) + 4 * hi, relwmin = krel0 - (wid * 32 + 31), relwmax = krel0 + 63 - wid * 32;
#define PSM(P0, P1, MN, AL, J) partialSM<MODE>(P0, P1, m_reg, MN, AL, relq + 64 * (J), relwmin + 64 * (J), relwmax + 64 * (J), lut)
  f32x16 pA0, pA1, pB0, pB1; float mnA, mnB, alA, alB; bf16x8 pa0, pa1, pa2, pa3;
  constexpr int SE = 0, SO = 1;
  SLOAD(SE, 0); asm volatile("s_waitcnt vmcnt(0)" ::: "memory"); SWRITE(0, SE); __syncthreads();
  qkt<ND0, DOFF>(pA0, pA1, K_lds, qr, r32, hi); PSM(pA0, pA1, mnA, alA, 0);
  SLOAD(SO, 64); if (2 < NT) SLOAD(SE, 2 * 64);
  SWAIT(); SWRITE(1, SO); __syncthreads();
  for (int j = 1; j + 1 < NT; j += 2) {
    SBAR(); qkt<ND0, DOFF>(pB0, pB1, K_lds + SHM_K, qr, r32, hi);
    finishSM(pA0, pA1, alA, l_reg, pa0, pa1, pa2, pa3); SBAR();
    SLOAD(SO, (j + 2) * 64); SBAR();
    pv_d0(o, vb0, pa0, pa1, pa2, pa3); PSM(pB0, pB1, mnB, alB, j);
    __syncthreads(); SWAIT(); SWRITE(0, SE);
    RESC(alB); __syncthreads();
    SBAR(); qkt<ND0, DOFF>(pA0, pA1, K_lds, qr, r32, hi);
    finishSM(pB0, pB1, alB, l_reg, pa0, pa1, pa2, pa3); SBAR();
    if (j + 3 < NT) SLOAD(SE, (j + 3) * 64); SBAR();
    pv_d0(o, vb0 + SHM_V, pa0, pa1, pa2, pa3); PSM(pA0, pA1, mnA, alA, j + 1);
    __syncthreads(); SWAIT(); SWRITE(1, SO);
    RESC(alA); __syncthreads();
  }
  SBAR(); qkt<ND0, DOFF>(pB0, pB1, K_lds + SHM_K, qr, r32, hi);
  finishSM(pA0, pA1, alA, l_reg, pa0, pa1, pa2, pa3); SBAR();
  pv_d0(o, vb0, pa0, pa1, pa2, pa3); PSM(pB0, pB1, mnB, alB, NT - 1);
  __syncthreads(); RESC(alB);
  finishSM(pB0, pB1, alB, l_reg, pa0, pa1, pa2, pa3); SBAR();
  pv_d0(o, vb0 + SHM_V, pa0, pa1, pa2, pa3);
  if constexpr (MODE == 1) l_reg += __builtin_amdgcn_exp2f(E.sinkl2 - m_reg);
  if (hi == 0) li_l[r32] = l_reg; asm volatile("s_waitcnt lgkmcnt(0)" ::: "memory");
  float rli[16];
#pragma unroll
  for (int r = 0; r < 16; ++r) rli[r] = __builtin_amdgcn_rcpf(li_l[crow(r, hi)]);
  float* pk0 = E.park; float* pk1 = E.park + 64 * 512;
  const int rowb = wid * 32;
  if constexpr (MODE == 0 || MODE == 1) {
#pragma unroll
    for (int r = 0; r < 16; ++r) { const int row = rowb + crow(r, hi);
#pragma unroll
      for (int d0 = 0; d0 < 4; ++d0) { const int idx = (d0 * 16 + r) * 512 + tid;
        const float g = bf2f(E.gate[(size_t)row * GW + d0 * 32 + r32]);
        const float v = o[d0][r] * rli[r] * g;
        if constexpr (MODE == 0) pk0[idx] = v; else pk0[idx] += v; } }
  } else if constexpr (MODE == 2) {
#pragma unroll
    for (int r = 0; r < 16; ++r)
#pragma unroll
      for (int d0 = 0; d0 < 4; ++d0) pk1[(d0 * 16 + r) * 512 + tid] = o[d0][r] * rli[r];
  } else {
    float gs[4];
#pragma unroll
    for (int d0 = 0; d0 < 4; ++d0) gs[d0] = E.gsub[d0 * 32 + r32] * E.oml;
#pragma unroll
    for (int r = 0; r < 16; ++r) { const int row = rowb + crow(r, hi);
      float ss = 0.f;
#pragma unroll
      for (int d0 = 0; d0 < 4; ++d0) { const float c = pk1[(d0 * 16 + r) * 512 + tid] - E.lam * (o[d0][r] * rli[r]); o[d0][r] = c; ss += c * c; }
      ss += __shfl_xor(ss, 1); ss += __shfl_xor(ss, 2); ss += __shfl_xor(ss, 4); ss += __shfl_xor(ss, 8); ss += __shfl_xor(ss, 16);
      const float rs = rsqrtf(ss * (1.f / 128.f) + EPS);
#pragma unroll
      for (int d0 = 0; d0 < 4; ++d0) { const int col = d0 * 32 + r32;
        const float g = bf2f(E.gate[(size_t)row * GW + col]);
        const float y = o[d0][r] * rs * gs[d0] * g + pk0[(d0 * 16 + r) * 512 + tid];
        E.merged[(size_t)row * DM + col] = (bf16_t)(cvtpk(y, y) & 0xffffu); } }
  }
#undef SLOAD
#undef SWRITE
#undef SWAIT
#undef RESC
#undef PSM
}

__device__ __forceinline__ int t5bucket(int rel) {
  const int n = rel < 0 ? -rel : rel;
  const int b = n < 8 ? n : 8 + (n >= 12) + (n >= 16) + (n >= 23) + (n >= 32) + (n >= 46) + (n >= 64) + (n >= 91);
  return b + (rel > 0 ? 16 : 0);
}
__device__ __forceinline__ float wave_sum(float v) {
  v += __shfl_xor(v, 1); v += __shfl_xor(v, 2); v += __shfl_xor(v, 4); v += __shfl_xor(v, 8); v += __shfl_xor(v, 16); v += __shfl_xor(v, 32); return v;
}

__device__ __forceinline__ void phase_setup(const Params& p, unsigned char* shm) {
  int tid_ = threadIdx.x; asm volatile("" : "+v"(tid_)); const int tid = tid_, nb = gridDim.x, bid = blockIdx.x, wid = tid >> 6, lane = tid & 63;
  {
    const float4* s0 = (const float4*)p.in[0]; const float4* s1 = (const float4*)p.in[1]; float4* o = (float4*)p.out;
    const size_t n4 = (size_t)16384 * 1024 / 4;
    for (size_t i = (size_t)bid * 512 + tid; i < 2 * n4; i += (size_t)nb * 512) o[i] = i < n4 ? s0[i] : s1[i - n4];
  }
  {
    float* rope = (float*)(p.ws + WS_ROPE);
    for (int i = bid * 512 + tid; i < 256 * 32; i += nb * 512) { const int pos = i >> 5, f = i & 31;
      const float inv = powf(10000.f, -(float)f / 32.f); const float ang = (float)pos * inv; rope[2 * i] = cosf(ang); rope[2 * i + 1] = sinf(ang); }
    float* lut = (float*)(p.ws + WS_LUT);
    for (int i = bid * 512 + tid; i < 16 * 259; i += nb * 512) { const int hh = i / 259, e = i % 259; int rel = e - 129; float v;
      if (hh < 8) { v = (rel < -128 || rel > 128) ? NEGBIG : p.in[23][t5bucket(rel) * 16 + hh] * LOG2E; }
      else { rel = rel < -128 ? -128 : (rel > 128 ? 128 : rel); v = p.in[23][t5bucket(rel) * 16 + hh] * LOG2E; }
      lut[i] = v; }
    if (bid == 0 && tid < 4) { const int l = tid; float s1 = 0.f, s2 = 0.f;
      for (int i = 0; i < 64; ++i) { s1 += p.in[18][l * 64 + i] * p.in[19][l * 64 + i]; s2 += p.in[20][l * 64 + i] * p.in[21][l * 64 + i]; }
      const float lam_init = 0.8f - 0.6f * expf(-0.3f * (float)l);
      float* lam = (float*)(p.ws + WS_LAM); lam[2 * l] = expf(s1) - expf(s2) + lam_init; lam[2 * l + 1] = 1.f - lam_init; }
  }
  {
    float* sc = (float*)shm; float* red = sc + 9 * 1024;
    for (int i = tid; i < 9 * 1024; i += 512) { const float c = i < 8192 ? p.in[2][i] : p.in[3][i - 8192]; sc[i] = c / (1.f + expf(-c)); }
    __syncthreads();
    float* mod = (float*)(p.ws + WS_MOD);
    for (int task = bid; task < 576; task += nb) {
      const int l = task / 144, j0 = (task % 144) * 64;
      const float* w = p.in[4] + (size_t)l * 1024 * 9216 + j0 + lane;
      float a0 = 0, a1 = 0, a2 = 0, a3 = 0, a4 = 0, a5 = 0, a6 = 0, a7 = 0, a8 = 0;
#pragma unroll 16
      for (int k = wid * 128; k < wid * 128 + 128; ++k) { const float wv = w[(size_t)k * 9216];
        a0 += sc[k] * wv; a1 += sc[1024 + k] * wv; a2 += sc[2048 + k] * wv; a3 += sc[3072 + k] * wv; a4 += sc[4096 + k] * wv;
        a5 += sc[5120 + k] * wv; a6 += sc[6144 + k] * wv; a7 += sc[7168 + k] * wv; a8 += sc[8192 + k] * wv; }
      float* rw = red + wid * 9 * 64 + lane;
      rw[0] = a0; rw[64] = a1; rw[128] = a2; rw[192] = a3; rw[256] = a4; rw[320] = a5; rw[384] = a6; rw[448] = a7; rw[512] = a8;
      __syncthreads();
      for (int i = tid; i < 9 * 64; i += 512) { const int b = i >> 6, ln = i & 63; float s = 0.f;
#pragma unroll
        for (int w8 = 0; w8 < 8; ++w8) s += red[w8 * 9 * 64 + b * 64 + ln];
        mod[((size_t)l * 9 + b) * 9216 + j0 + ln] = s + p.in[5][l * 9216 + j0 + ln]; }
      __syncthreads();
    }
  }
}

__device__ __forceinline__ void phase_convert(const Params& p, int l, unsigned char* shm) {
  float* tile = (float*)shm;
  int tid_ = threadIdx.x; asm volatile("" : "+v"(tid_)); const int tid = tid_;
  for (int q = blockIdx.x; q < 6400; q += gridDim.x) {
    const float* W; bf16_t* Bt; int N, K, k0, n0d, n0s;
    if (q < 2816) { const int i = q / 1408, qq = q % 1408; W = p.in[7] + (size_t)(l * 2 + i) * 1024 * 5632; Bt = (bf16_t*)(p.ws + (i ? WB_FFIN1 : WB_FFIN0)); N = 5632; K = 1024;
      k0 = (qq & 15) * 64; n0d = (qq >> 4) * 64; n0s = ((n0d >> 7) & 1) * 2816 + (n0d >> 8) * 128 + (n0d & 127); }
    else if (q < 4224) { const int i = (q - 2816) / 704, qq = (q - 2816) % 704; W = p.in[8] + (size_t)(l * 2 + i) * 2816 * 1024; Bt = (bf16_t*)(p.ws + (i ? WB_FFOUT1 : WB_FFOUT0)); N = 1024; K = 2816;
      k0 = (qq % 44) * 64; n0d = (qq / 44) * 64; n0s = n0d; }
    else if (q < 6144) { const int qq = q - 4224; W = p.in[9] + (size_t)l * 1024 * 7680; Bt = (bf16_t*)(p.ws + WB_WIN); N = 7680; K = 1024;
      k0 = (qq & 15) * 64; n0d = (qq >> 4) * 64; n0s = n0d; }
    else { const int qq = q - 6144; W = p.in[10] + (size_t)l * 1024 * 1024; Bt = (bf16_t*)(p.ws + WB_WO); N = 1024; K = 1024;
      k0 = (qq & 15) * 64; n0d = (qq >> 4) * 64; n0s = n0d; }
    { const int nl = tid & 63, ks = tid >> 6;
#pragma unroll
      for (int i = 0; i < 8; ++i) { const int k = ks + 8 * i; tile[nl * 65 + k] = W[(size_t)(k0 + k) * N + n0s + nl]; } }
    __syncthreads();
    { const int n = tid >> 3, kc = (tid & 7) * 8; const float* tr = tile + n * 65 + kc;
      u32x4 w; w.x = cvtpk(tr[0], tr[1]); w.y = cvtpk(tr[2], tr[3]); w.z = cvtpk(tr[4], tr[5]); w.w = cvtpk(tr[6], tr[7]);
      *(u32x4*)(Bt + (size_t)(n0d + n) * K + k0 + kc) = w; }
    __syncthreads();
  }
}

__device__ __forceinline__ void phase_norm(const float* __restrict__ x, const float* __restrict__ g, const float* __restrict__ modl, int jj, bf16_t* __restrict__ xn) {
  int tid_ = threadIdx.x; asm volatile("" : "+v"(tid_)); const int tid = tid_, wid = tid >> 6, lane = tid & 63;
  for (int row = blockIdx.x * 8 + wid; row < T_TOK; row += gridDim.x * 8) {
    const int bi = row < 16384 ? (row >> 11) : 8;
    const float* shift = modl + (size_t)bi * 9216 + (3 * jj) * 1024; const float* scale = shift + 1024;
    const float4* xr = (const float4*)(x + (size_t)row * DM);
    float4 v[4]; float ss = 0.f;
#pragma unroll
    for (int i = 0; i < 4; ++i) { v[i] = xr[lane + 64 * i]; ss += v[i].x * v[i].x + v[i].y * v[i].y + v[i].z * v[i].z + v[i].w * v[i].w; }
    ss = wave_sum(ss);
    const float rs = rsqrtf(ss * (1.f / 1024.f) + EPS);
#pragma unroll
    for (int i = 0; i < 4; ++i) { const int c4 = lane + 64 * i;
      const float4 gg = ((const float4*)g)[c4], sc = ((const float4*)scale)[c4], sh = ((const float4*)shift)[c4];
      const float y0 = v[i].x * rs * gg.x * (1.f + sc.x) + sh.x, y1 = v[i].y * rs * gg.y * (1.f + sc.y) + sh.y;
      const float y2 = v[i].z * rs * gg.z * (1.f + sc.z) + sh.z, y3 = v[i].w * rs * gg.w * (1.f + sc.w) + sh.w;
      u32x2 w; w.x = cvtpk(y0, y1); w.y = cvtpk(y2, y3);
      *(u32x2*)(xn + (size_t)row * DM + c4 * 4) = w; }
  }
}

__device__ __forceinline__ void phase_qknorm(const Params& p, int l) {
  bf16_t* qkv = (bf16_t*)(p.ws + WS_QKV); const float* rope = (const float*)(p.ws + WS_ROPE);
  int tid_ = threadIdx.x; asm volatile("" : "+v"(tid_)); const int tid = tid_, wid = tid >> 6, lane = tid & 63;
  f32x2 gq[3], gk[3];
  gq[0] = *(const f32x2*)(p.in[11] + l * 128 + 2 * lane); gk[0] = *(const f32x2*)(p.in[12] + l * 128 + 2 * lane);
  gq[1] = *(const f32x2*)(p.in[13] + l * 128 + 2 * lane); gk[1] = *(const f32x2*)(p.in[14] + l * 128 + 2 * lane);
  gq[2] = *(const f32x2*)(p.in[15] + l * 64 + ((2 * lane) & 63)); gk[2] = *(const f32x2*)(p.in[16] + l * 64 + ((2 * lane) & 63));
  const float sg = (lane & 16) ? 1.f : -1.f;
  for (int tok = blockIdx.x * 8 + wid; tok < T_TOK; tok += gridDim.x * 8) {
    unsigned* base = (unsigned*)(qkv + (size_t)tok * QKVW) + lane;
    unsigned u[30];
#pragma unroll
    for (int s = 0; s < 30; ++s) u[s] = base[((s / 10) * 1536 + (s % 10) * 128) / 2];
    const int sp = tok < 16384 ? (tok & 2047) : (tok - 16384);
    const int pos = lane < 32 ? (sp >> 6) : (sp & 63);
    const f32x4 cs = *(const f32x4*)(rope + (size_t)(pos * 32 + ((2 * lane) & 31)) * 2);
#pragma unroll
    for (int s = 0; s < 30; ++s) {
      const int br = s / 10, hs = s % 10;
      float a = bf_lo(u[s]), b = bf_hi(u[s]);
      float ss = a * a + b * b;
      ss += __shfl_xor(ss, 1); ss += __shfl_xor(ss, 2); ss += __shfl_xor(ss, 4); ss += __shfl_xor(ss, 8); ss += __shfl_xor(ss, 16);
      float rs;
      if (br < 2) { ss += __shfl_xor(ss, 32); rs = rsqrtf(ss * (1.f / 128.f) + EPS); }
      else rs = rsqrtf(ss * (1.f / 64.f) + EPS);
      const f32x2 g = hs < 8 ? gq[br] : gk[br];
      a = a * rs * g[0]; b = b * rs * g[1];
      if (br == 0) {
        const float pa = __shfl_xor(a, 16), pb = __shfl_xor(b, 16);
        a = a * cs[0] + sg * pa * cs[1]; b = b * cs[2] + sg * pb * cs[3];
      }
      base[(br * 1536 + hs * 128) / 2] = cvtpk(a, b);
    }
  }
}

__device__ __forceinline__ void phase_attn(const Params& p, int l, unsigned char* shm) {
  const bf16_t* qkv = (const bf16_t*)(p.ws + WS_QKV); const bf16_t* gates = (const bf16_t*)(p.ws + WS_GATES);
  bf16_t* merged = (bf16_t*)(p.ws + WS_XN);
  const float* lutall = (const float*)(p.ws + WS_LUT); const float* lamp = (const float*)(p.ws + WS_LAM);
  AttnEpi E; E.park = (float*)(p.ws + WS_PARK) + (size_t)blockIdx.x * 65536; E.gsub = p.in[22] + l * 128; E.lam = lamp[2 * l]; E.oml = lamp[2 * l + 1];
  for (int it = blockIdx.x; it < 1024; it += gridDim.x) {
    int S, tok0, h, qb;
    if (it < 512) { S = 16384; tok0 = 16384; h = it & 7; qb = it >> 3; }
    else { const int j = it - 512; S = 2048; h = j & 7; qb = (j >> 3) & 7; tok0 = (j >> 6) * 2048; }
    const int g = h >> 2, q0 = qb * 256;
    const bf16_t* rowQ = qkv + (size_t)(tok0 + q0) * QKVW; const bf16_t* seqK = qkv + (size_t)tok0 * QKVW;
    const bf16_t* grow = gates + (size_t)(tok0 + q0) * GW + h * 128;
    E.merged = merged + (size_t)(tok0 + q0) * DM + h * 128; E.sinkl2 = p.in[17][l * 8 + h] * LOG2E;
    E.gate = grow;
    attn_body<0>(rowQ + h * 128, seqK + 1024 + g * 128, seqK + 1280 + g * 128, S / 64, 0, (char*)shm, lutall, E);
    { const int t_lo = max(0, 4 * qb - 2), t_hi = min(S / 64, 4 * qb + 6);
      const bf16_t* kb = seqK + (size_t)t_lo * 64 * QKVW;
      E.gate = grow + 1024;
      attn_body<1>(rowQ + 1536 + h * 128, kb + 2560 + g * 128, kb + 2816 + g * 128, t_hi - t_lo, t_lo * 64 - q0, (char*)shm, lutall + h * 259, E); }
    E.gate = grow + 2048;
    attn_body<2>(rowQ + 3072 + h * 128, seqK + 4096 + g * 128, seqK + 4352 + g * 128, S / 64, -q0, (char*)shm, lutall + (8 + h) * 259, E);
    attn_body<3>(rowQ + 3072 + h * 128 + 64, seqK + 4096 + g * 128, seqK + 4352 + g * 128, S / 64, -q0, (char*)shm, lutall + (8 + h) * 259, E);
  }
}

__device__ __forceinline__ void gsync(cg::grid_group& g) {
  asm volatile("s_waitcnt vmcnt(0) lgkmcnt(0)" ::: "memory");
  g.sync();
  __builtin_amdgcn_fence(__ATOMIC_ACQUIRE, "agent");
  asm volatile("s_waitcnt vmcnt(0)" ::: "memory");
}
constexpr int N_PHASES = 45;
__global__ void __launch_bounds__(512) mega_fwd(Params p, int ph_lo, int ph_hi) {
  extern __shared__ __attribute__((aligned(16))) unsigned char shm[];
  cg::grid_group grid = cg::this_grid();
  LAS unsigned char* lds3 = (LAS unsigned char*)shm;
  float* X = p.out;
  bf16_t* XN = (bf16_t*)(p.ws + WS_XN); bf16_t* Hb = (bf16_t*)(p.ws + WS_QKV);
  pg8::StaticOrder S;
#pragma unroll 1
  for (int ph = ph_lo; ph < ph_hi; ++ph) {
    if (ph == 0) { phase_setup(p, shm); }
    else {
      const int l = (ph - 1) / 11, k = (ph - 1) % 11;
      const float* modl = (const float*)(p.ws + WS_MOD) + (size_t)l * 9 * 9216;
      if (k == 0 || k == 3 || k == 8) {
        if (k == 0) phase_convert(p, l, shm);
        const int jj = k == 0 ? 0 : (k == 3 ? 1 : 2);
        phase_norm(X, p.in[6] + (size_t)(l * 3 + jj) * 1024, modl, jj, XN);
      } else if (k == 1 || k == 9) {
        pg8::Gemm g{XN, (const bf16_t*)(p.ws + (k == 9 ? WB_FFIN1 : WB_FFIN0)), T_TOK, NFF2, DM};
        S.init(T_TOK, NFF2, gridDim.x, blockIdx.x); pg8::EpiSwiGLU E{Hb}; pg8::gemm_phase(lds3, g, S, E);
      } else if (k == 2 || k == 10 || k == 7) {
        const bool wo = (k == 7);
        pg8::Gemm g{wo ? XN : Hb, (const bf16_t*)(p.ws + (wo ? WB_WO : (k == 10 ? WB_FFOUT1 : WB_FFOUT0))), T_TOK, DM, wo ? DM : DFF};
        S.init(T_TOK, DM, gridDim.x, blockIdx.x); pg8::EpiResid E{X, modl + (wo ? 5 : (k == 10 ? 8 : 2)) * 1024, wo ? 1.0f : 0.5f}; pg8::gemm_phase(lds3, g, S, E);
      } else if (k == 4) {
        pg8::Gemm g{XN, (const bf16_t*)(p.ws + WB_WIN), T_TOK, WINC, DM};
        S.init(T_TOK, WINC, gridDim.x, blockIdx.x); pg8::EpiQKV E{(bf16_t*)(p.ws + WS_QKV), (bf16_t*)(p.ws + WS_GATES)}; pg8::gemm_phase(lds3, g, S, E);
      } else if (k == 5) { phase_qknorm(p, l); }
      else { phase_attn(p, l, shm); }
    }
    if (ph + 1 < ph_hi) gsync(grid);
  }
}

#ifndef N_LAUNCH_MODE
#define N_LAUNCH_MODE 1
#endif
extern "C" void kernel_launch(void* const* d_in, const int* in_sizes, int n_in, void* d_out, int out_size, void* d_ws, size_t ws_size, hipStream_t stream) {
  static int grid = 0;
  if (grid == 0) {
    if (n_in != 24 || out_size != T_TOK * DM || ws_size < WS_END) { fprintf(stderr, "kernel_launch: unexpected shapes (n_in %d out %d ws %zu need %zu)\n", n_in, out_size, ws_size, (size_t)WS_END); grid = -1; return; }
    int dev = 0, cus = 0, per_cu = 0;
    (void)hipGetDevice(&dev); (void)hipDeviceGetAttribute(&cus, hipDeviceAttributeMultiprocessorCount, dev);
    if (hipFuncSetAttribute((const void*)mega_fwd, hipFuncAttributeMaxDynamicSharedMemorySize, LDS_BYTES) != hipSuccess) { fprintf(stderr, "kernel_launch: hipFuncSetAttribute failed\n"); grid = -1; return; }
    if (hipOccupancyMaxActiveBlocksPerMultiprocessor(&per_cu, (const void*)mega_fwd, 512, LDS_BYTES) != hipSuccess || per_cu < 1) { fprintf(stderr, "kernel_launch: occupancy query gave %d\n", per_cu); per_cu = 1; }
    (void)hipGetLastError();
    grid = cus;
  }
  if (grid < 0) return;
  Params p{};
  for (int i = 0; i < 24; ++i) p.in[i] = (const float*)d_in[i];
  p.out = (float*)d_out; p.ws = (unsigned char*)d_ws;
#if N_LAUNCH_MODE == 1
  int lo = 0, hi = N_PHASES;
  void* args[] = {&p, &lo, &hi};
  hipError_t e = hipLaunchCooperativeKernel((const void*)mega_fwd, dim3(grid), dim3(512), args, LDS_BYTES, stream);
  if (e != hipSuccess) fprintf(stderr, "kernel_launch: cooperative launch failed: %s (grid %d)\n", hipGetErrorString(e), grid);
#else
  for (int ph = 0; ph < N_PHASES; ++ph) hipLaunchKernelGGL(mega_fwd, dim3(grid), dim3(512), LDS_BYTES, stream, p, ph, ph + 1);
#endif
}
```

```cpp
#include <hip/hip_runtime.h>
#include <hip/hip_bf16.h>
#include <hip/hip_cooperative_groups.h>
#include <cstdio>
#include <cstdint>
#define N_LAUNCH_MODE 1
namespace cg = cooperative_groups;

typedef unsigned short bf16_t;
typedef short bf16x8 __attribute__((ext_vector_type(8)));
typedef short s16x4 __attribute__((ext_vector_type(4)));
typedef float f32x4 __attribute__((ext_vector_type(4)));
typedef float f32x16 __attribute__((ext_vector_type(16)));
typedef unsigned u32x4 __attribute__((ext_vector_type(4)));
typedef unsigned u32x2 __attribute__((ext_vector_type(2)));
#define LAS __attribute__((address_space(3)))

constexpr int T_TOK = 32768, DM = 1024, DFF = 2816, NFF2 = 5632, WINC = 7680, QKVW = 4608, GW = 3072;
constexpr float EPS = 1e-6f, LOG2E = 1.4426950408889634f, NEGBIG = -1e30f;
constexpr size_t WB_FFIN0 = 0, WB_FFIN1 = 11534336, WB_FFOUT0 = 23068672, WB_FFOUT1 = 28835840, WB_WIN = 34603008, WB_WO = 50331648;
constexpr size_t WS_MOD = 52428800, WS_ROPE = 53755904, WS_LUT = 53821440, WS_LAM = 53854208, WS_XN = 53854464;
constexpr size_t WS_QKV = WS_XN + 67108864, WS_GATES = WS_QKV + 301989888, WS_PARK = WS_GATES + 201326592, WS_END = WS_PARK + 67108864;
constexpr size_t WS_BAR = WS_END, WS_END2 = WS_END + 16384;
constexpr int LDS_BYTES = 131072 + 16;

struct Params { const float* in[24]; float* out; unsigned char* ws; };

typedef __bf16 bf16v2 __attribute__((ext_vector_type(2)));
typedef float f32x2 __attribute__((ext_vector_type(2)));
__device__ __forceinline__ unsigned cvtpk(float lo, float hi) { f32x2 v = {lo, hi}; bf16v2 b = __builtin_convertvector(v, bf16v2); return __builtin_bit_cast(unsigned, b); }
__device__ __forceinline__ float bf_lo(unsigned u) { return __uint_as_float(u << 16); }
__device__ __forceinline__ float bf_hi(unsigned u) { return __uint_as_float(u & 0xffff0000u); }
__device__ __forceinline__ float bf2f(bf16_t v) { return __uint_as_float(((unsigned)v) << 16); }

namespace pg8 {
constexpr int BM = 256, BK = 64, HALF = 128, HTB = HALF * BK * 2, STAGE_BYTES = 8 * HTB, NXCD = 8, WGM = 8;
__device__ __forceinline__ int lds_byte(int r, int c) { const int st = (r >> 4) * 2 + (c >> 5), rr = r & 15, cc = c & 31, ob = rr * 64 + cc * 2; return st * 1024 + (ob ^ (((ob >> 9) & 1) << 5)); }
__device__ __forceinline__ void stage_rc(int b, int& R, int& C) { const int st = b / 1024, sb = b % 1024, swz = sb ^ (((sb >> 9) & 1) << 5); R = (st >> 1) * 16 + swz / 64; C = (st & 1) * 32 + (swz % 64) / 2; }
__device__ __forceinline__ int perm32(int rho) { const int n = rho >> 4, i = rho & 15; return 8 * (i >> 2) + 4 * n + (i & 3); }
struct Unit { int pm, pn; };
struct Gemm { const bf16_t* A; const bf16_t* Bt; int M, N, K; };
struct StaticOrder {
    int nM, nN, nwg, G, c;
    __device__ void init(int M, int N, int G_, int c_) { nM = M / BM; nN = N / BM; nwg = nM * nN; G = G_; c = c_; }
    __device__ bool next(int i, Unit& u) const {
        const long L = (long)i * G + c; if (L >= nwg) return false;
        int wgid = (int)L; { const int q = nwg / NXCD, r = nwg % NXCD, xcd = wgid % NXCD, off = wgid / NXCD; wgid = (xcd < r ? xcd * (q + 1) : r * (q + 1) + (xcd - r) * q) + off; }
        const int nig = WGM * nN, gid = wgid / nig, fm = gid * WGM, gsz = (nM - fm) < WGM ? (nM - fm) : WGM;
        u.pm = fm + ((wgid % nig) % gsz); u.pn = (wgid % nig) / gsz; return true;
    }
};

template <class Epi>
__device__ __forceinline__ void gemm_phase(LAS unsigned char* lds, const Gemm g, const StaticOrder& S, const Epi& E) {
    int tid_ = threadIdx.x; asm volatile("" : "+v"(tid_));
    const int tid = tid_, wid = __builtin_amdgcn_readfirstlane(tid >> 6), lane = tid & 63, wr = wid >> 2, wc = wid & 3, fr = lane & 15, fq = lane >> 4;
    const int K = g.K, nt = K / BK;
    unsigned voffA[2], voffB[2];
#pragma unroll
    for (int i = 0; i < 2; ++i) { int R, C; stage_rc(tid * 16 + i * 8192, R, C); const int Rb = Epi::PERM ? ((R & ~31) + perm32(R & 31)) : R;
        voffA[i] = (unsigned)(R * K + C) * 2u; voffB[i] = (unsigned)(Rb * K + C) * 2u; }
    const size_t kstep = (size_t)(BK * 2);
    const size_t hstep = (size_t)HALF * K * 2;
    const size_t tstep = 2 * hstep;
    const unsigned ldsw = (unsigned)wid * 1024u;
    const int aoff = lds_byte(wr * 64 + fr, fq * 8), boff = lds_byte(wc * 32 + fr, fq * 8);
#define PG8_SA(b, h) (((b) * 2 + (h)) * HTB)
#define PG8_SB(b, h) ((4 + (b) * 2 + (h)) * HTB)
#define PG8_STAGE(bufoff, gbase, voff) do { _Pragma("unroll") for (int _i = 0; _i < 2; ++_i) \
        __builtin_amdgcn_global_load_lds((const unsigned*)((const char*)(gbase) + (voff)[_i]), (LAS unsigned*)(lds + (bufoff) + ldsw + _i * 8192), 16, 0, 0); } while (0)
#define PG8_LDA(dst, b, h) do { _Pragma("unroll") for (int m = 0; m < 4; ++m) _Pragma("unroll") for (int k = 0; k < 2; ++k) dst[m][k] = *(const LAS bf16x8*)(lds + PG8_SA(b, h) + aoff + m * 2048 + k * 1024); } while (0)
#define PG8_LDB(dst, b, h) do { _Pragma("unroll") for (int n = 0; n < 2; ++n) _Pragma("unroll") for (int k = 0; k < 2; ++k) dst[n][k] = *(const LAS bf16x8*)(lds + PG8_SB(b, h) + boff + n * 2048 + k * 1024); } while (0)
#define PG8_MMA(ai, bj, At, Bt) do { __builtin_amdgcn_s_setprio(1); _Pragma("unroll") for (int m = 0; m < 4; ++m) _Pragma("unroll") for (int n = 0; n < 2; ++n) _Pragma("unroll") for (int k = 0; k < 2; ++k) \
        acc[ai][bj][m][n] = __builtin_amdgcn_mfma_f32_16x16x32_bf16(Bt[n][k], At[m][k], acc[ai][bj][m][n], 0, 0, 0); __builtin_amdgcn_s_setprio(0); } while (0)
#define PG8_WAIT_V(n) asm volatile("s_waitcnt vmcnt(" #n ")" ::: "memory")
#define PG8_WAIT_L(n) asm volatile("s_waitcnt lgkmcnt(" #n ")" ::: "memory")
#define PG8_BAR __builtin_amdgcn_s_barrier()
#define PG8_SCHED __builtin_amdgcn_sched_barrier(0)
    Unit cur, nxt; int ui = 0;
    if (!S.next(0, cur)) return;
    f32x4 acc[2][2][4][2];
#pragma unroll
    for (int a = 0; a < 2; ++a)
#pragma unroll
        for (int b = 0; b < 2; ++b)
#pragma unroll
            for (int m = 0; m < 4; ++m)
#pragma unroll
                for (int n = 0; n < 2; ++n) acc[a][b][m][n] = (f32x4){0.f, 0.f, 0.f, 0.f};
    bf16x8 At[4][2], B0[2][2], B1[2][2];
    const char* cA = (const char*)g.A + (size_t)cur.pm * tstep; const char* cB = (const char*)g.Bt + (size_t)cur.pn * tstep;
    PG8_STAGE(PG8_SB(0, 0), cB, voffB); PG8_STAGE(PG8_SA(0, 0), cA, voffA); PG8_STAGE(PG8_SB(0, 1), cB + hstep, voffB); PG8_STAGE(PG8_SA(0, 1), cA + hstep, voffA);
    if (wr == 1) PG8_BAR;
    PG8_WAIT_V(4); PG8_BAR;
    PG8_STAGE(PG8_SB(1, 0), cB + kstep, voffB); PG8_STAGE(PG8_SA(1, 0), cA + kstep, voffA); PG8_STAGE(PG8_SB(1, 1), cB + hstep + kstep, voffB);
    PG8_WAIT_V(6); PG8_BAR;
    for (;;) {
        const bool has_next = S.next(ui + 1, nxt);
        const char* nA = has_next ? (const char*)g.A + (size_t)nxt.pm * tstep : cA; const char* nB = has_next ? (const char*)g.Bt + (size_t)nxt.pn * tstep : cB;
        for (int t = 0; t < nt; t += 2) {
            const bool last = (t == nt - 2);
            const char* a1 = cA + (size_t)(t + 1) * kstep;
            const char* a2 = last ? nA : cA + (size_t)(t + 2) * kstep; const char* b2 = last ? nB : cB + (size_t)(t + 2) * kstep;
            const char* a3 = a2 + kstep; const char* b3 = b2 + kstep;
            PG8_LDB(B0, 0, 0); PG8_SCHED; PG8_LDA(At, 0, 0); PG8_STAGE(PG8_SA(1, 1), a1 + hstep, voffA);
            PG8_WAIT_L(8); PG8_BAR; PG8_WAIT_L(0); PG8_MMA(0, 0, At, B0); PG8_BAR; PG8_SCHED;
            PG8_LDB(B1, 0, 1); PG8_STAGE(PG8_SB(0, 0), b2, voffB);
            PG8_BAR; PG8_WAIT_L(0); PG8_MMA(0, 1, At, B1); PG8_BAR;
            PG8_LDA(At, 0, 1); PG8_STAGE(PG8_SA(0, 0), a2, voffA);
            PG8_BAR; PG8_WAIT_L(0); PG8_MMA(1, 0, At, B0); PG8_BAR; PG8_SCHED;
            PG8_STAGE(PG8_SB(0, 1), b2 + hstep, voffB);
            PG8_WAIT_V(6); PG8_BAR; PG8_MMA(1, 1, At, B1); PG8_BAR;
            PG8_LDB(B0, 1, 0); PG8_SCHED; PG8_LDA(At, 1, 0); PG8_STAGE(PG8_SA(0, 1), a2 + hstep, voffA);
            PG8_WAIT_L(8); PG8_BAR; PG8_WAIT_L(0); PG8_MMA(0, 0, At, B0); PG8_BAR; PG8_SCHED;
            PG8_LDB(B1, 1, 1); PG8_STAGE(PG8_SB(1, 0), b3, voffB);
            PG8_BAR; PG8_WAIT_L(0); PG8_MMA(0, 1, At, B1); PG8_BAR;
            PG8_LDA(At, 1, 1); PG8_STAGE(PG8_SA(1, 0), a3, voffA);
            PG8_BAR; PG8_WAIT_L(0); PG8_MMA(1, 0, At, B0); PG8_BAR; PG8_SCHED;
            PG8_STAGE(PG8_SB(1, 1), b3 + hstep, voffB);
            PG8_WAIT_V(6); PG8_BAR; PG8_MMA(1, 1, At, B1); PG8_BAR;
        }
        E(acc, cur, wr, wc, fr, fq);
        if (!has_next) break;
#pragma unroll
        for (int a = 0; a < 2; ++a)
#pragma unroll
            for (int b = 0; b < 2; ++b)
#pragma unroll
                for (int m = 0; m < 4; ++m)
#pragma unroll
                    for (int n = 0; n < 2; ++n) acc[a][b][m][n] = (f32x4){0.f, 0.f, 0.f, 0.f};
        cur = nxt; cA = nA; cB = nB; ++ui;
    }
    PG8_WAIT_V(0);
    if (wr == 0) PG8_BAR;
    PG8_BAR;
#undef PG8_SA
#undef PG8_SB
#undef PG8_STAGE
#undef PG8_LDA
#undef PG8_LDB
#undef PG8_MMA
#undef PG8_WAIT_V
#undef PG8_WAIT_L
#undef PG8_BAR
#undef PG8_SCHED
}

__device__ __forceinline__ float silu_f(float g) { return g * __builtin_amdgcn_rcpf(1.f + __expf(-g)); }
__device__ __forceinline__ float sigm_f(float g) { return __builtin_amdgcn_rcpf(1.f + __expf(-g)); }
struct EpiSwiGLU {
    static constexpr bool PERM = true;
    bf16_t* H;
    __device__ __forceinline__ void operator()(const f32x4 (&acc)[2][2][4][2], const Unit& u, int wr, int wc, int fr, int fq) const {
        const int row0 = u.pm * BM + wr * 64 + fr, col0 = u.pn * 128 + wc * 32 + 8 * fq;
#pragma unroll
        for (int ai = 0; ai < 2; ++ai)
#pragma unroll
            for (int m = 0; m < 4; ++m) { bf16_t* rowp = H + (size_t)(row0 + ai * HALF + m * 16) * DFF + col0;
                const f32x4 g0 = acc[ai][0][m][0], g1 = acc[ai][0][m][1], u0 = acc[ai][1][m][0], u1 = acc[ai][1][m][1];
                u32x4 w; w.x = cvtpk(silu_f(g0[0]) * u0[0], silu_f(g0[1]) * u0[1]); w.y = cvtpk(silu_f(g0[2]) * u0[2], silu_f(g0[3]) * u0[3]);
                w.z = cvtpk(silu_f(g1[0]) * u1[0], silu_f(g1[1]) * u1[1]); w.w = cvtpk(silu_f(g1[2]) * u1[2], silu_f(g1[3]) * u1[3]);
                *(u32x4*)rowp = w; }
    }
};
struct EpiResid {
    static constexpr bool PERM = false;
    float* X; const float* modg; float gs;
    __device__ __forceinline__ void operator()(const f32x4 (&acc)[2][2][4][2], const Unit& u, int wr, int wc, int fr, int fq) const {
        const int row0 = u.pm * BM + wr * 64 + fr, col0 = u.pn * BM + wc * 32 + 4 * fq;
        const int bi = u.pm < 64 ? (u.pm >> 3) : 8;
        const float* mg = modg + (size_t)bi * 9216 + col0;
        f32x4 gv[2][2];
#pragma unroll
        for (int bj = 0; bj < 2; ++bj)
#pragma unroll
            for (int n = 0; n < 2; ++n) gv[bj][n] = *(const f32x4*)(mg + bj * HALF + n * 16) * gs;
#pragma unroll
        for (int ai = 0; ai < 2; ++ai)
#pragma unroll
            for (int m = 0; m < 4; ++m) { float* rowp = X + (size_t)(row0 + ai * HALF + m * 16) * DM + col0;
#pragma unroll
                for (int bj = 0; bj < 2; ++bj)
#pragma unroll
                    for (int n = 0; n < 2; ++n) { f32x4* q = (f32x4*)(rowp + bj * HALF + n * 16); *q = *q + gv[bj][n] * acc[ai][bj][m][n]; } }
    }
};
struct EpiQKV {
    static constexpr bool PERM = true;
    bf16_t* QKV; bf16_t* GATES;
    __device__ __forceinline__ void operator()(const f32x4 (&acc)[2][2][4][2], const Unit& u, int wr, int wc, int fr, int fq) const {
        const int row0 = u.pm * BM + wr * 64 + fr;
        if (u.pn < 18) {
            const int col0 = u.pn * BM + wc * 32 + 8 * fq;
#pragma unroll
            for (int ai = 0; ai < 2; ++ai)
#pragma unroll
                for (int m = 0; m < 4; ++m) { bf16_t* rowp = QKV + (size_t)(row0 + ai * HALF + m * 16) * QKVW + col0;
#pragma unroll
                    for (int bj = 0; bj < 2; ++bj) { const f32x4 v0 = acc[ai][bj][m][0], v1 = acc[ai][bj][m][1];
                        u32x4 w; w.x = cvtpk(v0[0], v0[1]); w.y = cvtpk(v0[2], v0[3]); w.z = cvtpk(v1[0], v1[1]); w.w = cvtpk(v1[2], v1[3]);
                        *(u32x4*)(rowp + bj * HALF) = w; } }
        } else {
            const int col0 = (u.pn - 18) * BM + wc * 32 + 8 * fq;
#pragma unroll
            for (int ai = 0; ai < 2; ++ai)
#pragma unroll
                for (int m = 0; m < 4; ++m) { bf16_t* rowp = GATES + (size_t)(row0 + ai * HALF + m * 16) * GW + col0;
#pragma unroll
                    for (int bj = 0; bj < 2; ++bj) { const f32x4 v0 = acc[ai][bj][m][0], v1 = acc[ai][bj][m][1];
                        u32x4 w; w.x = cvtpk(sigm_f(v0[0]), sigm_f(v0[1])); w.y = cvtpk(sigm_f(v0[2]), sigm_f(v0[3])); w.z = cvtpk(sigm_f(v1[0]), sigm_f(v1[1])); w.w = cvtpk(sigm_f(v1[2]), sigm_f(v1[3]));
                        *(u32x4*)(rowp + bj * HALF) = w; } }
        }
    }
};
}

constexpr int LDQK = QKVW;
constexpr int SHM_V = 64 * 128 * 2, SHM_K = 64 * 128 * 2;
constexpr int ATT_WS_OFF = 2 * SHM_V + 2 * SHM_K, ATT_LUT_OFF = ATT_WS_OFF + 8 * 64 * 4;
#define KSWZ(row, colB) ((row) * 256 + ((colB) ^ (((row) & 7) << 4)))
#define SBAR() __builtin_amdgcn_sched_barrier(0)
__device__ __forceinline__ int crow(int r, int hi) { return (r & 3) + 8 * (r >> 2) + 4 * hi; }

template <int MODE>
__device__ __forceinline__ void partialSM(f32x16& p0, f32x16& p1, float& m_reg, float& mn, float& alpha, int relh, int relw_min, int relw_max, const float* lut) {
  if constexpr (MODE == 0) {
    constexpr float SCALE = 0.088388347648318440f, C = SCALE * LOG2E, THR = 8.f;
    float pmax = p0[0];
#pragma unroll
    for (int r = 1; r < 16; ++r) pmax = fmaxf(pmax, p0[r]);
#pragma unroll
    for (int r = 0; r < 16; ++r) pmax = fmaxf(pmax, p1[r]);
    { auto rr = __builtin_amdgcn_permlane32_swap(__float_as_uint(pmax), __float_as_uint(pmax), false, false);
      pmax = fmaxf(__uint_as_float(rr[0]), __uint_as_float(rr[1])); }
    if (__builtin_expect(__all(pmax - m_reg <= THR / SCALE), 1)) { mn = m_reg; alpha = 1.f; }
    else { mn = fmaxf(m_reg, pmax); alpha = __builtin_amdgcn_exp2f((m_reg - mn) * C); m_reg = mn; }
    const float mnC = -mn * C;
#pragma unroll
    for (int r = 0; r < 16; ++r) p0[r] = fmaf(p0[r], C, mnC);
#pragma unroll
    for (int r = 0; r < 16; ++r) p1[r] = fmaf(p1[r], C, mnC);
#pragma unroll
    for (int r = 0; r < 16; ++r) p0[r] = __builtin_amdgcn_exp2f(p0[r]);
  } else {
    constexpr float C = (MODE == 1 ? 0.088388347648318440f : 0.125f) * LOG2E, THR2 = 8.f * LOG2E;
    bool nearT = true; float cfar = 0.f;
    if constexpr (MODE >= 2) {
      if (relw_max <= -128) { nearT = false; cfar = lut[0]; }
      else if (relw_min >= 128) { nearT = false; cfar = lut[258]; }
      if (!nearT) {
        float pmax = p0[0];
#pragma unroll
        for (int r = 1; r < 16; ++r) pmax = fmaxf(pmax, p0[r]);
#pragma unroll
        for (int r = 0; r < 16; ++r) pmax = fmaxf(pmax, p1[r]);
        { auto rr = __builtin_amdgcn_permlane32_swap(__float_as_uint(pmax), __float_as_uint(pmax), false, false);
          pmax = fmaxf(__uint_as_float(rr[0]), __uint_as_float(rr[1])); }
        const float tmax = fmaf(pmax, C, cfar);
        if (__builtin_expect(__all(tmax - m_reg <= THR2), 1)) { mn = m_reg; alpha = 1.f; }
        else { mn = fmaxf(m_reg, tmax); alpha = __builtin_amdgcn_exp2f(m_reg - mn); m_reg = mn; }
        const float off = cfar - mn;
#pragma unroll
        for (int r = 0; r < 16; ++r) p0[r] = fmaf(p0[r], C, off);
#pragma unroll
        for (int r = 0; r < 16; ++r) p1[r] = fmaf(p1[r], C, off);
#pragma unroll
        for (int r = 0; r < 16; ++r) p0[r] = __builtin_amdgcn_exp2f(p0[r]);
        return;
      }
    }
    if (nearT) {
#pragma unroll
      for (int r = 0; r < 16; ++r) { const int i0 = relh + (r & 3) + 8 * (r >> 2);
        const int a0 = min(max(i0, -129), 129) + 129, a1 = min(max(i0 + 32, -129), 129) + 129;
        p0[r] = fmaf(p0[r], C, lut[a0]); p1[r] = fmaf(p1[r], C, lut[a1]); }
    } else {
#pragma unroll
      for (int r = 0; r < 16; ++r) { p0[r] = fmaf(p0[r], C, cfar); p1[r] = fmaf(p1[r], C, cfar); }
    }
    float pmax = p0[0];
#pragma unroll
    for (int r = 1; r < 16; ++r) pmax = fmaxf(pmax, p0[r]);
#pragma unroll
    for (int r = 0; r < 16; ++r) pmax = fmaxf(pmax, p1[r]);
    { auto rr = __builtin_amdgcn_permlane32_swap(__float_as_uint(pmax), __float_as_uint(pmax), false, false);
      pmax = fmaxf(__uint_as_float(rr[0]), __uint_as_float(rr[1])); }
    if (__builtin_expect(__all(pmax - m_reg <= THR2), 1)) { mn = m_reg; alpha = 1.f; }
    else { mn = fmaxf(m_reg, pmax); alpha = __builtin_amdgcn_exp2f(m_reg - mn); m_reg = mn; }
#pragma unroll
    for (int r = 0; r < 16; ++r) p0[r] = __builtin_amdgcn_exp2f(p0[r] - mn);
#pragma unroll
    for (int r = 0; r < 16; ++r) p1[r] = p1[r] - mn;
  }
}
__device__ __forceinline__ void finishSM(f32x16& p0, f32x16& p1, float alpha, float& l_reg, bf16x8& pa0, bf16x8& pa1, bf16x8& pa2, bf16x8& pa3) {
#pragma unroll
  for (int r = 0; r < 16; ++r) p1[r] = __builtin_amdgcn_exp2f(p1[r]);
  float ps = 0;
#pragma unroll
  for (int r = 0; r < 16; ++r) ps += p0[r];
#pragma unroll
  for (int r = 0; r < 16; ++r) ps += p1[r];
  { auto rr = __builtin_amdgcn_permlane32_swap(__float_as_uint(ps), __float_as_uint(ps), false, false);
    ps = __uint_as_float(rr[0]) + __uint_as_float(rr[1]); }
  l_reg = l_reg * alpha + ps;
#define PK4(P, BASE, OUT) do { unsigned a0 = cvtpk(P[BASE + 0], P[BASE + 1]), a1 = cvtpk(P[BASE + 2], P[BASE + 3]);   \
    unsigned b0 = cvtpk(P[BASE + 4], P[BASE + 5]), b1 = cvtpk(P[BASE + 6], P[BASE + 7]);                              \
    auto r0 = __builtin_amdgcn_permlane32_swap(a0, b0, false, false); auto r1 = __builtin_amdgcn_permlane32_swap(a1, b1, false, false); \
    u32x4 w = {r0[0], r1[0], r0[1], r1[1]}; OUT = *reinterpret_cast<bf16x8*>(&w); } while (0)
  PK4(p0, 0, pa0); PK4(p0, 8, pa1); PK4(p1, 0, pa2); PK4(p1, 8, pa3);
#undef PK4
}
template <int ND0, int DOFF>
__device__ __forceinline__ void qkt(f32x16& p0, f32x16& p1, const char* Ks, const bf16x8* qr, int r32, int hi) {
  p0 = f32x16{}; p1 = f32x16{};
#pragma unroll
  for (int d0 = 0; d0 < ND0; ++d0) { const int cb = ((d0 + DOFF) * 16 + hi * 8) * 2;
    bf16x8 b0 = *reinterpret_cast<const bf16x8*>(Ks + KSWZ(r32, cb));
    bf16x8 b1 = *reinterpret_cast<const bf16x8*>(Ks + KSWZ(32 + r32, cb));
    p0 = __builtin_amdgcn_mfma_f32_32x32x16_bf16(b0, qr[d0], p0, 0, 0, 0);
    p1 = __builtin_amdgcn_mfma_f32_32x32x16_bf16(b1, qr[d0], p1, 0, 0, 0); }
}
__device__ __forceinline__ int v_st(int k, int c) { const int kk = (k & ~0xC) | ((k & 4) << 1) | ((k & 8) >> 1); return ((kk >> 3) * 4 + (c >> 5)) * 512 + ((kk & 7) * 32 + (c & 31)) * 2; }
__device__ __forceinline__ int v_rd_base(int lane) { return ((lane & 3) << 3) | (((lane >> 2) & 3) << 6) | (((lane >> 4) & 1) << 5) | (((lane >> 5) & 1) << 8); }
constexpr int v_rd_off(int d0, int ks, int half) { return d0 * 512 + ks * 4096 + half * 2048; }
template <int OFF> __device__ __forceinline__ s16x4 tr_read(int vb) {
  s16x4 r; asm volatile("ds_read_b64_tr_b16 %0, %1 offset:%2" : "=&v"(r) : "v"(vb), "i"(OFF) : "memory"); return r;
}
template <int D0> __device__ __forceinline__ void pv_one(f32x16& od, int vb, bf16x8 pa0, bf16x8 pa1, bf16x8 pa2, bf16x8 pa3) {
  const s16x4 l0 = tr_read<v_rd_off(D0, 0, 0)>(vb), h0 = tr_read<v_rd_off(D0, 0, 1)>(vb), l1 = tr_read<v_rd_off(D0, 1, 0)>(vb), h1 = tr_read<v_rd_off(D0, 1, 1)>(vb);
  const s16x4 l2 = tr_read<v_rd_off(D0, 2, 0)>(vb), h2 = tr_read<v_rd_off(D0, 2, 1)>(vb), l3 = tr_read<v_rd_off(D0, 3, 0)>(vb), h3 = tr_read<v_rd_off(D0, 3, 1)>(vb);
  asm volatile("s_waitcnt lgkmcnt(0)" ::: "memory"); SBAR();
#define PK(L, H) (bf16x8){L[0], L[1], L[2], L[3], H[0], H[1], H[2], H[3]}
  od = __builtin_amdgcn_mfma_f32_32x32x16_bf16(pa0, PK(l0, h0), od, 0, 0, 0);
  od = __builtin_amdgcn_mfma_f32_32x32x16_bf16(pa1, PK(l1, h1), od, 0, 0, 0);
  od = __builtin_amdgcn_mfma_f32_32x32x16_bf16(pa2, PK(l2, h2), od, 0, 0, 0);
  od = __builtin_amdgcn_mfma_f32_32x32x16_bf16(pa3, PK(l3, h3), od, 0, 0, 0);
#undef PK
}
__device__ __forceinline__ void pv_d0(f32x16* o, int vb, bf16x8 pa0, bf16x8 pa1, bf16x8 pa2, bf16x8 pa3) {
  pv_one<0>(o[0], vb, pa0, pa1, pa2, pa3); pv_one<1>(o[1], vb, pa0, pa1, pa2, pa3); pv_one<2>(o[2], vb, pa0, pa1, pa2, pa3); pv_one<3>(o[3], vb, pa0, pa1, pa2, pa3);
}

struct AttnEpi {
  const bf16_t* gate;
  float* park;
  bf16_t* merged;
  const float* gsub;
  float lam, oml;
  float sinkl2;
};

template <int MODE>
__device__ __forceinline__ void attn_body(const bf16_t* __restrict__ Qb, const bf16_t* __restrict__ Kh, const bf16_t* __restrict__ Vh, int NT, int krel0,
                                          char* lds, const float* __restrict__ lutg, const AttnEpi& E) {
  constexpr int ND0 = (MODE < 2) ? 8 : 4, DOFF = (MODE == 3) ? 4 : 0;
  int tid_ = threadIdx.x; asm volatile("" : "+v"(tid_));
  const int tid = tid_, wid = tid >> 6, lane = tid & 63, r32 = lane & 31, hi = lane >> 5;
  char* V_lds = lds; char* K_lds = lds + 2 * SHM_V;
  float* wsm = (float*)(lds + ATT_WS_OFF) + wid * 64; float* li_l = wsm; float* al_l = wsm + 32;
  float* lut = (float*)(lds + ATT_LUT_OFF);
  __syncthreads();
  if constexpr (MODE != 0) { if (tid < 259) lut[tid] = lutg[tid]; }
  float m_reg = -1e30f, l_reg = 0; f32x16 o[4] = {}; bf16x8 qr[ND0];
  const bf16_t* Qw = Qb + (size_t)(wid * 32 + r32) * LDQK + hi * 8;
#pragma unroll
  for (int d0 = 0; d0 < ND0; ++d0) qr[d0] = *reinterpret_cast<const bf16x8*>(Qw + d0 * 16);
  const int sr = tid >> 4, sc = (tid & 15) * 8, vst0 = v_st(sr, sc), vst1 = v_st(32 + sr, sc);
  const int vb0 = (int)(uintptr_t)V_lds + v_rd_base(lane);
  struct { bf16x8 vs0, vs1, ks0, ks1; } sr_[2];
#define SLOAD(i, k0) do { sr_[i].vs0 = *reinterpret_cast<const bf16x8*>(&Vh[(size_t)((k0) + sr) * LDQK + sc]); sr_[i].vs1 = *reinterpret_cast<const bf16x8*>(&Vh[(size_t)((k0) + 32 + sr) * LDQK + sc]); \
    sr_[i].ks0 = *reinterpret_cast<const bf16x8*>(&Kh[(size_t)((k0) + sr) * LDQK + sc]); sr_[i].ks1 = *reinterpret_cast<const bf16x8*>(&Kh[(size_t)((k0) + 32 + sr) * LDQK + sc]); } while (0)
#define SWRITE(b, i) do { *(bf16x8*)(V_lds + (b) * SHM_V + vst0) = sr_[i].vs0;          \
    *(bf16x8*)(V_lds + (b) * SHM_V + vst1) = sr_[i].vs1; int kc = sc * 2;               \
    *(bf16x8*)(K_lds + (b) * SHM_K + KSWZ(sr, kc)) = sr_[i].ks0;                       \
    *(bf16x8*)(K_lds + (b) * SHM_K + KSWZ(32 + sr, kc)) = sr_[i].ks1; } while (0)
#define SWAIT() asm volatile("s_waitcnt vmcnt(4)" ::: "memory")
#define RESC(a) do { if (__any((a) < 1.f)) { if (hi == 0) al_l[r32] = (a); asm volatile("s_waitcnt lgkmcnt(0)" ::: "memory"); \
    _Pragma("unroll") for (int d = 0; d < 4; ++d) _Pragma("unroll") for (int r = 0; r < 16; ++r) o[d][r] *= al_l[crow(r, hi)]; } } while (0)
  const int relq = krel0 - (wid * 32 + r32) + 4 * hi, relwmin = krel0 - (wid * 32 + 31), relwmax = krel0 + 63 - wid * 32;
#define PSM(P0, P1, MN, AL, J) partialSM<MODE>(P0, P1, m_reg, MN, AL, relq + 64 * (J), relwmin + 64 * (J), relwmax + 64 * (J), lut)
  f32x16 pA0, pA1, pB0, pB1; float mnA, mnB, alA, alB; bf16x8 pa0, pa1, pa2, pa3;
  constexpr int SE = 0, SO = 1;
  SLOAD(SE, 0); asm volatile("s_waitcnt vmcnt(0)" ::: "memory"); SWRITE(0, SE); __syncthreads();
  qkt<ND0, DOFF>(pA0, pA1, K_lds, qr, r32, hi); PSM(pA0, pA1, mnA, alA, 0);
  SLOAD(SO, 64); if (2 < NT) SLOAD(SE, 2 * 64);
  SWAIT(); SWRITE(1, SO); __syncthreads();
  for (int j = 1; j + 1 < NT; j += 2) {
    SBAR(); qkt<ND0, DOFF>(pB0, pB1, K_lds + SHM_K, qr, r32, hi);
    finishSM(pA0, pA1, alA, l_reg, pa0, pa1, pa2, pa3); SBAR();
    SLOAD(SO, (j + 2) * 64); SBAR();
    pv_d0(o, vb0, pa0, pa1, pa2, pa3); PSM(pB0, pB1, mnB, alB, j);
    __syncthreads(); SWAIT(); SWRITE(0, SE);
    RESC(alB); __syncthreads();
    SBAR(); qkt<ND0, DOFF>(pA0, pA1, K_lds, qr, r32, hi);
    finishSM(pB0, pB1, alB, l_reg, pa0, pa1, pa2, pa3); SBAR();
    if (j + 3 < NT) SLOAD(SE, (j + 3) * 64); SBAR();
    pv_d0(o, vb0 + SHM_V, pa0, pa1, pa2, pa3); PSM(pA0, pA1, mnA, alA, j + 1);
    __syncthreads(); SWAIT(); SWRITE(1, SO);
    RESC(alA); __syncthreads();
  }
  SBAR(); qkt<ND0, DOFF>(pB0, pB1, K_lds + SHM_K, qr, r32, hi);
  finishSM(pA0, pA1, alA, l_reg, pa0, pa1, pa2, pa3); SBAR();
  pv_d0(o, vb0, pa0, pa1, pa2, pa3); PSM(pB0, pB1, mnB, alB, NT - 1);
  __syncthreads(); RESC(alB);
  finishSM(pB0, pB1, alB, l_reg, pa0, pa1, pa2, pa3); SBAR();
  pv_d0(o, vb0 + SHM_V, pa0, pa1, pa2, pa3);
  if constexpr (MODE == 1) l_reg += __builtin_amdgcn_exp2f(E.sinkl2 - m_reg);
  if (hi == 0) li_l[r32] = l_reg; asm volatile("s_waitcnt lgkmcnt(0)" ::: "memory");
  float rli[16];
#pragma unroll
  for (int r = 0; r < 16; ++r) rli[r] = __builtin_amdgcn_rcpf(li_l[crow(r, hi)]);
  float* pk0 = E.park; float* pk1 = E.park + 64 * 512;
  const int rowb = wid * 32;
  if constexpr (MODE == 0 || MODE == 1) {
#pragma unroll
    for (int r = 0; r < 16; ++r) { const int row = rowb + crow(r, hi);
#pragma unroll
      for (int d0 = 0; d0 < 4; ++d0) { const int idx = (d0 * 16 + r) * 512 + tid;
        const float g = bf2f(E.gate[(size_t)row * GW + d0 * 32 + r32]);
        const float v = o[d0][r] * rli[r] * g;
        if constexpr (MODE == 0) pk0[idx] = v; else pk0[idx] += v; } }
  } else if constexpr (MODE == 2) {
#pragma unroll
    for (int r = 0; r < 16; ++r)
#pragma unroll
      for (int d0 = 0; d0 < 4; ++d0) pk1[(d0 * 16 + r) * 512 + tid] = o[d0][r] * rli[r];
  } else {
    float gs[4];
#pragma unroll
    for (int d0 = 0; d0 < 4; ++d0) gs[d0] = E.gsub[d0 * 32 + r32] * E.oml;
#pragma unroll
    for (int r = 0; r < 16; ++r) { const int row = rowb + crow(r, hi);
      float ss = 0.f;
#pragma unroll
      for (int d0 = 0; d0 < 4; ++d0) { const float c = pk1[(d0 * 16 + r) * 512 + tid] - E.lam * (o[d0][r] * rli[r]); o[d0][r] = c; ss += c * c; }
      ss += __shfl_xor(ss, 1); ss += __shfl_xor(ss, 2); ss += __shfl_xor(ss, 4); ss += __shfl_xor(ss, 8); ss += __shfl_xor(ss, 16);
      const float rs = rsqrtf(ss * (1.f / 128.f) + EPS);
#pragma unroll
      for (int d0 = 0; d0 < 4; ++d0) { const int col = d0 * 32 + r32;
        const float g = bf2f(E.gate[(size_t)row * GW + col]);
        const float y = o[d0][r] * rs * gs[d0] * g + pk0[(d0 * 16 + r) * 512 + tid];
        E.merged[(size_t)row * DM + col] = (bf16_t)(cvtpk(y, y) & 0xffffu); } }
  }
#undef SLOAD
#undef SWRITE
#undef SWAIT
#undef RESC
#undef PSM
}

__device__ __forceinline__ int t5bucket(int rel) {
  const int n = rel < 0 ? -rel : rel;
  const int b = n < 8 ? n : 8 + (n >= 12) + (n >= 16) + (n >= 23) + (n >= 32) + (n >= 46) + (n >= 64) + (n >= 91);
  return b + (rel > 0 ? 16 : 0);
}
__device__ __forceinline__ float wave_sum(float v) {
  v += __shfl_xor(v, 1); v += __shfl_xor(v, 2); v += __shfl_xor(v, 4); v += __shfl_xor(v, 8); v += __shfl_xor(v, 16); v += __shfl_xor(v, 32); return v;
}

__device__ __forceinline__ void phase_setup(const Params& p, unsigned char* shm) {
  int tid_ = threadIdx.x; asm volatile("" : "+v"(tid_)); const int tid = tid_, nb = gridDim.x, bid = blockIdx.x, wid = tid >> 6, lane = tid & 63;
  {
    const float4* s0 = (const float4*)p.in[0]; const float4* s1 = (const float4*)p.in[1]; float4* o = (float4*)p.out;
    const size_t n4 = (size_t)16384 * 1024 / 4;
    for (size_t i = (size_t)bid * 512 + tid; i < 2 * n4; i += (size_t)nb * 512) o[i] = i < n4 ? s0[i] : s1[i - n4];
  }
  {
    float* rope = (float*)(p.ws + WS_ROPE);
    for (int i = bid * 512 + tid; i < 256 * 32; i += nb * 512) { const int pos = i >> 5, f = i & 31;
      const float inv = powf(10000.f, -(float)f / 32.f); const float ang = (float)pos * inv; rope[2 * i] = cosf(ang); rope[2 * i + 1] = sinf(ang); }
    float* lut = (float*)(p.ws + WS_LUT);
    for (int i = bid * 512 + tid; i < 16 * 259; i += nb * 512) { const int hh = i / 259, e = i % 259; int rel = e - 129; float v;
      if (hh < 8) { v = (rel < -128 || rel > 128) ? NEGBIG : p.in[23][t5bucket(rel) * 16 + hh] * LOG2E; }
      else { rel = rel < -128 ? -128 : (rel > 128 ? 128 : rel); v = p.in[23][t5bucket(rel) * 16 + hh] * LOG2E; }
      lut[i] = v; }
    if (bid == 0 && tid < 4) { const int l = tid; float s1 = 0.f, s2 = 0.f;
      for (int i = 0; i < 64; ++i) { s1 += p.in[18][l * 64 + i] * p.in[19][l * 64 + i]; s2 += p.in[20][l * 64 + i] * p.in[21][l * 64 + i]; }
      const float lam_init = 0.8f - 0.6f * expf(-0.3f * (float)l);
      float* lam = (float*)(p.ws + WS_LAM); lam[2 * l] = expf(s1) - expf(s2) + lam_init; lam[2 * l + 1] = 1.f - lam_init; }
  }
  {
    float* sc = (float*)shm; float* red = sc + 9 * 1024;
    for (int i = tid; i < 9 * 1024; i += 512) { const float c = i < 8192 ? p.in[2][i] : p.in[3][i - 8192]; sc[i] = c / (1.f + expf(-c)); }
    __syncthreads();
    float* mod = (float*)(p.ws + WS_MOD);
    for (int task = bid; task < 576; task += nb) {
      const int l = task / 144, j0 = (task % 144) * 64;
      const float* w = p.in[4] + (size_t)l * 1024 * 9216 + j0 + lane;
      float a0 = 0, a1 = 0, a2 = 0, a3 = 0, a4 = 0, a5 = 0, a6 = 0, a7 = 0, a8 = 0;
#pragma unroll 16
      for (int k = wid * 128; k < wid * 128 + 128; ++k) { const float wv = w[(size_t)k * 9216];
        a0 += sc[k] * wv; a1 += sc[1024 + k] * wv; a2 += sc[2048 + k] * wv; a3 += sc[3072 + k] * wv; a4 += sc[4096 + k] * wv;
        a5 += sc[5120 + k] * wv; a6 += sc[6144 + k] * wv; a7 += sc[7168 + k] * wv; a8 += sc[8192 + k] * wv; }
      float* rw = red + wid * 9 * 64 + lane;
      rw[0] = a0; rw[64] = a1; rw[128] = a2; rw[192] = a3; rw[256] = a4; rw[320] = a5; rw[384] = a6; rw[448] = a7; rw[512] = a8;
      __syncthreads();
      for (int i = tid; i < 9 * 64; i += 512) { const int b = i >> 6, ln = i & 63; float s = 0.f;
#pragma unroll
        for (int w8 = 0; w8 < 8; ++w8) s += red[w8 * 9 * 64 + b * 64 + ln];
        mod[((size_t)l * 9 + b) * 9216 + j0 + ln] = s + p.in[5][l * 9216 + j0 + ln]; }
      __syncthreads();
    }
  }
}

__device__ __forceinline__ void phase_convert(const Params& p, int l, unsigned char* shm) {
  float* tile = (float*)shm;
  int tid_ = threadIdx.x; asm volatile("" : "+v"(tid_)); const int tid = tid_;
  for (int q = blockIdx.x; q < 6400; q += gridDim.x) {
    const float* W; bf16_t* Bt; int N, K, k0, n0d, n0s;
    if (q < 2816) { const int i = q / 1408, qq = q % 1408; W = p.in[7] + (size_t)(l * 2 + i) * 1024 * 5632; Bt = (bf16_t*)(p.ws + (i ? WB_FFIN1 : WB_FFIN0)); N = 5632; K = 1024;
      k0 = (qq & 15) * 64; n0d = (qq >> 4) * 64; n0s = ((n0d >> 7) & 1) * 2816 + (n0d >> 8) * 128 + (n0d & 127); }
    else if (q < 4224) { const int i = (q - 2816) / 704, qq = (q - 2816) % 704; W = p.in[8] + (size_t)(l * 2 + i) * 2816 * 1024; Bt = (bf16_t*)(p.ws + (i ? WB_FFOUT1 : WB_FFOUT0)); N = 1024; K = 2816;
      k0 = (qq % 44) * 64; n0d = (qq / 44) * 64; n0s = n0d; }
    else if (q < 6144) { const int qq = q - 4224; W = p.in[9] + (size_t)l * 1024 * 7680; Bt = (bf16_t*)(p.ws + WB_WIN); N = 7680; K = 1024;
      k0 = (qq & 15) * 64; n0d = (qq >> 4) * 64; n0s = n0d; }
    else { const int qq = q - 6144; W = p.in[10] + (size_t)l * 1024 * 1024; Bt = (bf16_t*)(p.ws + WB_WO); N = 1024; K = 1024;
      k0 = (qq & 15) * 64; n0d = (qq >> 4) * 64; n0s = n0d; }
    { const int nl = tid & 63, ks = tid >> 6;
#pragma unroll
      for (int i = 0; i < 8; ++i) { const int k = ks + 8 * i; tile[nl * 65 + k] = W[(size_t)(k0 + k) * N + n0s + nl]; } }
    __syncthreads();
    { const int n = tid >> 3, kc = (tid & 7) * 8; const float* tr = tile + n * 65 + kc;
      u32x4 w; w.x = cvtpk(tr[0], tr[1]); w.y = cvtpk(tr[2], tr[3]); w.z = cvtpk(tr[4], tr[5]); w.w = cvtpk(tr[6], tr[7]);
      *(u32x4*)(Bt + (size_t)(n0d + n) * K + k0 + kc) = w; }
    __syncthreads();
  }
}

__device__ __forceinline__ void phase_norm(const float* __restrict__ x, const float* __restrict__ g, const float* __restrict__ modl, int jj, bf16_t* __restrict__ xn) {
  int tid_ = threadIdx.x; asm volatile("" : "+v"(tid_)); const int tid = tid_, wid = tid >> 6, lane = tid & 63;
  for (int row = blockIdx.x * 8 + wid; row < T_TOK; row += gridDim.x * 8) {
    const int bi = row < 16384 ? (row >> 11) : 8;
    const float* shift = modl + (size_t)bi * 9216 + (3 * jj) * 1024; const float* scale = shift + 1024;
    const float4* xr = (const float4*)(x + (size_t)row * DM);
    float4 v[4]; float ss = 0.f;
#pragma unroll
    for (int i = 0; i < 4; ++i) { v[i] = xr[lane + 64 * i]; ss += v[i].x * v[i].x + v[i].y * v[i].y + v[i].z * v[i].z + v[i].w * v[i].w; }
    ss = wave_sum(ss);
    const float rs = rsqrtf(ss * (1.f / 1024.f) + EPS);
#pragma unroll
    for (int i = 0; i < 4; ++i) { const int c4 = lane + 64 * i;
      const float4 gg = ((const float4*)g)[c4], sc = ((const float4*)scale)[c4], sh = ((const float4*)shift)[c4];
      const float y0 = v[i].x * rs * gg.x * (1.f + sc.x) + sh.x, y1 = v[i].y * rs * gg.y * (1.f + sc.y) + sh.y;
      const float y2 = v[i].z * rs * gg.z * (1.f + sc.z) + sh.z, y3 = v[i].w * rs * gg.w * (1.f + sc.w) + sh.w;
      u32x2 w; w.x = cvtpk(y0, y1); w.y = cvtpk(y2, y3);
      *(u32x2*)(xn + (size_t)row * DM + c4 * 4) = w; }
  }
}

__device__ __forceinline__ void phase_qknorm(const Params& p, int l) {
  bf16_t* qkv = (bf16_t*)(p.ws + WS_QKV); const float* rope = (const float*)(p.ws + WS_ROPE);
  int tid_ = threadIdx.x; asm volatile("" : "+v"(tid_)); const int tid = tid_, wid = tid >> 6, lane = tid & 63;
  f32x2 gq[3], gk[3];
  gq[0] = *(const f32x2*)(p.in[11] + l * 128 + 2 * lane); gk[0] = *(const f32x2*)(p.in[12] + l * 128 + 2 * lane);
  gq[1] = *(const f32x2*)(p.in[13] + l * 128 + 2 * lane); gk[1] = *(const f32x2*)(p.in[14] + l * 128 + 2 * lane);
  gq[2] = *(const f32x2*)(p.in[15] + l * 64 + ((2 * lane) & 63)); gk[2] = *(const f32x2*)(p.in[16] + l * 64 + ((2 * lane) & 63));
  const float sg = (lane & 16) ? 1.f : -1.f;
  for (int tok = blockIdx.x * 8 + wid; tok < T_TOK; tok += gridDim.x * 8) {
    unsigned* base = (unsigned*)(qkv + (size_t)tok * QKVW) + lane;
    unsigned u[30];
#pragma unroll
    for (int s = 0; s < 30; ++s) u[s] = base[((s / 10) * 1536 + (s % 10) * 128) / 2];
    const int sp = tok < 16384 ? (tok & 2047) : (tok - 16384);
    const int pos = lane < 32 ? (sp >> 6) : (sp & 63);
    const f32x4 cs = *(const f32x4*)(rope + (size_t)(pos * 32 + ((2 * lane) & 31)) * 2);
#pragma unroll
    for (int s = 0; s < 30; ++s) {
      const int br = s / 10, hs = s % 10;
      float a = bf_lo(u[s]), b = bf_hi(u[s]);
      float ss = a * a + b * b;
      ss += __shfl_xor(ss, 1); ss += __shfl_xor(ss, 2); ss += __shfl_xor(ss, 4); ss += __shfl_xor(ss, 8); ss += __shfl_xor(ss, 16);
      float rs;
      if (br < 2) { ss += __shfl_xor(ss, 32); rs = rsqrtf(ss * (1.f / 128.f) + EPS); }
      else rs = rsqrtf(ss * (1.f / 64.f) + EPS);
      const f32x2 g = hs < 8 ? gq[br] : gk[br];
      a = a * rs * g[0]; b = b * rs * g[1];
      if (br == 0) {
        const float pa = __shfl_xor(a, 16), pb = __shfl_xor(b, 16);
        a = a * cs[0] + sg * pa * cs[1]; b = b * cs[2] + sg * pb * cs[3];
      }
      base[(br * 1536 + hs * 128) / 2] = cvtpk(a, b);
    }
  }
}

__device__ __forceinline__ void phase_attn(const Params& p, int l, unsigned char* shm) {
  const bf16_t* qkv = (const bf16_t*)(p.ws + WS_QKV); const bf16_t* gates = (const bf16_t*)(p.ws + WS_GATES);
  bf16_t* merged = (bf16_t*)(p.ws + WS_XN);
  const float* lutall = (const float*)(p.ws + WS_LUT); const float* lamp = (const float*)(p.ws + WS_LAM);
  AttnEpi E; E.park = (float*)(p.ws + WS_PARK) + (size_t)blockIdx.x * 65536; E.gsub = p.in[22] + l * 128; E.lam = lamp[2 * l]; E.oml = lamp[2 * l + 1];
  for (int it = blockIdx.x; it < 1024; it += gridDim.x) {
    int S, tok0, h, qb;
    if (it < 512) { S = 16384; tok0 = 16384; h = it & 7; qb = it >> 3; }
    else { const int j = it - 512; S = 2048; h = j & 7; qb = (j >> 3) & 7; tok0 = (j >> 6) * 2048; }
    const int g = h >> 2, q0 = qb * 256;
    const bf16_t* rowQ = qkv + (size_t)(tok0 + q0) * QKVW; const bf16_t* seqK = qkv + (size_t)tok0 * QKVW;
    const bf16_t* grow = gates + (size_t)(tok0 + q0) * GW + h * 128;
    E.merged = merged + (size_t)(tok0 + q0) * DM + h * 128; E.sinkl2 = p.in[17][l * 8 + h] * LOG2E;
    E.gate = grow;
    attn_body<0>(rowQ + h * 128, seqK + 1024 + g * 128, seqK + 1280 + g * 128, S / 64, 0, (char*)shm, lutall, E);
    { const int t_lo = max(0, 4 * qb - 2), t_hi = min(S / 64, 4 * qb + 6);
      const bf16_t* kb = seqK + (size_t)t_lo * 64 * QKVW;
      E.gate = grow + 1024;
      attn_body<1>(rowQ + 1536 + h * 128, kb + 2560 + g * 128, kb + 2816 + g * 128, t_hi - t_lo, t_lo * 64 - q0, (char*)shm, lutall + h * 259, E); }
    E.gate = grow + 2048;
    attn_body<2>(rowQ + 3072 + h * 128, seqK + 4096 + g * 128, seqK + 4352 + g * 128, S / 64, -q0, (char*)shm, lutall + (8 + h) * 259, E);
    attn_body<3>(rowQ + 3072 + h * 128 + 64, seqK + 4096 + g * 128, seqK + 4352 + g * 128, S / 64, -q0, (char*)shm, lutall + (8 + h) * 259, E);
  }
}

__device__ __forceinline__ void gsync(cg::grid_group& g) {
  asm volatile("s_waitcnt vmcnt(0) lgkmcnt(0)" ::: "memory");
  g.sync();
  __builtin_amdgcn_fence(__ATOMIC_ACQUIRE, "agent");
  asm volatile("s_waitcnt vmcnt(0)" ::: "memory");
}
#define XB_TMO      128
#define XB_XCNT(j)  (256  + 64 * (j))
#define XB_XSUB(j)  (1280 + 64 * (j))
#define XB_XGEN(j)  (2304 + 64 * (j))
#define XB_TOP      3328
#define XB_TOPGEN   3392
#define XCD_BAR_WORDS 3456
#define XB_SPIN_CAP (1u << 22)
__device__ __forceinline__ unsigned xb_ld(unsigned* p)              { return __hip_atomic_load(p, __ATOMIC_RELAXED, __HIP_MEMORY_SCOPE_AGENT); }
__device__ __forceinline__ unsigned xb_add(unsigned* p, unsigned v) { return __hip_atomic_fetch_add(p, v, __ATOMIC_RELAXED, __HIP_MEMORY_SCOPE_AGENT); }
__device__ __forceinline__ unsigned xb_xcc_id() { return (unsigned)__builtin_amdgcn_s_getreg((3 << 11) | 20) & 0xFu; }
#define XB_SPIN(cond, bar) do { unsigned _sp = 0; while (cond) { __builtin_amdgcn_s_sleep(1); \
    if ((++_sp & 255u) == 0u) { if (xb_ld(&(bar)[XB_TMO])) break; if (_sp > XB_SPIN_CAP) { atomicAdd(&(bar)[XB_TMO], 1u); break; } } } } while (0)
struct XcdBarrier { unsigned* bar; unsigned x; volatile LAS unsigned* st; };
__device__ __forceinline__ XcdBarrier xcd_barrier_post(unsigned* bar, volatile LAS unsigned* st) {
    XcdBarrier b; b.bar = bar; b.x = xb_xcc_id(); b.st = st;
    if (threadIdx.x == 0) (void)xb_add(&bar[XB_XCNT(b.x)], 1u);
    return b;
}
__device__ __forceinline__ void xcd_barrier_complete(unsigned* bar, unsigned x, unsigned& nloc, unsigned& nx) {
    const unsigned G = gridDim.x * gridDim.y * gridDim.z;
    unsigned sum, cnt, mine, sp = 0u;
    for (;;) {
        sum = 0u; cnt = 0u; mine = 0u;
#pragma unroll
        for (unsigned j = 0; j < 16; ++j) { const unsigned c = xb_ld(&bar[XB_XCNT(j)]); sum += c; cnt += (c > 0u) ? 1u : 0u; mine = (j == x) ? c : mine; }
        if (sum == G) break;
        __builtin_amdgcn_s_sleep(1);
        if ((++sp & 255u) == 0u) { if (xb_ld(&bar[XB_TMO])) break; if (sp > XB_SPIN_CAP) { atomicAdd(&bar[XB_TMO], 1u); break; } }
    }
    nloc = mine > 0u ? mine : 1u; nx = cnt > 0u ? cnt : 1u;
}
__device__ __forceinline__ void xcd_barrier(const XcdBarrier& b) {
    asm volatile("s_waitcnt vmcnt(0)" ::: "memory");
    __syncthreads();
    if (threadIdx.x == 0) {
        unsigned* bar = b.bar;
        __builtin_amdgcn_s_waitcnt(0);
        unsigned nloc = b.st[0], nx = b.st[1];
        if (nloc == 0u) { xcd_barrier_complete(bar, b.x, nloc, nx); b.st[0] = nloc; b.st[1] = nx; }
        const unsigned old = xb_add(&bar[XB_XSUB(b.x)], 1u);
        const unsigned gen = old / nloc;
        if (old + 1u == (gen + 1u) * nloc) {
            __builtin_amdgcn_fence(__ATOMIC_RELEASE, "agent");
            asm volatile("s_waitcnt vmcnt(0)" ::: "memory");
            const unsigned og = xb_add(&bar[XB_TOP], 1u);
            const unsigned tg = og / nx;
            if (og + 1u == (tg + 1u) * nx) xb_add(&bar[XB_TOPGEN], 1u);
            else XB_SPIN(xb_ld(&bar[XB_TOPGEN]) == tg, bar);
            __builtin_amdgcn_fence(__ATOMIC_ACQUIRE, "agent");
            xb_add(&bar[XB_XGEN(b.x)], 1u);
            asm volatile("s_waitcnt vmcnt(0)" ::: "memory");
        } else {
            XB_SPIN(xb_ld(&bar[XB_XGEN(b.x)]) == gen, bar);
            __builtin_amdgcn_fence(__ATOMIC_ACQUIRE, "agent");
            asm volatile("s_waitcnt vmcnt(0)" ::: "memory");
        }
    }
    __syncthreads();
}

constexpr int N_PHASES = 45;
__global__ void __launch_bounds__(512) mega_fwd(Params p, int ph_lo, int ph_hi) {
  extern __shared__ __attribute__((aligned(16))) unsigned char shm[];
  cg::grid_group grid = cg::this_grid();
  LAS unsigned char* lds3 = (LAS unsigned char*)shm;
  float* X = p.out;
  bf16_t* XN = (bf16_t*)(p.ws + WS_XN); bf16_t* Hb = (bf16_t*)(p.ws + WS_QKV);
  pg8::StaticOrder S;
  volatile LAS unsigned* xst = (volatile LAS unsigned*)(lds3 + 131072);
  if (threadIdx.x == 0) { xst[0] = 0u; xst[1] = 0u; }
  unsigned* xbar = (unsigned*)(p.ws + WS_BAR);
  XcdBarrier xb; xb.bar = xbar; xb.x = 0u; xb.st = xst;
#pragma unroll 1
  for (int ph = ph_lo; ph < ph_hi; ++ph) {
    if (ph == 0) { if (blockIdx.x == 0) for (int i = threadIdx.x; i < XCD_BAR_WORDS; i += 512) xbar[i] = 0u;
      phase_setup(p, shm); }
    else {
      const int l = (ph - 1) / 11, k = (ph - 1) % 11;
      const float* modl = (const float*)(p.ws + WS_MOD) + (size_t)l * 9 * 9216;
      if (k == 0 || k == 3 || k == 8) {
        if (k == 0) phase_convert(p, l, shm);
        const int jj = k == 0 ? 0 : (k == 3 ? 1 : 2);
        phase_norm(X, p.in[6] + (size_t)(l * 3 + jj) * 1024, modl, jj, XN);
      } else if (k == 1 || k == 9) {
        pg8::Gemm g{XN, (const bf16_t*)(p.ws + (k == 9 ? WB_FFIN1 : WB_FFIN0)), T_TOK, NFF2, DM};
        S.init(T_TOK, NFF2, gridDim.x, blockIdx.x); pg8::EpiSwiGLU E{Hb}; pg8::gemm_phase(lds3, g, S, E);
      } else if (k == 2 || k == 10 || k == 7) {
        const bool wo = (k == 7);
        pg8::Gemm g{wo ? XN : Hb, (const bf16_t*)(p.ws + (wo ? WB_WO : (k == 10 ? WB_FFOUT1 : WB_FFOUT0))), T_TOK, DM, wo ? DM : DFF};
        S.init(T_TOK, DM, gridDim.x, blockIdx.x); pg8::EpiResid E{X, modl + (wo ? 5 : (k == 10 ? 8 : 2)) * 1024, wo ? 1.0f : 0.5f}; pg8::gemm_phase(lds3, g, S, E);
      } else if (k == 4) {
        pg8::Gemm g{XN, (const bf16_t*)(p.ws + WB_WIN), T_TOK, WINC, DM};
        S.init(T_TOK, WINC, gridDim.x, blockIdx.x); pg8::EpiQKV E{(bf16_t*)(p.ws + WS_QKV), (bf16_t*)(p.ws + WS_GATES)}; pg8::gemm_phase(lds3, g, S, E);
      } else if (k == 5) { phase_qknorm(p, l); }
      else { phase_attn(p, l, shm); }
    }
    if (ph + 1 < ph_hi) {
      if (ph == 0) { gsync(grid); xb = xcd_barrier_post(xbar, xst); }
      else xcd_barrier(xb);
    }
  }
}

#ifndef N_LAUNCH_MODE
#define N_LAUNCH_MODE 1
#endif
extern "C" void kernel_launch(void* const* d_in, const int* in_sizes, int n_in, void* d_out, int out_size, void* d_ws, size_t ws_size, hipStream_t stream) {
  static int grid = 0;
  if (grid == 0) {
    if (n_in != 24 || out_size != T_TOK * DM || ws_size < WS_END2) { fprintf(stderr, "kernel_launch: unexpected shapes (n_in %d out %d ws %zu need %zu)\n", n_in, out_size, ws_size, (size_t)WS_END2); grid = -1; return; }
    int dev = 0, cus = 0, per_cu = 0;
    (void)hipGetDevice(&dev); (void)hipDeviceGetAttribute(&cus, hipDeviceAttributeMultiprocessorCount, dev);
    if (hipFuncSetAttribute((const void*)mega_fwd, hipFuncAttributeMaxDynamicSharedMemorySize, LDS_BYTES) != hipSuccess) { fprintf(stderr, "kernel_launch: hipFuncSetAttribute failed\n"); grid = -1; return; }
    if (hipOccupancyMaxActiveBlocksPerMultiprocessor(&per_cu, (const void*)mega_fwd, 512, LDS_BYTES) != hipSuccess || per_cu < 1) { fprintf(stderr, "kernel_launch: occupancy query gave %d\n", per_cu); per_cu = 1; }
    (void)hipGetLastError();
    grid = cus;
  }
  if (grid < 0) return;
  Params p{};
  for (int i = 0; i < 24; ++i) p.in[i] = (const float*)d_in[i];
  p.out = (float*)d_out; p.ws = (unsigned char*)d_ws;
#if N_LAUNCH_MODE == 1
  int lo = 0, hi = N_PHASES;
  void* args[] = {&p, &lo, &hi};
  hipError_t e = hipLaunchCooperativeKernel((const void*)mega_fwd, dim3(grid), dim3(512), args, LDS_BYTES, stream);
  if (e != hipSuccess) fprintf(stderr, "kernel_launch: cooperative launch failed: %s (grid %d)\n", hipGetErrorString(e), grid);
#else
  for (int ph = 0; ph < N_PHASES; ++ph) hipLaunchKernelGGL(mega_fwd, dim3(grid), dim3(512), LDS_BYTES, stream, p, ph, ph + 1);
#endif
}
```

```cpp
#include <hip/hip_runtime.h>
#include <hip/hip_bf16.h>
#include <hip/hip_cooperative_groups.h>
#include <cstdio>
#include <cstdint>
#define N_LAUNCH_MODE 1
namespace cg = cooperative_groups;

typedef unsigned short bf16_t;
typedef short bf16x8 __attribute__((ext_vector_type(8)));
typedef short s16x4 __attribute__((ext_vector_type(4)));
typedef float f32x4 __attribute__((ext_vector_type(4)));
typedef float f32x16 __attribute__((ext_vector_type(16)));
typedef unsigned u32x4 __attribute__((ext_vector_type(4)));
typedef unsigned u32x2 __attribute__((ext_vector_type(2)));
#define LAS __attribute__((address_space(3)))

constexpr int T_TOK = 32768, DM = 1024, DFF = 2816, NFF2 = 5632, WINC = 7680, QKVW = 4608, GW = 3072;
constexpr float EPS = 1e-6f, LOG2E = 1.4426950408889634f, NEGBIG = -1e30f;
constexpr size_t WB_FFIN0 = 0, WB_FFIN1 = 11534336, WB_FFOUT0 = 23068672, WB_FFOUT1 = 28835840, WB_WIN = 34603008, WB_WO = 50331648;
constexpr size_t WS_MOD = 52428800, WS_ROPE = 53755904, WS_LUT = 53821440, WS_LAM = 53854208, WS_XN = 53854464;
constexpr size_t WS_QKV = WS_XN + 67108864, WS_GATES = WS_QKV + 301989888, WS_PARK = WS_GATES + 201326592, WS_END = WS_PARK + 67108864;
constexpr size_t WS_BAR = WS_END, WS_END2 = WS_END + 16384;
constexpr int LDS_BYTES = 131072 + 16;

struct Params { const float* in[24]; float* out; unsigned char* ws; };

typedef __bf16 bf16v2 __attribute__((ext_vector_type(2)));
typedef float f32x2 __attribute__((ext_vector_type(2)));
__device__ __forceinline__ unsigned cvtpk(float lo, float hi) { f32x2 v = {lo, hi}; bf16v2 b = __builtin_convertvector(v, bf16v2); return __builtin_bit_cast(unsigned, b); }
__device__ __forceinline__ float bf_lo(unsigned u) { return __uint_as_float(u << 16); }
__device__ __forceinline__ float bf_hi(unsigned u) { return __uint_as_float(u & 0xffff0000u); }
__device__ __forceinline__ float bf2f(bf16_t v) { return __uint_as_float(((unsigned)v) << 16); }

namespace pg8 {
constexpr int BM = 256, BK = 64, HALF = 128, HTB = HALF * BK * 2, STAGE_BYTES = 8 * HTB, NXCD = 8, WGM = 8;
__device__ __forceinline__ int lds_byte(int r, int c) { const int st = (r >> 4) * 2 + (c >> 5), rr = r & 15, cc = c & 31, ob = rr * 64 + cc * 2; return st * 1024 + (ob ^ (((ob >> 9) & 1) << 5)); }
__device__ __forceinline__ void stage_rc(int b, int& R, int& C) { const int st = b / 1024, sb = b % 1024, swz = sb ^ (((sb >> 9) & 1) << 5); R = (st >> 1) * 16 + swz / 64; C = (st & 1) * 32 + (swz % 64) / 2; }
__device__ __forceinline__ int perm32(int rho) { const int n = rho >> 4, i = rho & 15; return 8 * (i >> 2) + 4 * n + (i & 3); }
struct Unit { int pm, pn; };
struct Gemm { const bf16_t* A; const bf16_t* Bt; int M, N, K; };
struct StaticOrder {
    int nM, nN, nwg, G, c;
    __device__ void init(int M, int N, int G_, int c_) { nM = M / BM; nN = N / BM; nwg = nM * nN; G = G_; c = c_; }
    __device__ bool next(int i, Unit& u) const {
        const long L = (long)i * G + c; if (L >= nwg) return false;
        int wgid = (int)L; { const int q = nwg / NXCD, r = nwg % NXCD, xcd = wgid % NXCD, off = wgid / NXCD; wgid = (xcd < r ? xcd * (q + 1) : r * (q + 1) + (xcd - r) * q) + off; }
        const int nig = WGM * nN, gid = wgid / nig, fm = gid * WGM, gsz = (nM - fm) < WGM ? (nM - fm) : WGM;
        u.pm = fm + ((wgid % nig) % gsz); u.pn = (wgid % nig) / gsz; return true;
    }
};

template <class Epi>
__device__ __forceinline__ void gemm_phase(LAS unsigned char* lds, const Gemm g, const StaticOrder& S, const Epi& E) {
    int tid_ = threadIdx.x; asm volatile("" : "+v"(tid_));
    const int tid = tid_, wid = __builtin_amdgcn_readfirstlane(tid >> 6), lane = tid & 63, wr = wid >> 2, wc = wid & 3, fr = lane & 15, fq = lane >> 4;
    const int K = g.K, nt = K / BK;
    unsigned voffA[2], voffB[2];
#pragma unroll
    for (int i = 0; i < 2; ++i) { int R, C; stage_rc(tid * 16 + i * 8192, R, C); const int Rb = Epi::PERM ? ((R & ~31) + perm32(R & 31)) : R;
        voffA[i] = (unsigned)(R * K + C) * 2u; voffB[i] = (unsigned)(Rb * K + C) * 2u; }
    const size_t kstep = (size_t)(BK * 2);
    const size_t hstep = (size_t)HALF * K * 2;
    const size_t tstep = 2 * hstep;
    const unsigned ldsw = (unsigned)wid * 1024u;
    const int aoff = lds_byte(wr * 64 + fr, fq * 8), boff = lds_byte(wc * 32 + fr, fq * 8);
#define PG8_SA(b, h) (((b) * 2 + (h)) * HTB)
#define PG8_SB(b, h) ((4 + (b) * 2 + (h)) * HTB)
#define PG8_STAGE(bufoff, gbase, voff) do { _Pragma("unroll") for (int _i = 0; _i < 2; ++_i) \
        __builtin_amdgcn_global_load_lds((const unsigned*)((const char*)(gbase) + (voff)[_i]), (LAS unsigned*)(lds + (bufoff) + ldsw + _i * 8192), 16, 0, 0); } while (0)
#define PG8_LDA(dst, b, h) do { _Pragma("unroll") for (int m = 0; m < 4; ++m) _Pragma("unroll") for (int k = 0; k < 2; ++k) dst[m][k] = *(const LAS bf16x8*)(lds + PG8_SA(b, h) + aoff + m * 2048 + k * 1024); } while (0)
#define PG8_LDB(dst, b, h) do { _Pragma("unroll") for (int n = 0; n < 2; ++n) _Pragma("unroll") for (int k = 0; k < 2; ++k) dst[n][k] = *(const LAS bf16x8*)(lds + PG8_SB(b, h) + boff + n * 2048 + k * 1024); } while (0)
#define PG8_MMA(ai, bj, At, Bt) do { __builtin_amdgcn_s_setprio(1); _Pragma("unroll") for (int m = 0; m < 4; ++m) _Pragma("unroll") for (int n = 0; n < 2; ++n) _Pragma("unroll") for (int k = 0; k < 2; ++k) \
        acc[ai][bj][m][n] = __builtin_amdgcn_mfma_f32_16x16x32_bf16(Bt[n][k], At[m][k], acc[ai][bj][m][n], 0, 0, 0); __builtin_amdgcn_s_setprio(0); } while (0)
#define PG8_WAIT_V(n) asm volatile("s_waitcnt vmcnt(" #n ")" ::: "memory")
#define PG8_WAIT_L(n) asm volatile("s_waitcnt lgkmcnt(" #n ")" ::: "memory")
#define PG8_BAR __builtin_amdgcn_s_barrier()
#define PG8_SCHED __builtin_amdgcn_sched_barrier(0)
    Unit cur, nxt; int ui = 0;
    if (!S.next(0, cur)) return;
    f32x4 acc[2][2][4][2];
#pragma unroll
    for (int a = 0; a < 2; ++a)
#pragma unroll
        for (int b = 0; b < 2; ++b)
#pragma unroll
            for (int m = 0; m < 4; ++m)
#pragma unroll
                for (int n = 0; n < 2; ++n) acc[a][b][m][n] = (f32x4){0.f, 0.f, 0.f, 0.f};
    bf16x8 At[4][2], B0[2][2], B1[2][2];
    const char* cA = (const char*)g.A + (size_t)cur.pm * tstep; const char* cB = (const char*)g.Bt + (size_t)cur.pn * tstep;
    PG8_STAGE(PG8_SB(0, 0), cB, voffB); PG8_STAGE(PG8_SA(0, 0), cA, voffA); PG8_STAGE(PG8_SB(0, 1), cB + hstep, voffB); PG8_STAGE(PG8_SA(0, 1), cA + hstep, voffA);
    if (wr == 1) PG8_BAR;
    PG8_WAIT_V(4); PG8_BAR;
    PG8_STAGE(PG8_SB(1, 0), cB + kstep, voffB); PG8_STAGE(PG8_SA(1, 0), cA + kstep, voffA); PG8_STAGE(PG8_SB(1, 1), cB + hstep + kstep, voffB);
    PG8_WAIT_V(6); PG8_BAR;
    for (;;) {
        const bool has_next = S.next(ui + 1, nxt);
        const char* nA = has_next ? (const char*)g.A + (size_t)nxt.pm * tstep : cA; const char* nB = has_next ? (const char*)g.Bt + (size_t)nxt.pn * tstep : cB;
        for (int t = 0; t < nt; t += 2) {
            const bool last = (t == nt - 2);
            const char* a1 = cA + (size_t)(t + 1) * kstep;
            const char* a2 = last ? nA : cA + (size_t)(t + 2) * kstep; const char* b2 = last ? nB : cB + (size_t)(t + 2) * kstep;
            const char* a3 = a2 + kstep; const char* b3 = b2 + kstep;
            PG8_LDB(B0, 0, 0); PG8_SCHED; PG8_LDA(At, 0, 0); PG8_STAGE(PG8_SA(1, 1), a1 + hstep, voffA);
            PG8_WAIT_L(8); PG8_BAR; PG8_WAIT_L(0); PG8_MMA(0, 0, At, B0); PG8_BAR; PG8_SCHED;
            PG8_LDB(B1, 0, 1); PG8_STAGE(PG8_SB(0, 0), b2, voffB);
            PG8_BAR; PG8_WAIT_L(0); PG8_MMA(0, 1, At, B1); PG8_BAR;
            PG8_LDA(At, 0, 1); PG8_STAGE(PG8_SA(0, 0), a2, voffA);
            PG8_BAR; PG8_WAIT_L(0); PG8_MMA(1, 0, At, B0); PG8_BAR; PG8_SCHED;
            PG8_STAGE(PG8_SB(0, 1), b2 + hstep, voffB);
            PG8_WAIT_V(6); PG8_BAR; PG8_MMA(1, 1, At, B1); PG8_BAR;
            PG8_LDB(B0, 1, 0); PG8_SCHED; PG8_LDA(At, 1, 0); PG8_STAGE(PG8_SA(0, 1), a2 + hstep, voffA);
            PG8_WAIT_L(8); PG8_BAR; PG8_WAIT_L(0); PG8_MMA(0, 0, At, B0); PG8_BAR; PG8_SCHED;
            PG8_LDB(B1, 1, 1); PG8_STAGE(PG8_SB(1, 0), b3, voffB);
            PG8_BAR; PG8_WAIT_L(0); PG8_MMA(0, 1, At, B1); PG8_BAR;
            PG8_LDA(At, 1, 1); PG8_STAGE(PG8_SA(1, 0), a3, voffA);
            PG8_BAR; PG8_WAIT_L(0); PG8_MMA(1, 0, At, B0); PG8_BAR; PG8_SCHED;
            PG8_STAGE(PG8_SB(1, 1), b3 + hstep, voffB);
            PG8_WAIT_V(6); PG8_BAR; PG8_MMA(1, 1, At, B1); PG8_BAR;
        }
        E(acc, cur, wr, wc, fr, fq);
        if (!has_next) break;
#pragma unroll
        for (int a = 0; a < 2; ++a)
#pragma unroll
            for (int b = 0; b < 2; ++b)
#pragma unroll
                for (int m = 0; m < 4; ++m)
#pragma unroll
                    for (int n = 0; n < 2; ++n) acc[a][b][m][n] = (f32x4){0.f, 0.f, 0.f, 0.f};
        cur = nxt; cA = nA; cB = nB; ++ui;
    }
    PG8_WAIT_V(0);
    if (wr == 0) PG8_BAR;
    PG8_BAR;
#undef PG8_SA
#undef PG8_SB
#undef PG8_STAGE
#undef PG8_LDA
#undef PG8_LDB
#undef PG8_MMA
#undef PG8_WAIT_V
#undef PG8_WAIT_L
#undef PG8_BAR
#undef PG8_SCHED
}

__device__ __forceinline__ float silu_f(float g) { return g * __builtin_amdgcn_rcpf(1.f + __expf(-g)); }
__device__ __forceinline__ float sigm_f(float g) { return __builtin_amdgcn_rcpf(1.f + __expf(-g)); }
struct EpiSwiGLU {
    static constexpr bool PERM = true;
    bf16_t* H;
    __device__ __forceinline__ void operator()(const f32x4 (&acc)[2][2][4][2], const Unit& u, int wr, int wc, int fr, int fq) const {
        const int row0 = u.pm * BM + wr * 64 + fr, col0 = u.pn * 128 + wc * 32 + 8 * fq;
#pragma unroll
        for (int ai = 0; ai < 2; ++ai)
#pragma unroll
            for (int m = 0; m < 4; ++m) { bf16_t* rowp = H + (size_t)(row0 + ai * HALF + m * 16) * DFF + col0;
                const f32x4 g0 = acc[ai][0][m][0], g1 = acc[ai][0][m][1], u0 = acc[ai][1][m][0], u1 = acc[ai][1][m][1];
                u32x4 w; w.x = cvtpk(silu_f(g0[0]) * u0[0], silu_f(g0[1]) * u0[1]); w.y = cvtpk(silu_f(g0[2]) * u0[2], silu_f(g0[3]) * u0[3]);
                w.z = cvtpk(silu_f(g1[0]) * u1[0], silu_f(g1[1]) * u1[1]); w.w = cvtpk(silu_f(g1[2]) * u1[2], silu_f(g1[3]) * u1[3]);
                *(u32x4*)rowp = w; }
    }
};
struct EpiResid {
    static constexpr bool PERM = false;
    float* X; const float* modg; float gs;
    __device__ __forceinline__ void operator()(const f32x4 (&acc)[2][2][4][2], const Unit& u, int wr, int wc, int fr, int fq) const {
        const int row0 = u.pm * BM + wr * 64 + fr, col0 = u.pn * BM + wc * 32 + 4 * fq;
        const int bi = u.pm < 64 ? (u.pm >> 3) : 8;
        const float* mg = modg + (size_t)bi * 9216 + col0;
        f32x4 gv[2][2];
#pragma unroll
        for (int bj = 0; bj < 2; ++bj)
#pragma unroll
            for (int n = 0; n < 2; ++n) gv[bj][n] = *(const f32x4*)(mg + bj * HALF + n * 16) * gs;
#pragma unroll
        for (int ai = 0; ai < 2; ++ai)
#pragma unroll
            for (int m = 0; m < 4; ++m) { float* rowp = X + (size_t)(row0 + ai * HALF + m * 16) * DM + col0;
#pragma unroll
                for (int bj = 0; bj < 2; ++bj)
#pragma unroll
                    for (int n = 0; n < 2; ++n) { f32x4* q = (f32x4*)(rowp + bj * HALF + n * 16); *q = *q + gv[bj][n] * acc[ai][bj][m][n]; } }
    }
};
struct EpiQKV {
    static constexpr bool PERM = true;
    bf16_t* QKV; bf16_t* GATES;
    __device__ __forceinline__ void operator()(const f32x4 (&acc)[2][2][4][2], const Unit& u, int wr, int wc, int fr, int fq) const {
        const int row0 = u.pm * BM + wr * 64 + fr;
        if (u.pn < 18) {
            const int col0 = u.pn * BM + wc * 32 + 8 * fq;
#pragma unroll
            for (int ai = 0; ai < 2; ++ai)
#pragma unroll
                for (int m = 0; m < 4; ++m) { bf16_t* rowp = QKV + (size_t)(row0 + ai * HALF + m * 16) * QKVW + col0;
#pragma unroll
                    for (int bj = 0; bj < 2; ++bj) { const f32x4 v0 = acc[ai][bj][m][0], v1 = acc[ai][bj][m][1];
                        u32x4 w; w.x = cvtpk(v0[0], v0[1]); w.y = cvtpk(v0[2], v0[3]); w.z = cvtpk(v1[0], v1[1]); w.w = cvtpk(v1[2], v1[3]);
                        *(u32x4*)(rowp + bj * HALF) = w; } }
        } else {
            const int col0 = (u.pn - 18) * BM + wc * 32 + 8 * fq;
#pragma unroll
            for (int ai = 0; ai < 2; ++ai)
#pragma unroll
                for (int m = 0; m < 4; ++m) { bf16_t* rowp = GATES + (size_t)(row0 + ai * HALF + m * 16) * GW + col0;
#pragma unroll
                    for (int bj = 0; bj < 2; ++bj) { const f32x4 v0 = acc[ai][bj][m][0], v1 = acc[ai][bj][m][1];
                        u32x4 w; w.x = cvtpk(sigm_f(v0[0]), sigm_f(v0[1])); w.y = cvtpk(sigm_f(v0[2]), sigm_f(v0[3])); w.z = cvtpk(sigm_f(v1[0]), sigm_f(v1[1])); w.w = cvtpk(sigm_f(v1[2]), sigm_f(v1[3]));
                        *(u32x4*)(rowp + bj * HALF) = w; } }
        }
    }
};
}

constexpr int LDQK = QKVW;
constexpr int SHM_V = 64 * 128 * 2, SHM_K = 64 * 128 * 2;
constexpr int ATT_WS_OFF = 2 * SHM_V + 2 * SHM_K, ATT_LUT_OFF = ATT_WS_OFF + 8 * 64 * 4;
#define KSWZ(row, colB) ((row) * 256 + ((colB) ^ (((row) & 7) << 4)))
#define SBAR() __builtin_amdgcn_sched_barrier(0)
__device__ __forceinline__ int crow(int r, int hi) { return (r & 3) + 8 * (r >> 2) + 4 * hi; }

template <int MODE>
__device__ __forceinline__ void partialSM(f32x16& p0, f32x16& p1, float& m_reg, float& mn, float& alpha, int relh, int relw_min, int relw_max, const float* lut) {
  if constexpr (MODE == 0) {
    constexpr float SCALE = 0.088388347648318440f, C = SCALE * LOG2E, THR = 8.f;
    float pmax = p0[0];
#pragma unroll
    for (int r = 1; r < 16; ++r) pmax = fmaxf(pmax, p0[r]);
#pragma unroll
    for (int r = 0; r < 16; ++r) pmax = fmaxf(pmax, p1[r]);
    { auto rr = __builtin_amdgcn_permlane32_swap(__float_as_uint(pmax), __float_as_uint(pmax), false, false);
      pmax = fmaxf(__uint_as_float(rr[0]), __uint_as_float(rr[1])); }
    if (__builtin_expect(__all(pmax - m_reg <= THR / SCALE), 1)) { mn = m_reg; alpha = 1.f; }
    else { mn = fmaxf(m_reg, pmax); alpha = __builtin_amdgcn_exp2f((m_reg - mn) * C); m_reg = mn; }
    const float mnC = -mn * C;
#pragma unroll
    for (int r = 0; r < 16; ++r) p0[r] = fmaf(p0[r], C, mnC);
#pragma unroll
    for (int r = 0; r < 16; ++r) p1[r] = fmaf(p1[r], C, mnC);
#pragma unroll
    for (int r = 0; r < 16; ++r) p0[r] = __builtin_amdgcn_exp2f(p0[r]);
  } else {
    constexpr float C = (MODE == 1 ? 0.088388347648318440f : 0.125f) * LOG2E, THR2 = 8.f * LOG2E;
    bool nearT = true; float cfar = 0.f;
    if constexpr (MODE >= 2) {
      if (relw_max <= -128) { nearT = false; cfar = lut[0]; }
      else if (relw_min >= 128) { nearT = false; cfar = lut[258]; }
      if (!nearT) {
        float pmax = p0[0];
#pragma unroll
        for (int r = 1; r < 16; ++r) pmax = fmaxf(pmax, p0[r]);
#pragma unroll
        for (int r = 0; r < 16; ++r) pmax = fmaxf(pmax, p1[r]);
        { auto rr = __builtin_amdgcn_permlane32_swap(__float_as_uint(pmax), __float_as_uint(pmax), false, false);
          pmax = fmaxf(__uint_as_float(rr[0]), __uint_as_float(rr[1])); }
        const float tmax = fmaf(pmax, C, cfar);
        if (__builtin_expect(__all(tmax - m_reg <= THR2), 1)) { mn = m_reg; alpha = 1.f; }
        else { mn = fmaxf(m_reg, tmax); alpha = __builtin_amdgcn_exp2f(m_reg - mn); m_reg = mn; }
        const float off = cfar - mn;
#pragma unroll
        for (int r = 0; r < 16; ++r) p0[r] = fmaf(p0[r], C, off);
#pragma unroll
        for (int r = 0; r < 16; ++r) p1[r] = fmaf(p1[r], C, off);
#pragma unroll
        for (int r = 0; r < 16; ++r) p0[r] = __builtin_amdgcn_exp2f(p0[r]);
        return;
      }
    }
    if (nearT) {
#pragma unroll
      for (int r = 0; r < 16; ++r) { const int i0 = relh + (r & 3) + 8 * (r >> 2);
        const int a0 = min(max(i0, -129), 129) + 129, a1 = min(max(i0 + 32, -129), 129) + 129;
        p0[r] = fmaf(p0[r], C, lut[a0]); p1[r] = fmaf(p1[r], C, lut[a1]); }
    } else {
#pragma unroll
      for (int r = 0; r < 16; ++r) { p0[r] = fmaf(p0[r], C, cfar); p1[r] = fmaf(p1[r], C, cfar); }
    }
    float pmax = p0[0];
#pragma unroll
    for (int r = 1; r < 16; ++r) pmax = fmaxf(pmax, p0[r]);
#pragma unroll
    for (int r = 0; r < 16; ++r) pmax = fmaxf(pmax, p1[r]);
    { auto rr = __builtin_amdgcn_permlane32_swap(__float_as_uint(pmax), __float_as_uint(pmax), false, false);
      pmax = fmaxf(__uint_as_float(rr[0]), __uint_as_float(rr[1])); }
    if (__builtin_expect(__all(pmax - m_reg <= THR2), 1)) { mn = m_reg; alpha = 1.f; }
    else { mn = fmaxf(m_reg, pmax); alpha = __builtin_amdgcn_exp2f(m_reg - mn); m_reg = mn; }
#pragma unroll
    for (int r = 0; r < 16; ++r) p0[r] = __builtin_amdgcn_exp2f(p0[r] - mn);
#pragma unroll
    for (int r = 0; r < 16; ++r) p1[r] = p1[r] - mn;
  }
}
__device__ __forceinline__ void finishSM(f32x16& p0, f32x16& p1, float alpha, float& l_reg, bf16x8& pa0, bf16x8& pa1, bf16x8& pa2, bf16x8& pa3) {
#pragma unroll
  for (int r = 0; r < 16; ++r) p1[r] = __builtin_amdgcn_exp2f(p1[r]);
  float ps = 0;
#pragma unroll
  for (int r = 0; r < 16; ++r) ps += p0[r];
#pragma unroll
  for (int r = 0; r < 16; ++r) ps += p1[r];
  { auto rr = __builtin_amdgcn_permlane32_swap(__float_as_uint(ps), __float_as_uint(ps), false, false);
    ps = __uint_as_float(rr[0]) + __uint_as_float(rr[1]); }
  l_reg = l_reg * alpha + ps;
#define PK4(P, BASE, OUT) do { unsigned a0 = cvtpk(P[BASE + 0], P[BASE + 1]), a1 = cvtpk(P[BASE + 2], P[BASE + 3]);   \
    unsigned b0 = cvtpk(P[BASE + 4], P[BASE + 5]), b1 = cvtpk(P[BASE + 6], P[BASE + 7]);                              \
    auto r0 = __builtin_amdgcn_permlane32_swap(a0, b0, false, false); auto r1 = __builtin_amdgcn_permlane32_swap(a1, b1, false, false); \
    u32x4 w = {r0[0], r1[0], r0[1], r1[1]}; OUT = *reinterpret_cast<bf16x8*>(&w); } while (0)
  PK4(p0, 0, pa0); PK4(p0, 8, pa1); PK4(p1, 0, pa2); PK4(p1, 8, pa3);
#undef PK4
}
template <int ND0, int DOFF>
__device__ __forceinline__ void qkt(f32x16& p0, f32x16& p1, const char* Ks, const bf16x8* qr, int r32, int hi) {
  p0 = f32x16{}; p1 = f32x16{};
#pragma unroll
  for (int d0 = 0; d0 < ND0; ++d0) { const int cb = ((d0 + DOFF) * 16 + hi * 8) * 2;
    bf16x8 b0 = *reinterpret_cast<const bf16x8*>(Ks + KSWZ(r32, cb));
    bf16x8 b1 = *reinterpret_cast<const bf16x8*>(Ks + KSWZ(32 + r32, cb));
    p0 = __builtin_amdgcn_mfma_f32_32x32x16_bf16(b0, qr[d0], p0, 0, 0, 0);
    p1 = __builtin_amdgcn_mfma_f32_32x32x16_bf16(b1, qr[d0], p1, 0, 0, 0); }
}
__device__ __forceinline__ int v_st(int k, int c) { const int kk = (k & ~0xC) | ((k & 4) << 1) | ((k & 8) >> 1); return ((kk >> 3) * 4 + (c >> 5)) * 512 + ((kk & 7) * 32 + (c & 31)) * 2; }
__device__ __forceinline__ int v_rd_base(int lane) { return ((lane & 3) << 3) | (((lane >> 2) & 3) << 6) | (((lane >> 4) & 1) << 5) | (((lane >> 5) & 1) << 8); }
constexpr int v_rd_off(int d0, int ks, int half) { return d0 * 512 + ks * 4096 + half * 2048; }
template <int OFF> __device__ __forceinline__ s16x4 tr_read(int vb) {
  s16x4 r; asm volatile("ds_read_b64_tr_b16 %0, %1 offset:%2" : "=&v"(r) : "v"(vb), "i"(OFF) : "memory"); return r;
}
template <int D0> __device__ __forceinline__ void pv_one(f32x16& od, int vb, bf16x8 pa0, bf16x8 pa1, bf16x8 pa2, bf16x8 pa3) {
  const s16x4 l0 = tr_read<v_rd_off(D0, 0, 0)>(vb), h0 = tr_read<v_rd_off(D0, 0, 1)>(vb), l1 = tr_read<v_rd_off(D0, 1, 0)>(vb), h1 = tr_read<v_rd_off(D0, 1, 1)>(vb);
  const s16x4 l2 = tr_read<v_rd_off(D0, 2, 0)>(vb), h2 = tr_read<v_rd_off(D0, 2, 1)>(vb), l3 = tr_read<v_rd_off(D0, 3, 0)>(vb), h3 = tr_read<v_rd_off(D0, 3, 1)>(vb);
  asm volatile("s_waitcnt lgkmcnt(0)" ::: "memory"); SBAR();
#define PK(L, H) (bf16x8){L[0], L[1], L[2], L[3], H[0], H[1], H[2], H[3]}
  od = __builtin_amdgcn_mfma_f32_32x32x16_bf16(pa0, PK(l0, h0), od, 0, 0, 0);
  od = __builtin_amdgcn_mfma_f32_32x32x16_bf16(pa1, PK(l1, h1), od, 0, 0, 0);
  od = __builtin_amdgcn_mfma_f32_32x32x16_bf16(pa2, PK(l2, h2), od, 0, 0, 0);
  od = __builtin_amdgcn_mfma_f32_32x32x16_bf16(pa3, PK(l3, h3), od, 0, 0, 0);
#undef PK
}
__device__ __forceinline__ void pv_d0(f32x16* o, int vb, bf16x8 pa0, bf16x8 pa1, bf16x8 pa2, bf16x8 pa3) {
  pv_one<0>(o[0], vb, pa0, pa1, pa2, pa3); pv_one<1>(o[1], vb, pa0, pa1, pa2, pa3); pv_one<2>(o[2], vb, pa0, pa1, pa2, pa3); pv_one<3>(o[3], vb, pa0, pa1, pa2, pa3);
}

struct AttnEpi {
  const bf16_t* gate;
  float* park;
  bf16_t* merged;
  const float* gsub;
  float lam, oml;
  float sinkl2;
};

template <int MODE>
__device__ __forceinline__ void attn_body(const bf16_t* __restrict__ Qb, const bf16_t* __restrict__ Kh, const bf16_t* __restrict__ Vh, int NT, int krel0,
                                          char* lds, const float* __restrict__ lutg, const AttnEpi& E) {
  constexpr int ND0 = (MODE < 2) ? 8 : 4, DOFF = (MODE == 3) ? 4 : 0;
  int tid_ = threadIdx.x; asm volatile("" : "+v"(tid_));
  const int tid = tid_, wid = tid >> 6, lane = tid & 63, r32 = lane & 31, hi = lane >> 5;
  char* V_lds = lds; char* K_lds = lds + 2 * SHM_V;
  float* wsm = (float*)(lds + ATT_WS_OFF) + wid * 64; float* li_l = wsm; float* al_l = wsm + 32;
  float* lut = (float*)(lds + ATT_LUT_OFF);
  __syncthreads();
  if constexpr (MODE != 0) { if (tid < 259) lut[tid] = lutg[tid]; }
  float m_reg = -1e30f, l_reg = 0; f32x16 o[4] = {}; bf16x8 qr[ND0];
  const bf16_t* Qw = Qb + (size_t)(wid * 32 + r32) * LDQK + hi * 8;
#pragma unroll
  for (int d0 = 0; d0 < ND0; ++d0) qr[d0] = *reinterpret_cast<const bf16x8*>(Qw + d0 * 16);
  const int sr = tid >> 4, sc = (tid & 15) * 8, vst0 = v_st(sr, sc), vst1 = v_st(32 + sr, sc);
  const int vb0 = (int)(uintptr_t)V_lds + v_rd_base(lane);
  struct { bf16x8 vs0, vs1, ks0, ks1; } sr_[2];
#define SLOAD(i, k0) do { sr_[i].vs0 = *reinterpret_cast<const bf16x8*>(&Vh[(size_t)((k0) + sr) * LDQK + sc]); sr_[i].vs1 = *reinterpret_cast<const bf16x8*>(&Vh[(size_t)((k0) + 32 + sr) * LDQK + sc]); \
    sr_[i].ks0 = *reinterpret_cast<const bf16x8*>(&Kh[(size_t)((k0) + sr) * LDQK + sc]); sr_[i].ks1 = *reinterpret_cast<const bf16x8*>(&Kh[(size_t)((k0) + 32 + sr) * LDQK + sc]); } while (0)
#define SWRITE(b, i) do { *(bf16x8*)(V_lds + (b) * SHM_V + vst0) = sr_[i].vs0;          \
    *(bf16x8*)(V_lds + (b) * SHM_V + vst1) = sr_[i].vs1; int kc = sc * 2;               \
    *(bf16x8*)(K_lds + (b) * SHM_K + KSWZ(sr, kc)) = sr_[i].ks0;                       \
    *(bf16x8*)(K_lds + (b) * SHM_K + KSWZ(32 + sr, kc)) = sr_[i].ks1; } while (0)
#define SWAIT() asm volatile("s_waitcnt vmcnt(4)" ::: "memory")
#define RESC(a) do { if (__any((a) < 1.f)) { if (hi == 0) al_l[r32] = (a); asm volatile("s_waitcnt lgkmcnt(0)" ::: "memory"); \
    _Pragma("unroll") for (int d = 0; d < 4; ++d) _Pragma("unroll") for (int r = 0; r < 16; ++r) o[d][r] *= al_l[crow(r, hi)]; } } while (0)
  const int relq = krel0 - (wid * 32 + r32) + 4 * hi, relwmin = krel0 - (wid * 32 + 31), relwmax = krel0 + 63 - wid * 32;
#define PSM(P0, P1, MN, AL, J) partialSM<MODE>(P0, P1, m_reg, MN, AL, relq + 64 * (J), relwmin + 64 * (J), relwmax + 64 * (J), lut)
  f32x16 pA0, pA1, pB0, pB1; float mnA, mnB, alA, alB; bf16x8 pa0, pa1, pa2, pa3;
  constexpr int SE = 0, SO = 1;
  SLOAD(SE, 0); asm volatile("s_waitcnt vmcnt(0)" ::: "memory"); SWRITE(0, SE); __syncthreads();
  qkt<ND0, DOFF>(pA0, pA1, K_lds, qr, r32, hi); PSM(pA0, pA1, mnA, alA, 0);
  SLOAD(SO, 64); if (2 < NT) SLOAD(SE, 2 * 64);
  SWAIT(); SWRITE(1, SO); __syncthreads();
  for (int j = 1; j + 1 < NT; j += 2) {
    SBAR(); qkt<ND0, DOFF>(pB0, pB1, K_lds + SHM_K, qr, r32, hi);
    finishSM(pA0, pA1, alA, l_reg, pa0, pa1, pa2, pa3); SBAR();
    SLOAD(SO, (j + 2) * 64); SBAR();
    pv_d0(o, vb0, pa0, pa1, pa2, pa3); PSM(pB0, pB1, mnB, alB, j);
    __syncthreads(); SWAIT(); SWRITE(0, SE);
    RESC(alB); __syncthreads();
    SBAR(); qkt<ND0, DOFF>(pA0, pA1, K_lds, qr, r32, hi);
    finishSM(pB0, pB1, alB, l_reg, pa0, pa1, pa2, pa3); SBAR();
    if (j + 3 < NT) SLOAD(SE, (j + 3) * 64); SBAR();
    pv_d0(o, vb0 + SHM_V, pa0, pa1, pa2, pa3); PSM(pA0, pA1, mnA, alA, j + 1);
    __syncthreads(); SWAIT(); SWRITE(1, SO);
    RESC(alA); __syncthreads();
  }
  SBAR(); qkt<ND0, DOFF>(pB0, pB1, K_lds + SHM_K, qr, r32, hi);
  finishSM(pA0, pA1, alA, l_reg, pa0, pa1, pa2, pa3); SBAR();
  pv_d0(o, vb0, pa0, pa1, pa2, pa3); PSM(pB0, pB1, mnB, alB, NT - 1);
  __syncthreads(); RESC(alB);
  finishSM(pB0, pB1, alB, l_reg, pa0, pa1, pa2, pa3); SBAR();
  pv_d0(o, vb0 + SHM_V, pa0, pa1, pa2, pa3);
  if constexpr (MODE == 1) l_reg += __builtin_amdgcn_exp2f(E.sinkl2 - m_reg);
  if (hi == 0) li_l[r32] = l_reg; asm volatile("s_waitcnt lgkmcnt(0)" ::: "memory");
  float rli[16];
#pragma unroll
  for (int r = 0; r < 16; ++r) rli[r] = __builtin_amdgcn_rcpf(li_l[crow(r, hi)]);
  float* pk0 = E.park; float* pk1 = E.park + 64 * 512;
  const int rowb = wid * 32;
  if constexpr (MODE == 0 || MODE == 1) {
#pragma unroll
    for (int r = 0; r < 16; ++r) { const int row = rowb + crow(r, hi);
#pragma unroll
      for (int d0 = 0; d0 < 4; ++d0) { const int idx = (d0 * 16 + r) * 512 + tid;
        const float g = bf2f(E.gate[(size_t)row * GW + d0 * 32 + r32]);
        const float v = o[d0][r] * rli[r] * g;
        if constexpr (MODE == 0) pk0[idx] = v; else pk0[idx] += v; } }
  } else if constexpr (MODE == 2) {
#pragma unroll
    for (int r = 0; r < 16; ++r)
#pragma unroll
      for (int d0 = 0; d0 < 4; ++d0) pk1[(d0 * 16 + r) * 512 + tid] = o[d0][r] * rli[r];
  } else {
    float gs[4];
#pragma unroll
    for (int d0 = 0; d0 < 4; ++d0) gs[d0] = E.gsub[d0 * 32 + r32] * E.oml;
#pragma unroll
    for (int r = 0; r < 16; ++r) { const int row = rowb + crow(r, hi);
      float ss = 0.f;
#pragma unroll
      for (int d0 = 0; d0 < 4; ++d0) { const float c = pk1[(d0 * 16 + r) * 512 + tid] - E.lam * (o[d0][r] * rli[r]); o[d0][r] = c; ss += c * c; }
      ss += __shfl_xor(ss, 1); ss += __shfl_xor(ss, 2); ss += __shfl_xor(ss, 4); ss += __shfl_xor(ss, 8); ss += __shfl_xor(ss, 16);
      const float rs = rsqrtf(ss * (1.f / 128.f) + EPS);
#pragma unroll
      for (int d0 = 0; d0 < 4; ++d0) { const int col = d0 * 32 + r32;
        const float g = bf2f(E.gate[(size_t)row * GW + col]);
        const float y = o[d0][r] * rs * gs[d0] * g + pk0[(d0 * 16 + r) * 512 + tid];
        E.merged[(size_t)row * DM + col] = (bf16_t)(cvtpk(y, y) & 0xffffu); } }
  }
#undef SLOAD
#undef SWRITE
#undef SWAIT
#undef RESC
#undef PSM
}

__device__ __forceinline__ int t5bucket(int rel) {
  const int n = rel < 0 ? -rel : rel;
  const int b = n < 8 ? n : 8 + (n >= 12) + (n >= 16) + (n >= 23) + (n >= 32) + (n >= 46) + (n >= 64) + (n >= 91);
  return b + (rel > 0 ? 16 : 0);
}
__device__ __forceinline__ float wave_sum(float v) {
  v += __shfl_xor(v, 1); v += __shfl_xor(v, 2); v += __shfl_xor(v, 4); v += __shfl_xor(v, 8); v += __shfl_xor(v, 16); v += __shfl_xor(v, 32); return v;
}

__device__ __forceinline__ void phase_setup(const Params& p, unsigned char* shm) {
  int tid_ = threadIdx.x; asm volatile("" : "+v"(tid_)); const int tid = tid_, nb = gridDim.x, bid = blockIdx.x, wid = tid >> 6, lane = tid & 63;
  {
    const float4* s0 = (const float4*)p.in[0]; const float4* s1 = (const float4*)p.in[1]; float4* o = (float4*)p.out;
    const size_t n4 = (size_t)16384 * 1024 / 4;
    for (size_t i = (size_t)bid * 512 + tid; i < 2 * n4; i += (size_t)nb * 512) o[i] = i < n4 ? s0[i] : s1[i - n4];
  }
  {
    float* rope = (float*)(p.ws + WS_ROPE);
    for (int i = bid * 512 + tid; i < 256 * 32; i += nb * 512) { const int pos = i >> 5, f = i & 31;
      const float inv = powf(10000.f, -(float)f / 32.f); const float ang = (float)pos * inv; rope[2 * i] = cosf(ang); rope[2 * i + 1] = sinf(ang); }
    float* lut = (float*)(p.ws + WS_LUT);
    for (int i = bid * 512 + tid; i < 16 * 259; i += nb * 512) { const int hh = i / 259, e = i % 259; int rel = e - 129; float v;
      if (hh < 8) { v = (rel < -128 || rel > 128) ? NEGBIG : p.in[23][t5bucket(rel) * 16 + hh] * LOG2E; }
      else { rel = rel < -128 ? -128 : (rel > 128 ? 128 : rel); v = p.in[23][t5bucket(rel) * 16 + hh] * LOG2E; }
      lut[i] = v; }
    if (bid == 0 && tid < 4) { const int l = tid; float s1 = 0.f, s2 = 0.f;
      for (int i = 0; i < 64; ++i) { s1 += p.in[18][l * 64 + i] * p.in[19][l * 64 + i]; s2 += p.in[20][l * 64 + i] * p.in[21][l * 64 + i]; }
      const float lam_init = 0.8f - 0.6f * expf(-0.3f * (float)l);
      float* lam = (float*)(p.ws + WS_LAM); lam[2 * l] = expf(s1) - expf(s2) + lam_init; lam[2 * l + 1] = 1.f - lam_init; }
  }
  {
    float* sc = (float*)shm; float* red = sc + 9 * 1024;
    for (int i = tid; i < 9 * 1024; i += 512) { const float c = i < 8192 ? p.in[2][i] : p.in[3][i - 8192]; sc[i] = c / (1.f + expf(-c)); }
    __syncthreads();
    float* mod = (float*)(p.ws + WS_MOD);
    for (int task = bid; task < 576; task += nb) {
      const int l = task / 144, j0 = (task % 144) * 64;
      const float* w = p.in[4] + (size_t)l * 1024 * 9216 + j0 + lane;
      float a0 = 0, a1 = 0, a2 = 0, a3 = 0, a4 = 0, a5 = 0, a6 = 0, a7 = 0, a8 = 0;
#pragma unroll 16
      for (int k = wid * 128; k < wid * 128 + 128; ++k) { const float wv = w[(size_t)k * 9216];
        a0 += sc[k] * wv; a1 += sc[1024 + k] * wv; a2 += sc[2048 + k] * wv; a3 += sc[3072 + k] * wv; a4 += sc[4096 + k] * wv;
        a5 += sc[5120 + k] * wv; a6 += sc[6144 + k] * wv; a7 += sc[7168 + k] * wv; a8 += sc[8192 + k] * wv; }
      float* rw = red + wid * 9 * 64 + lane;
      rw[0] = a0; rw[64] = a1; rw[128] = a2; rw[192] = a3; rw[256] = a4; rw[320] = a5; rw[384] = a6; rw[448] = a7; rw[512] = a8;
      __syncthreads();
      for (int i = tid; i < 9 * 64; i += 512) { const int b = i >> 6, ln = i & 63; float s = 0.f;
#pragma unroll
        for (int w8 = 0; w8 < 8; ++w8) s += red[w8 * 9 * 64 + b * 64 + ln];
        mod[((size_t)l * 9 + b) * 9216 + j0 + ln] = s + p.in[5][l * 9216 + j0 + ln]; }
      __syncthreads();
    }
  }
}

__device__ __forceinline__ void phase_convert(const Params& p, int l, unsigned char* shm) {
  float* tile = (float*)shm;
  int tid_ = threadIdx.x; asm volatile("" : "+v"(tid_)); const int tid = tid_;
  for (int q = blockIdx.x; q < 6400; q += gridDim.x) {
    const float* W; bf16_t* Bt; int N, K, k0, n0d, n0s;
    if (q < 2816) { const int i = q / 1408, qq = q % 1408; W = p.in[7] + (size_t)(l * 2 + i) * 1024 * 5632; Bt = (bf16_t*)(p.ws + (i ? WB_FFIN1 : WB_FFIN0)); N = 5632; K = 1024;
      k0 = (qq & 15) * 64; n0d = (qq >> 4) * 64; n0s = ((n0d >> 7) & 1) * 2816 + (n0d >> 8) * 128 + (n0d & 127); }
    else if (q < 4224) { const int i = (q - 2816) / 704, qq = (q - 2816) % 704; W = p.in[8] + (size_t)(l * 2 + i) * 2816 * 1024; Bt = (bf16_t*)(p.ws + (i ? WB_FFOUT1 : WB_FFOUT0)); N = 1024; K = 2816;
      k0 = (qq % 44) * 64; n0d = (qq / 44) * 64; n0s = n0d; }
    else if (q < 6144) { const int qq = q - 4224; W = p.in[9] + (size_t)l * 1024 * 7680; Bt = (bf16_t*)(p.ws + WB_WIN); N = 7680; K = 1024;
      k0 = (qq & 15) * 64; n0d = (qq >> 4) * 64; n0s = n0d; }
    else { const int qq = q - 6144; W = p.in[10] + (size_t)l * 1024 * 1024; Bt = (bf16_t*)(p.ws + WB_WO); N = 1024; K = 1024;
      k0 = (qq & 15) * 64; n0d = (qq >> 4) * 64; n0s = n0d; }
    { const int nl = tid & 63, ks = tid >> 6;
#pragma unroll
      for (int i = 0; i < 8; ++i) { const int k = ks + 8 * i; tile[nl * 65 + k] = W[(size_t)(k0 + k) * N + n0s + nl]; } }
    __syncthreads();
    { const int n = tid >> 3, kc = (tid & 7) * 8; const float* tr = tile + n * 65 + kc;
      u32x4 w; w.x = cvtpk(tr[0], tr[1]); w.y = cvtpk(tr[2], tr[3]); w.z = cvtpk(tr[4], tr[5]); w.w = cvtpk(tr[6], tr[7]);
      *(u32x4*)(Bt + (size_t)(n0d + n) * K + k0 + kc) = w; }
    __syncthreads();
  }
}

__device__ __forceinline__ void phase_norm(const float* __restrict__ x, const float* __restrict__ g, const float* __restrict__ modl, int jj, bf16_t* __restrict__ xn) {
  int tid_ = threadIdx.x; asm volatile("" : "+v"(tid_)); const int tid = tid_, wid = tid >> 6, lane = tid & 63;
  for (int row = (blockIdx.x * 8 + wid) * 2; row < T_TOK; row += gridDim.x * 16) {
    const int bi = row < 16384 ? (row >> 11) : 8;
    const float* shift = modl + (size_t)bi * 9216 + (3 * jj) * 1024; const float* scale = shift + 1024;
    const float4* xr = (const float4*)(x + (size_t)row * DM);
    float4 v[8]; float ss0 = 0.f, ss1 = 0.f;
#pragma unroll
    for (int i = 0; i < 8; ++i) v[i] = xr[lane + 64 * i];
#pragma unroll
    for (int i = 0; i < 4; ++i) { ss0 += v[i].x * v[i].x + v[i].y * v[i].y + v[i].z * v[i].z + v[i].w * v[i].w;
      ss1 += v[4 + i].x * v[4 + i].x + v[4 + i].y * v[4 + i].y + v[4 + i].z * v[4 + i].z + v[4 + i].w * v[4 + i].w; }
    ss0 = wave_sum(ss0); ss1 = wave_sum(ss1);
    const float rs0 = rsqrtf(ss0 * (1.f / 1024.f) + EPS), rs1 = rsqrtf(ss1 * (1.f / 1024.f) + EPS);
#pragma unroll
    for (int i = 0; i < 4; ++i) { const int c4 = lane + 64 * i;
      const float4 gg = ((const float4*)g)[c4], sc = ((const float4*)scale)[c4], sh = ((const float4*)shift)[c4];
      const float m0 = gg.x * (1.f + sc.x), m1 = gg.y * (1.f + sc.y), m2 = gg.z * (1.f + sc.z), m3 = gg.w * (1.f + sc.w);
      u32x2 w; w.x = cvtpk(v[i].x * rs0 * m0 + sh.x, v[i].y * rs0 * m1 + sh.y); w.y = cvtpk(v[i].z * rs0 * m2 + sh.z, v[i].w * rs0 * m3 + sh.w);
      *(u32x2*)(xn + (size_t)row * DM + c4 * 4) = w;
      u32x2 w2; w2.x = cvtpk(v[4 + i].x * rs1 * m0 + sh.x, v[4 + i].y * rs1 * m1 + sh.y); w2.y = cvtpk(v[4 + i].z * rs1 * m2 + sh.z, v[4 + i].w * rs1 * m3 + sh.w);
      *(u32x2*)(xn + (size_t)(row + 1) * DM + c4 * 4) = w2; }
  }
}

__device__ __forceinline__ void phase_qknorm(const Params& p, int l) {
  bf16_t* qkv = (bf16_t*)(p.ws + WS_QKV); const float* rope = (const float*)(p.ws + WS_ROPE);
  int tid_ = threadIdx.x; asm volatile("" : "+v"(tid_)); const int tid = tid_, wid = tid >> 6, lane = tid & 63;
  f32x2 gq[3], gk[3];
  gq[0] = *(const f32x2*)(p.in[11] + l * 128 + 2 * lane); gk[0] = *(const f32x2*)(p.in[12] + l * 128 + 2 * lane);
  gq[1] = *(const f32x2*)(p.in[13] + l * 128 + 2 * lane); gk[1] = *(const f32x2*)(p.in[14] + l * 128 + 2 * lane);
  gq[2] = *(const f32x2*)(p.in[15] + l * 64 + ((2 * lane) & 63)); gk[2] = *(const f32x2*)(p.in[16] + l * 64 + ((2 * lane) & 63));
  const float sg = (lane & 16) ? 1.f : -1.f;
  for (int tok = blockIdx.x * 8 + wid; tok < T_TOK; tok += gridDim.x * 8) {
    unsigned* base = (unsigned*)(qkv + (size_t)tok * QKVW) + lane;
    unsigned u[30];
#pragma unroll
    for (int s = 0; s < 30; ++s) u[s] = base[((s / 10) * 1536 + (s % 10) * 128) / 2];
    const int sp = tok < 16384 ? (tok & 2047) : (tok - 16384);
    const int pos = lane < 32 ? (sp >> 6) : (sp & 63);
    const f32x4 cs = *(const f32x4*)(rope + (size_t)(pos * 32 + ((2 * lane) & 31)) * 2);
#pragma unroll
    for (int s = 0; s < 30; ++s) {
      const int br = s / 10, hs = s % 10;
      float a = bf_lo(u[s]), b = bf_hi(u[s]);
      float ss = a * a + b * b;
      ss += __shfl_xor(ss, 1); ss += __shfl_xor(ss, 2); ss += __shfl_xor(ss, 4); ss += __shfl_xor(ss, 8); ss += __shfl_xor(ss, 16);
      float rs;
      if (br < 2) { ss += __shfl_xor(ss, 32); rs = rsqrtf(ss * (1.f / 128.f) + EPS); }
      else rs = rsqrtf(ss * (1.f / 64.f) + EPS);
      const f32x2 g = hs < 8 ? gq[br] : gk[br];
      a = a * rs * g[0]; b = b * rs * g[1];
      if (br == 0) {
        const float pa = __shfl_xor(a, 16), pb = __shfl_xor(b, 16);
        a = a * cs[0] + sg * pa * cs[1]; b = b * cs[2] + sg * pb * cs[3];
      }
      base[(br * 1536 + hs * 128) / 2] = cvtpk(a, b);
    }
  }
}

__device__ __forceinline__ void phase_attn(const Params& p, int l, unsigned char* shm) {
  const bf16_t* qkv = (const bf16_t*)(p.ws + WS_QKV); const bf16_t* gates = (const bf16_t*)(p.ws + WS_GATES);
  bf16_t* merged = (bf16_t*)(p.ws + WS_XN);
  const float* lutall = (const float*)(p.ws + WS_LUT); const float* lamp = (const float*)(p.ws + WS_LAM);
  AttnEpi E; E.park = (float*)(p.ws + WS_PARK) + (size_t)blockIdx.x * 65536; E.gsub = p.in[22] + l * 128; E.lam = lamp[2 * l]; E.oml = lamp[2 * l + 1];
  for (int it = blockIdx.x; it < 1024; it += gridDim.x) {
    int S, tok0, h, qb;
    if (it < 512) { S = 16384; tok0 = 16384; h = it & 7; qb = it >> 3; }
    else { const int j = it - 512; S = 2048; h = j & 7; qb = (j >> 3) & 7; tok0 = (j >> 6) * 2048; }
    const int g = h >> 2, q0 = qb * 256;
    const bf16_t* rowQ = qkv + (size_t)(tok0 + q0) * QKVW; const bf16_t* seqK = qkv + (size_t)tok0 * QKVW;
    const bf16_t* grow = gates + (size_t)(tok0 + q0) * GW + h * 128;
    E.merged = merged + (size_t)(tok0 + q0) * DM + h * 128; E.sinkl2 = p.in[17][l * 8 + h] * LOG2E;
    E.gate = grow;
    attn_body<0>(rowQ + h * 128, seqK + 1024 + g * 128, seqK + 1280 + g * 128, S / 64, 0, (char*)shm, lutall, E);
    { const int t_lo = max(0, 4 * qb - 2), t_hi = min(S / 64, 4 * qb + 6);
      const bf16_t* kb = seqK + (size_t)t_lo * 64 * QKVW;
      E.gate = grow + 1024;
      attn_body<1>(rowQ + 1536 + h * 128, kb + 2560 + g * 128, kb + 2816 + g * 128, t_hi - t_lo, t_lo * 64 - q0, (char*)shm, lutall + h * 259, E); }
    E.gate = grow + 2048;
    attn_body<2>(rowQ + 3072 + h * 128, seqK + 4096 + g * 128, seqK + 4352 + g * 128, S / 64, -q0, (char*)shm, lutall + (8 + h) * 259, E);
    attn_body<3>(rowQ + 3072 + h * 128 + 64, seqK + 4096 + g * 128, seqK + 4352 + g * 128, S / 64, -q0, (char*)shm, lutall + (8 + h) * 259, E);
  }
}

__device__ __forceinline__ void gsync(cg::grid_group& g) {
  asm volatile("s_waitcnt vmcnt(0) lgkmcnt(0)" ::: "memory");
  g.sync();
  __builtin_amdgcn_fence(__ATOMIC_ACQUIRE, "agent");
  asm volatile("s_waitcnt vmcnt(0)" ::: "memory");
}
#define XB_TMO      128
#define XB_XCNT(j)  (256  + 64 * (j))
#define XB_XSUB(j)  (1280 + 64 * (j))
#define XB_XGEN(j)  (2304 + 64 * (j))
#define XB_TOP      3328
#define XB_TOPGEN   3392
#define XCD_BAR_WORDS 3456
#define XB_SPIN_CAP (1u << 22)
__device__ __forceinline__ unsigned xb_ld(unsigned* p)              { return __hip_atomic_load(p, __ATOMIC_RELAXED, __HIP_MEMORY_SCOPE_AGENT); }
__device__ __forceinline__ unsigned xb_add(unsigned* p, unsigned v) { return __hip_atomic_fetch_add(p, v, __ATOMIC_RELAXED, __HIP_MEMORY_SCOPE_AGENT); }
__device__ __forceinline__ unsigned xb_xcc_id() { return (unsigned)__builtin_amdgcn_s_getreg((3 << 11) | 20) & 0xFu; }
#define XB_SPIN(cond, bar) do { unsigned _sp = 0; while (cond) { __builtin_amdgcn_s_sleep(1); \
    if ((++_sp & 255u) == 0u) { if (xb_ld(&(bar)[XB_TMO])) break; if (_sp > XB_SPIN_CAP) { atomicAdd(&(bar)[XB_TMO], 1u); break; } } } } while (0)
struct XcdBarrier { unsigned* bar; unsigned x; volatile LAS unsigned* st; };
__device__ __forceinline__ XcdBarrier xcd_barrier_post(unsigned* bar, volatile LAS unsigned* st) {
    XcdBarrier b; b.bar = bar; b.x = xb_xcc_id(); b.st = st;
    if (threadIdx.x == 0) (void)xb_add(&bar[XB_XCNT(b.x)], 1u);
    return b;
}
__device__ __forceinline__ void xcd_barrier_complete(unsigned* bar, unsigned x, unsigned& nloc, unsigned& nx) {
    const unsigned G = gridDim.x * gridDim.y * gridDim.z;
    unsigned sum, cnt, mine, sp = 0u;
    for (;;) {
        sum = 0u; cnt = 0u; mine = 0u;
#pragma unroll
        for (unsigned j = 0; j < 16; ++j) { const unsigned c = xb_ld(&bar[XB_XCNT(j)]); sum += c; cnt += (c > 0u) ? 1u : 0u; mine = (j == x) ? c : mine; }
        if (sum == G) break;
        __builtin_amdgcn_s_sleep(1);
        if ((++sp & 255u) == 0u) { if (xb_ld(&bar[XB_TMO])) break; if (sp > XB_SPIN_CAP) { atomicAdd(&bar[XB_TMO], 1u); break; } }
    }
    nloc = mine > 0u ? mine : 1u; nx = cnt > 0u ? cnt : 1u;
}
__device__ __forceinline__ void xcd_barrier(const XcdBarrier& b) {
    asm volatile("s_waitcnt vmcnt(0)" ::: "memory");
    __syncthreads();
    if (threadIdx.x == 0) {
        unsigned* bar = b.bar;
        __builtin_amdgcn_s_waitcnt(0);
        unsigned nloc = b.st[0], nx = b.st[1];
        if (nloc == 0u) { xcd_barrier_complete(bar, b.x, nloc, nx); b.st[0] = nloc; b.st[1] = nx; }
        const unsigned old = xb_add(&bar[XB_XSUB(b.x)], 1u);
        const unsigned gen = old / nloc;
        if (old + 1u == (gen + 1u) * nloc) {
            __builtin_amdgcn_fence(__ATOMIC_RELEASE, "agent");
            asm volatile("s_waitcnt vmcnt(0)" ::: "memory");
            const unsigned og = xb_add(&bar[XB_TOP], 1u);
            const unsigned tg = og / nx;
            if (og + 1u == (tg + 1u) * nx) xb_add(&bar[XB_TOPGEN], 1u);
            else XB_SPIN(xb_ld(&bar[XB_TOPGEN]) == tg, bar);
            __builtin_amdgcn_fence(__ATOMIC_ACQUIRE, "agent");
            xb_add(&bar[XB_XGEN(b.x)], 1u);
            asm volatile("s_waitcnt vmcnt(0)" ::: "memory");
        } else {
            XB_SPIN(xb_ld(&bar[XB_XGEN(b.x)]) == gen, bar);
            __builtin_amdgcn_fence(__ATOMIC_ACQUIRE, "agent");
            asm volatile("s_waitcnt vmcnt(0)" ::: "memory");
        }
    }
    __syncthreads();
}

constexpr int N_PHASES = 45;
__global__ void __launch_bounds__(512) mega_fwd(Params p, int ph_lo, int ph_hi) {
  extern __shared__ __attribute__((aligned(16))) unsigned char shm[];
  cg::grid_group grid = cg::this_grid();
  LAS unsigned char* lds3 = (LAS unsigned char*)shm;
  float* X = p.out;
  bf16_t* XN = (bf16_t*)(p.ws + WS_XN); bf16_t* Hb = (bf16_t*)(p.ws + WS_QKV);
  pg8::StaticOrder S;
  volatile LAS unsigned* xst = (volatile LAS unsigned*)(lds3 + 131072);
  if (threadIdx.x == 0) { xst[0] = 0u; xst[1] = 0u; }
  unsigned* xbar = (unsigned*)(p.ws + WS_BAR);
  XcdBarrier xb; xb.bar = xbar; xb.x = 0u; xb.st = xst;
#pragma unroll 1
  for (int ph = ph_lo; ph < ph_hi; ++ph) {
    if (ph == 0) { if (blockIdx.x == 0) for (int i = threadIdx.x; i < XCD_BAR_WORDS; i += 512) xbar[i] = 0u;
      phase_setup(p, shm); }
    else {
      const int l = (ph - 1) / 11, k = (ph - 1) % 11;
      const float* modl = (const float*)(p.ws + WS_MOD) + (size_t)l * 9 * 9216;
      if (k == 0 || k == 3 || k == 8) {
        if (k == 0) phase_convert(p, l, shm);
        const int jj = k == 0 ? 0 : (k == 3 ? 1 : 2);
        phase_norm(X, p.in[6] + (size_t)(l * 3 + jj) * 1024, modl, jj, XN);
      } else if (k == 1 || k == 9) {
        pg8::Gemm g{XN, (const bf16_t*)(p.ws + (k == 9 ? WB_FFIN1 : WB_FFIN0)), T_TOK, NFF2, DM};
        S.init(T_TOK, NFF2, gridDim.x, blockIdx.x); pg8::EpiSwiGLU E{Hb}; pg8::gemm_phase(lds3, g, S, E);
      } else if (k == 2 || k == 10 || k == 7) {
        const bool wo = (k == 7);
        pg8::Gemm g{wo ? XN : Hb, (const bf16_t*)(p.ws + (wo ? WB_WO : (k == 10 ? WB_FFOUT1 : WB_FFOUT0))), T_TOK, DM, wo ? DM : DFF};
        S.init(T_TOK, DM, gridDim.x, blockIdx.x); pg8::EpiResid E{X, modl + (wo ? 5 : (k == 10 ? 8 : 2)) * 1024, wo ? 1.0f : 0.5f}; pg8::gemm_phase(lds3, g, S, E);
      } else if (k == 4) {
        pg8::Gemm g{XN, (const bf16_t*)(p.ws + WB_WIN), T_TOK, WINC, DM};
        S.init(T_TOK, WINC, gridDim.x, blockIdx.x); pg8::EpiQKV E{(bf16_t*)(p.ws + WS_QKV), (bf16_t*)(p.ws + WS_GATES)}; pg8::gemm_phase(lds3, g, S, E);
      } else if (k == 5) { phase_qknorm(p, l); }
      else { phase_attn(p, l, shm); }
    }
    if (ph + 1 < ph_hi) {
      if (ph == 0) { gsync(grid); xb = xcd_barrier_post(xbar, xst); }
      else xcd_barrier(xb);
    }
  }
}

#ifndef N_LAUNCH_MODE
#define N_LAUNCH_MODE 1
#endif
extern "C" void kernel_launch(void* const* d_in, const int* in_sizes, int n_in, void* d_out, int out_size, void* d_ws, size_t ws_size, hipStream_t stream) {
  static int grid = 0;
  if (grid == 0) {
    if (n_in != 24 || out_size != T_TOK * DM || ws_size < WS_END2) { fprintf(stderr, "kernel_launch: unexpected shapes (n_in %d out %d ws %zu need %zu)\n", n_in, out_size, ws_size, (size_t)WS_END2); grid = -1; return; }
    int dev = 0, cus = 0, per_cu = 0;
    (void)hipGetDevice(&dev); (void)hipDeviceGetAttribute(&cus, hipDeviceAttributeMultiprocessorCount, dev);
    if (hipFuncSetAttribute((const void*)mega_fwd, hipFuncAttributeMaxDynamicSharedMemorySize, LDS_BYTES) != hipSuccess) { fprintf(stderr, "kernel_launch: hipFuncSetAttribute failed\n"); grid = -1; return; }
    if (hipOccupancyMaxActiveBlocksPerMultiprocessor(&per_cu, (const void*)mega_fwd, 512, LDS_BYTES) != hipSuccess || per_cu < 1) { fprintf(stderr, "kernel_launch: occupancy query gave %d\n", per_cu); per_cu = 1; }
    (void)hipGetLastError();
    grid = cus;
  }
  if (grid < 0) return;
  Params p{};
  for (int i = 0; i < 24; ++i) p.in[i] = (const float*)d_in[i];
  p.out = (float*)d_out; p.ws = (unsigned char*)d_ws;
#if N_LAUNCH_MODE == 1
  int lo = 0, hi = N_PHASES;
  void* args[] = {&p, &lo, &hi};
  hipError_t e = hipLaunchCooperativeKernel((const void*)mega_fwd, dim3(grid), dim3(512), args, LDS_BYTES, stream);
  if (e != hipSuccess) fprintf(stderr, "kernel_launch: cooperative launch failed: %s (grid %d)\n", hipGetErrorString(e), grid);
#else
  for (int ph = 0; ph < N_PHASES; ++ph) hipLaunchKernelGGL(mega_fwd, dim3(grid), dim3(512), LDS_BYTES, stream, p, ph, ph + 1);
#endif
}
```

```cpp
#include <hip/hip_runtime.h>
#include <hip/hip_bf16.h>
#include <hip/hip_cooperative_groups.h>
#include <cstdio>
#include <cstdint>
#define N_LAUNCH_MODE 1
namespace cg = cooperative_groups;

typedef unsigned short bf16_t;
typedef short bf16x8 __attribute__((ext_vector_type(8)));
typedef short s16x4 __attribute__((ext_vector_type(4)));
typedef float f32x4 __attribute__((ext_vector_type(4)));
typedef float f32x16 __attribute__((ext_vector_type(16)));
typedef unsigned u32x4 __attribute__((ext_vector_type(4)));
typedef unsigned u32x2 __attribute__((ext_vector_type(2)));
#define LAS __attribute__((address_space(3)))

constexpr int T_TOK = 32768, DM = 1024, DFF = 2816, NFF2 = 5632, WINC = 7680, QKVW = 4608, GW = 3072;
constexpr float EPS = 1e-6f, LOG2E = 1.4426950408889634f, NEGBIG = -1e30f;
constexpr size_t WB_FFIN0 = 0, WB_FFIN1 = 11534336, WB_FFOUT0 = 23068672, WB_FFOUT1 = 28835840, WB_WIN = 34603008, WB_WO = 50331648;
constexpr size_t WS_MOD = 52428800, WS_ROPE = 53755904, WS_LUT = 53821440, WS_LAM = 53854208, WS_XN = 53854464;
constexpr size_t WS_QKV = WS_XN + 67108864, WS_GATES = WS_QKV + 301989888, WS_PARK = WS_GATES + 201326592, WS_END = WS_PARK + 67108864;
constexpr size_t WS_BAR = WS_END, WS_END2 = WS_END + 16384;
constexpr int LDS_BYTES = 131072 + 16;

struct Params { const float* in[24]; float* out; unsigned char* ws; };

typedef __bf16 bf16v2 __attribute__((ext_vector_type(2)));
typedef float f32x2 __attribute__((ext_vector_type(2)));
__device__ __forceinline__ unsigned cvtpk(float lo, float hi) { f32x2 v = {lo, hi}; bf16v2 b = __builtin_convertvector(v, bf16v2); return __builtin_bit_cast(unsigned, b); }
__device__ __forceinline__ float bf_lo(unsigned u) { return __uint_as_float(u << 16); }
__device__ __forceinline__ float bf_hi(unsigned u) { return __uint_as_float(u & 0xffff0000u); }
__device__ __forceinline__ float bf2f(bf16_t v) { return __uint_as_float(((unsigned)v) << 16); }

namespace pg8 {
constexpr int BM = 256, BK = 64, HALF = 128, HTB = HALF * BK * 2, STAGE_BYTES = 8 * HTB, NXCD = 8, WGM = 8;
__device__ __forceinline__ int lds_byte(int r, int c) { const int st = (r >> 4) * 2 + (c >> 5), rr = r & 15, cc = c & 31, ob = rr * 64 + cc * 2; return st * 1024 + (ob ^ (((ob >> 9) & 1) << 5)); }
__device__ __forceinline__ void stage_rc(int b, int& R, int& C) { const int st = b / 1024, sb = b % 1024, swz = sb ^ (((sb >> 9) & 1) << 5); R = (st >> 1) * 16 + swz / 64; C = (st & 1) * 32 + (swz % 64) / 2; }
__device__ __forceinline__ int perm32(int rho) { const int n = rho >> 4, i = rho & 15; return 8 * (i >> 2) + 4 * n + (i & 3); }
struct Unit { int pm, pn; };
struct Gemm { const bf16_t* A; const bf16_t* Bt; int M, N, K; };
struct StaticOrder {
    int nM, nN, nwg, G, c;
    __device__ void init(int M, int N, int G_, int c_) { nM = M / BM; nN = N / BM; nwg = nM * nN; G = G_; c = c_; }
    __device__ bool next(int i, Unit& u) const {
        const long L = (long)i * G + c; if (L >= nwg) return false;
        int wgid = (int)L; { const int q = nwg / NXCD, r = nwg % NXCD, xcd = wgid % NXCD, off = wgid / NXCD; wgid = (xcd < r ? xcd * (q + 1) : r * (q + 1) + (xcd - r) * q) + off; }
        const int nig = WGM * nN, gid = wgid / nig, fm = gid * WGM, gsz = (nM - fm) < WGM ? (nM - fm) : WGM;
        u.pm = fm + ((wgid % nig) % gsz); u.pn = (wgid % nig) / gsz; return true;
    }
};

template <class Epi>
__device__ __forceinline__ void gemm_phase(LAS unsigned char* lds, const Gemm g, const StaticOrder& S, const Epi& E) {
    int tid_ = threadIdx.x; asm volatile("" : "+v"(tid_));
    const int tid = tid_, wid = __builtin_amdgcn_readfirstlane(tid >> 6), lane = tid & 63, wr = wid >> 2, wc = wid & 3, fr = lane & 15, fq = lane >> 4;
    const int K = g.K, nt = K / BK;
    unsigned voffA[2], voffB[2];
#pragma unroll
    for (int i = 0; i < 2; ++i) { int R, C; stage_rc(tid * 16 + i * 8192, R, C); const int Rb = Epi::PERM ? ((R & ~31) + perm32(R & 31)) : R;
        voffA[i] = (unsigned)(R * K + C) * 2u; voffB[i] = (unsigned)(Rb * K + C) * 2u; }
    const size_t kstep = (size_t)(BK * 2);
    const size_t hstep = (size_t)HALF * K * 2;
    const size_t tstep = 2 * hstep;
    const unsigned ldsw = (unsigned)wid * 1024u;
    const int aoff = lds_byte(wr * 64 + fr, fq * 8), boff = lds_byte(wc * 32 + fr, fq * 8);
#define PG8_SA(b, h) (((b) * 2 + (h)) * HTB)
#define PG8_SB(b, h) ((4 + (b) * 2 + (h)) * HTB)
#define PG8_STAGE(bufoff, gbase, voff) do { _Pragma("unroll") for (int _i = 0; _i < 2; ++_i) \
        __builtin_amdgcn_global_load_lds((const unsigned*)((const char*)(gbase) + (voff)[_i]), (LAS unsigned*)(lds + (bufoff) + ldsw + _i * 8192), 16, 0, 0); } while (0)
#define PG8_LDA(dst, b, h) do { _Pragma("unroll") for (int m = 0; m < 4; ++m) _Pragma("unroll") for (int k = 0; k < 2; ++k) dst[m][k] = *(const LAS bf16x8*)(lds + PG8_SA(b, h) + aoff + m * 2048 + k * 1024); } while (0)
#define PG8_LDB(dst, b, h) do { _Pragma("unroll") for (int n = 0; n < 2; ++n) _Pragma("unroll") for (int k = 0; k < 2; ++k) dst[n][k] = *(const LAS bf16x8*)(lds + PG8_SB(b, h) + boff + n * 2048 + k * 1024); } while (0)
#define PG8_MMA(ai, bj, At, Bt) do { __builtin_amdgcn_s_setprio(1); _Pragma("unroll") for (int m = 0; m < 4; ++m) _Pragma("unroll") for (int n = 0; n < 2; ++n) _Pragma("unroll") for (int k = 0; k < 2; ++k) \
        acc[ai][bj][m][n] = __builtin_amdgcn_mfma_f32_16x16x32_bf16(Bt[n][k], At[m][k], acc[ai][bj][m][n], 0, 0, 0); __builtin_amdgcn_s_setprio(0); } while (0)
#define PG8_WAIT_V(n) asm volatile("s_waitcnt vmcnt(" #n ")" ::: "memory")
#define PG8_WAIT_L(n) asm volatile("s_waitcnt lgkmcnt(" #n ")" ::: "memory")
#define PG8_BAR __builtin_amdgcn_s_barrier()
#define PG8_SCHED __builtin_amdgcn_sched_barrier(0)
    Unit cur, nxt; int ui = 0;
    if (!S.next(0, cur)) return;
    f32x4 acc[2][2][4][2];
#pragma unroll
    for (int a = 0; a < 2; ++a)
#pragma unroll
        for (int b = 0; b < 2; ++b)
#pragma unroll
            for (int m = 0; m < 4; ++m)
#pragma unroll
                for (int n = 0; n < 2; ++n) acc[a][b][m][n] = (f32x4){0.f, 0.f, 0.f, 0.f};
    bf16x8 At[4][2], B0[2][2], B1[2][2];
    const char* cA = (const char*)g.A + (size_t)cur.pm * tstep; const char* cB = (const char*)g.Bt + (size_t)cur.pn * tstep;
    PG8_STAGE(PG8_SB(0, 0), cB, voffB); PG8_STAGE(PG8_SA(0, 0), cA, voffA); PG8_STAGE(PG8_SB(0, 1), cB + hstep, voffB); PG8_STAGE(PG8_SA(0, 1), cA + hstep, voffA);
    if (wr == 1) PG8_BAR;
    PG8_WAIT_V(4); PG8_BAR;
    PG8_STAGE(PG8_SB(1, 0), cB + kstep, voffB); PG8_STAGE(PG8_SA(1, 0), cA + kstep, voffA); PG8_STAGE(PG8_SB(1, 1), cB + hstep + kstep, voffB);
    PG8_WAIT_V(6); PG8_BAR;
    for (;;) {
        const bool has_next = S.next(ui + 1, nxt);
        const char* nA = has_next ? (const char*)g.A + (size_t)nxt.pm * tstep : cA; const char* nB = has_next ? (const char*)g.Bt + (size_t)nxt.pn * tstep : cB;
        for (int t = 0; t < nt; t += 2) {
            const bool last = (t == nt - 2);
            const char* a1 = cA + (size_t)(t + 1) * kstep;
            const char* a2 = last ? nA : cA + (size_t)(t + 2) * kstep; const char* b2 = last ? nB : cB + (size_t)(t + 2) * kstep;
            const char* a3 = a2 + kstep; const char* b3 = b2 + kstep;
            PG8_LDB(B0, 0, 0); PG8_SCHED; PG8_LDA(At, 0, 0); PG8_STAGE(PG8_SA(1, 1), a1 + hstep, voffA);
            PG8_WAIT_L(8); PG8_BAR; PG8_WAIT_L(0); PG8_MMA(0, 0, At, B0); PG8_BAR; PG8_SCHED;
            PG8_LDB(B1, 0, 1); PG8_STAGE(PG8_SB(0, 0), b2, voffB);
            PG8_BAR; PG8_WAIT_L(0); PG8_MMA(0, 1, At, B1); PG8_BAR;
            PG8_LDA(At, 0, 1); PG8_STAGE(PG8_SA(0, 0), a2, voffA);
            PG8_BAR; PG8_WAIT_L(0); PG8_MMA(1, 0, At, B0); PG8_BAR; PG8_SCHED;
            PG8_STAGE(PG8_SB(0, 1), b2 + hstep, voffB);
            PG8_WAIT_V(6); PG8_BAR; PG8_MMA(1, 1, At, B1); PG8_BAR;
            PG8_LDB(B0, 1, 0); PG8_SCHED; PG8_LDA(At, 1, 0); PG8_STAGE(PG8_SA(0, 1), a2 + hstep, voffA);
            PG8_WAIT_L(8); PG8_BAR; PG8_WAIT_L(0); PG8_MMA(0, 0, At, B0); PG8_BAR; PG8_SCHED;
            PG8_LDB(B1, 1, 1); PG8_STAGE(PG8_SB(1, 0), b3, voffB);
            PG8_BAR; PG8_WAIT_L(0); PG8_MMA(0, 1, At, B1); PG8_BAR;
            PG8_LDA(At, 1, 1); PG8_STAGE(PG8_SA(1, 0), a3, voffA);
            PG8_BAR; PG8_WAIT_L(0); PG8_MMA(1, 0, At, B0); PG8_BAR; PG8_SCHED;
            PG8_STAGE(PG8_SB(1, 1), b3 + hstep, voffB);
            PG8_WAIT_V(6); PG8_BAR; PG8_MMA(1, 1, At, B1); PG8_BAR;
        }
        E(acc, cur, wr, wc, fr, fq);
        if (!has_next) break;
#pragma unroll
        for (int a = 0; a < 2; ++a)
#pragma unroll
            for (int b = 0; b < 2; ++b)
#pragma unroll
                for (int m = 0; m < 4; ++m)
#pragma unroll
                    for (int n = 0; n < 2; ++n) acc[a][b][m][n] = (f32x4){0.f, 0.f, 0.f, 0.f};
        cur = nxt; cA = nA; cB = nB; ++ui;
    }
    PG8_WAIT_V(0);
    if (wr == 0) PG8_BAR;
    PG8_BAR;
#undef PG8_SA
#undef PG8_SB
#undef PG8_STAGE
#undef PG8_LDA
#undef PG8_LDB
#undef PG8_MMA
#undef PG8_WAIT_V
#undef PG8_WAIT_L
#undef PG8_BAR
#undef PG8_SCHED
}

__device__ __forceinline__ float silu_f(float g) { return g * __builtin_amdgcn_rcpf(1.f + __expf(-g)); }
__device__ __forceinline__ float sigm_f(float g) { return __builtin_amdgcn_rcpf(1.f + __expf(-g)); }
struct EpiSwiGLU {
    static constexpr bool PERM = true;
    bf16_t* H;
    __device__ __forceinline__ void operator()(const f32x4 (&acc)[2][2][4][2], const Unit& u, int wr, int wc, int fr, int fq) const {
        const int row0 = u.pm * BM + wr * 64 + fr, col0 = u.pn * 128 + wc * 32 + 8 * fq;
#pragma unroll
        for (int ai = 0; ai < 2; ++ai)
#pragma unroll
            for (int m = 0; m < 4; ++m) { bf16_t* rowp = H + (size_t)(row0 + ai * HALF + m * 16) * DFF + col0;
                const f32x4 g0 = acc[ai][0][m][0], g1 = acc[ai][0][m][1], u0 = acc[ai][1][m][0], u1 = acc[ai][1][m][1];
                u32x4 w; w.x = cvtpk(silu_f(g0[0]) * u0[0], silu_f(g0[1]) * u0[1]); w.y = cvtpk(silu_f(g0[2]) * u0[2], silu_f(g0[3]) * u0[3]);
                w.z = cvtpk(silu_f(g1[0]) * u1[0], silu_f(g1[1]) * u1[1]); w.w = cvtpk(silu_f(g1[2]) * u1[2], silu_f(g1[3]) * u1[3]);
                *(u32x4*)rowp = w; }
    }
};
struct EpiResid {
    static constexpr bool PERM = false;
    float* X; const float* modg; float gs;
    __device__ __forceinline__ void operator()(const f32x4 (&acc)[2][2][4][2], const Unit& u, int wr, int wc, int fr, int fq) const {
        const int row0 = u.pm * BM + wr * 64 + fr, col0 = u.pn * BM + wc * 32 + 4 * fq;
        const int bi = u.pm < 64 ? (u.pm >> 3) : 8;
        const float* mg = modg + (size_t)bi * 9216 + col0;
        f32x4 gv[2][2];
#pragma unroll
        for (int bj = 0; bj < 2; ++bj)
#pragma unroll
            for (int n = 0; n < 2; ++n) gv[bj][n] = *(const f32x4*)(mg + bj * HALF + n * 16) * gs;
#pragma unroll
        for (int ai = 0; ai < 2; ++ai)
#pragma unroll
            for (int m = 0; m < 4; ++m) { float* rowp = X + (size_t)(row0 + ai * HALF + m * 16) * DM + col0;
#pragma unroll
                for (int bj = 0; bj < 2; ++bj)
#pragma unroll
                    for (int n = 0; n < 2; ++n) { f32x4* q = (f32x4*)(rowp + bj * HALF + n * 16); *q = *q + gv[bj][n] * acc[ai][bj][m][n]; } }
    }
};
struct EpiQKV {
    static constexpr bool PERM = true;
    bf16_t* QKV; bf16_t* GATES;
    __device__ __forceinline__ void operator()(const f32x4 (&acc)[2][2][4][2], const Unit& u, int wr, int wc, int fr, int fq) const {
        const int row0 = u.pm * BM + wr * 64 + fr;
        if (u.pn < 18) {
            const int col0 = u.pn * BM + wc * 32 + 8 * fq;
#pragma unroll
            for (int ai = 0; ai < 2; ++ai)
#pragma unroll
                for (int m = 0; m < 4; ++m) { bf16_t* rowp = QKV + (size_t)(row0 + ai * HALF + m * 16) * QKVW + col0;
#pragma unroll
                    for (int bj = 0; bj < 2; ++bj) { const f32x4 v0 = acc[ai][bj][m][0], v1 = acc[ai][bj][m][1];
                        u32x4 w; w.x = cvtpk(v0[0], v0[1]); w.y = cvtpk(v0[2], v0[3]); w.z = cvtpk(v1[0], v1[1]); w.w = cvtpk(v1[2], v1[3]);
                        *(u32x4*)(rowp + bj * HALF) = w; } }
        } else {
            const int col0 = (u.pn - 18) * BM + wc * 32 + 8 * fq;
#pragma unroll
            for (int ai = 0; ai < 2; ++ai)
#pragma unroll
                for (int m = 0; m < 4; ++m) { bf16_t* rowp = GATES + (size_t)(row0 + ai * HALF + m * 16) * GW + col0;
#pragma unroll
                    for (int bj = 0; bj < 2; ++bj) { const f32x4 v0 = acc[ai][bj][m][0], v1 = acc[ai][bj][m][1];
                        u32x4 w; w.x = cvtpk(sigm_f(v0[0]), sigm_f(v0[1])); w.y = cvtpk(sigm_f(v0[2]), sigm_f(v0[3])); w.z = cvtpk(sigm_f(v1[0]), sigm_f(v1[1])); w.w = cvtpk(sigm_f(v1[2]), sigm_f(v1[3]));
                        *(u32x4*)(rowp + bj * HALF) = w; } }
        }
    }
};
}

constexpr int LDQK = QKVW;
constexpr int SHM_V = 64 * 128 * 2, SHM_K = 64 * 128 * 2;
constexpr int ATT_WS_OFF = 2 * SHM_V + 2 * SHM_K, ATT_LUT_OFF = ATT_WS_OFF + 8 * 64 * 4;
#define KSWZ(row, colB) ((row) * 256 + ((colB) ^ (((row) & 7) << 4)))
#define SBAR() __builtin_amdgcn_sched_barrier(0)
__device__ __forceinline__ int crow(int r, int hi) { return (r & 3) + 8 * (r >> 2) + 4 * hi; }

template <int MODE>
__device__ __forceinline__ void partialSM(f32x16& p0, f32x16& p1, float& m_reg, float& mn, float& alpha, int relh, int relw_min, int relw_max, const float* lut) {
  if constexpr (MODE == 0) {
    constexpr float SCALE = 0.088388347648318440f, C = SCALE * LOG2E, THR = 8.f;
    float pmax = p0[0];
#pragma unroll
    for (int r = 1; r < 16; ++r) pmax = fmaxf(pmax, p0[r]);
#pragma unroll
    for (int r = 0; r < 16; ++r) pmax = fmaxf(pmax, p1[r]);
    { auto rr = __builtin_amdgcn_permlane32_swap(__float_as_uint(pmax), __float_as_uint(pmax), false, false);
      pmax = fmaxf(__uint_as_float(rr[0]), __uint_as_float(rr[1])); }
    if (__builtin_expect(__all(pmax - m_reg <= THR / SCALE), 1)) { mn = m_reg; alpha = 1.f; }
    else { mn = fmaxf(m_reg, pmax); alpha = __builtin_amdgcn_exp2f((m_reg - mn) * C); m_reg = mn; }
    const float mnC = -mn * C;
#pragma unroll
    for (int r = 0; r < 16; ++r) p0[r] = fmaf(p0[r], C, mnC);
#pragma unroll
    for (int r = 0; r < 16; ++r) p1[r] = fmaf(p1[r], C, mnC);
#pragma unroll
    for (int r = 0; r < 16; ++r) p0[r] = __builtin_amdgcn_exp2f(p0[r]);
  } else {
    constexpr float C = (MODE == 1 ? 0.088388347648318440f : 0.125f) * LOG2E, THR2 = 8.f * LOG2E;
    bool nearT = true; float cfar = 0.f;
    if constexpr (MODE >= 2) {
      if (relw_max <= -128) { nearT = false; cfar = lut[0]; }
      else if (relw_min >= 128) { nearT = false; cfar = lut[258]; }
      if (!nearT) {
        float pmax = p0[0];
#pragma unroll
        for (int r = 1; r < 16; ++r) pmax = fmaxf(pmax, p0[r]);
#pragma unroll
        for (int r = 0; r < 16; ++r) pmax = fmaxf(pmax, p1[r]);
        { auto rr = __builtin_amdgcn_permlane32_swap(__float_as_uint(pmax), __float_as_uint(pmax), false, false);
          pmax = fmaxf(__uint_as_float(rr[0]), __uint_as_float(rr[1])); }
        const float tmax = fmaf(pmax, C, cfar);
        if (__builtin_expect(__all(tmax - m_reg <= THR2), 1)) { mn = m_reg; alpha = 1.f; }
        else { mn = fmaxf(m_reg, tmax); alpha = __builtin_amdgcn_exp2f(m_reg - mn); m_reg = mn; }
        const float off = cfar - mn;
#pragma unroll
        for (int r = 0; r < 16; ++r) p0[r] = fmaf(p0[r], C, off);
#pragma unroll
        for (int r = 0; r < 16; ++r) p1[r] = fmaf(p1[r], C, off);
#pragma unroll
        for (int r = 0; r < 16; ++r) p0[r] = __builtin_amdgcn_exp2f(p0[r]);
        return;
      }
    }
    if (nearT) {
#pragma unroll
      for (int r = 0; r < 16; ++r) { const int i0 = relh + (r & 3) + 8 * (r >> 2);
        const int a0 = min(max(i0, -129), 129) + 129, a1 = min(max(i0 + 32, -129), 129) + 129;
        p0[r] = fmaf(p0[r], C, lut[a0]); p1[r] = fmaf(p1[r], C, lut[a1]); }
    } else {
#pragma unroll
      for (int r = 0; r < 16; ++r) { p0[r] = fmaf(p0[r], C, cfar); p1[r] = fmaf(p1[r], C, cfar); }
    }
    float pmax = p0[0];
#pragma unroll
    for (int r = 1; r < 16; ++r) pmax = fmaxf(pmax, p0[r]);
#pragma unroll
    for (int r = 0; r < 16; ++r) pmax = fmaxf(pmax, p1[r]);
    { auto rr = __builtin_amdgcn_permlane32_swap(__float_as_uint(pmax), __float_as_uint(pmax), false, false);
      pmax = fmaxf(__uint_as_float(rr[0]), __uint_as_float(rr[1])); }
    if (__builtin_expect(__all(pmax - m_reg <= THR2), 1)) { mn = m_reg; alpha = 1.f; }
    else { mn = fmaxf(m_reg, pmax); alpha = __builtin_amdgcn_exp2f(m_reg - mn); m_reg = mn; }
#pragma unroll
    for (int r = 0; r < 16; ++r) p0[r] = __builtin_amdgcn_exp2f(p0[r] - mn);
#pragma unroll
    for (int r = 0; r < 16; ++r) p1[r] = p1[r] - mn;
  }
}
__device__ __forceinline__ void finishSM(f32x16& p0, f32x16& p1, float alpha, float& l_reg, bf16x8& pa0, bf16x8& pa1, bf16x8& pa2, bf16x8& pa3) {
#pragma unroll
  for (int r = 0; r < 16; ++r) p1[r] = __builtin_amdgcn_exp2f(p1[r]);
  float ps = 0;
#pragma unroll
  for (int r = 0; r < 16; ++r) ps += p0[r];
#pragma unroll
  for (int r = 0; r < 16; ++r) ps += p1[r];
  { auto rr = __builtin_amdgcn_permlane32_swap(__float_as_uint(ps), __float_as_uint(ps), false, false);
    ps = __uint_as_float(rr[0]) + __uint_as_float(rr[1]); }
  l_reg = l_reg * alpha + ps;
#define PK4(P, BASE, OUT) do { unsigned a0 = cvtpk(P[BASE + 0], P[BASE + 1]), a1 = cvtpk(P[BASE + 2], P[BASE + 3]);   \
    unsigned b0 = cvtpk(P[BASE + 4], P[BASE + 5]), b1 = cvtpk(P[BASE + 6], P[BASE + 7]);                              \
    auto r0 = __builtin_amdgcn_permlane32_swap(a0, b0, false, false); auto r1 = __builtin_amdgcn_permlane32_swap(a1, b1, false, false); \
    u32x4 w = {r0[0], r1[0], r0[1], r1[1]}; OUT = *reinterpret_cast<bf16x8*>(&w); } while (0)
  PK4(p0, 0, pa0); PK4(p0, 8, pa1); PK4(p1, 0, pa2); PK4(p1, 8, pa3);
#undef PK4
}
template <int ND0, int DOFF>
__device__ __forceinline__ void qkt(f32x16& p0, f32x16& p1, const char* Ks, const bf16x8* qr, int r32, int hi) {
  p0 = f32x16{}; p1 = f32x16{};
#pragma unroll
  for (int d0 = 0; d0 < ND0; ++d0) { const int cb = ((d0 + DOFF) * 16 + hi * 8) * 2;
    bf16x8 b0 = *reinterpret_cast<const bf16x8*>(Ks + KSWZ(r32, cb));
    bf16x8 b1 = *reinterpret_cast<const bf16x8*>(Ks + KSWZ(32 + r32, cb));
    p0 = __builtin_amdgcn_mfma_f32_32x32x16_bf16(b0, qr[d0], p0, 0, 0, 0);
    p1 = __builtin_amdgcn_mfma_f32_32x32x16_bf16(b1, qr[d0], p1, 0, 0, 0); }
}
__device__ __forceinline__ int v_st(int k, int c) { const int kk = (k & ~0xC) | ((k & 4) << 1) | ((k & 8) >> 1); return ((kk >> 3) * 4 + (c >> 5)) * 512 + ((kk & 7) * 32 + (c & 31)) * 2; }
__device__ __forceinline__ int v_rd_base(int lane) { return ((lane & 3) << 3) | (((lane >> 2) & 3) << 6) | (((lane >> 4) & 1) << 5) | (((lane >> 5) & 1) << 8); }
constexpr int v_rd_off(int d0, int ks, int half) { return d0 * 512 + ks * 4096 + half * 2048; }
template <int OFF> __device__ __forceinline__ s16x4 tr_read(int vb) {
  s16x4 r; asm volatile("ds_read_b64_tr_b16 %0, %1 offset:%2" : "=&v"(r) : "v"(vb), "i"(OFF) : "memory"); return r;
}
template <int D0> __device__ __forceinline__ void pv_one(f32x16& od, int vb, bf16x8 pa0, bf16x8 pa1, bf16x8 pa2, bf16x8 pa3) {
  const s16x4 l0 = tr_read<v_rd_off(D0, 0, 0)>(vb), h0 = tr_read<v_rd_off(D0, 0, 1)>(vb), l1 = tr_read<v_rd_off(D0, 1, 0)>(vb), h1 = tr_read<v_rd_off(D0, 1, 1)>(vb);
  const s16x4 l2 = tr_read<v_rd_off(D0, 2, 0)>(vb), h2 = tr_read<v_rd_off(D0, 2, 1)>(vb), l3 = tr_read<v_rd_off(D0, 3, 0)>(vb), h3 = tr_read<v_rd_off(D0, 3, 1)>(vb);
  asm volatile("s_waitcnt lgkmcnt(0)" ::: "memory"); SBAR();
#define PK(L, H) (bf16x8){L[0], L[1], L[2], L[3], H[0], H[1], H[2], H[3]}
  od = __builtin_amdgcn_mfma_f32_32x32x16_bf16(pa0, PK(l0, h0), od, 0, 0, 0);
  od = __builtin_amdgcn_mfma_f32_32x32x16_bf16(pa1, PK(l1, h1), od, 0, 0, 0);
  od = __builtin_amdgcn_mfma_f32_32x32x16_bf16(pa2, PK(l2, h2), od, 0, 0, 0);
  od = __builtin_amdgcn_mfma_f32_32x32x16_bf16(pa3, PK(l3, h3), od, 0, 0, 0);
#undef PK
}
__device__ __forceinline__ void pv_d0(f32x16* o, int vb, bf16x8 pa0, bf16x8 pa1, bf16x8 pa2, bf16x8 pa3) {
  pv_one<0>(o[0], vb, pa0, pa1, pa2, pa3); pv_one<1>(o[1], vb, pa0, pa1, pa2, pa3); pv_one<2>(o[2], vb, pa0, pa1, pa2, pa3); pv_one<3>(o[3], vb, pa0, pa1, pa2, pa3);
}

struct AttnEpi {
  const bf16_t* gate;
  float* park;
  bf16_t* merged;
  const float* gsub;
  float lam, oml;
  float sinkl2;
  const float* gq;
};

template <int MODE>
__device__ __forceinline__ void attn_body(const bf16_t* __restrict__ Qb, const bf16_t* __restrict__ Kh, const bf16_t* __restrict__ Vh, int NT, int krel0,
                                          char* lds, const float* __restrict__ lutg, const AttnEpi& E) {
  constexpr int ND0 = (MODE < 2) ? 8 : 4, DOFF = (MODE == 3) ? 4 : 0;
  int tid_ = threadIdx.x; asm volatile("" : "+v"(tid_));
  const int tid = tid_, wid = tid >> 6, lane = tid & 63, r32 = lane & 31, hi = lane >> 5;
  char* V_lds = lds; char* K_lds = lds + 2 * SHM_V;
  float* wsm = (float*)(lds + ATT_WS_OFF) + wid * 64; float* li_l = wsm; float* al_l = wsm + 32;
  float* lut = (float*)(lds + ATT_LUT_OFF);
  __syncthreads();
  if constexpr (MODE != 0) { if (tid < 259) lut[tid] = lutg[tid]; }
  float m_reg = -1e30f, l_reg = 0; f32x16 o[4] = {}; bf16x8 qr[ND0];
  const bf16_t* Qw = Qb + (size_t)(wid * 32 + r32) * LDQK + hi * 8;
  {
    float qf[ND0][8]; float ss = 0.f;
#pragma unroll
    for (int d0 = 0; d0 < ND0; ++d0) { const bf16x8 raw = *reinterpret_cast<const bf16x8*>(Qw + d0 * 16);
#pragma unroll
      for (int j = 0; j < 8; ++j) { const float v = __uint_as_float(((unsigned)(unsigned short)raw[j]) << 16); qf[d0][j] = v; ss += v * v; } }
    { auto rr = __builtin_amdgcn_permlane32_swap(__float_as_uint(ss), __float_as_uint(ss), false, false);
      ss = __uint_as_float(rr[0]) + __uint_as_float(rr[1]); }
    const float rs = rsqrtf(ss * (MODE < 2 ? (1.f / 128.f) : (1.f / 64.f)) + EPS);
#pragma unroll
    for (int d0 = 0; d0 < ND0; ++d0) { const f32x4 g0 = *(const f32x4*)(E.gq + d0 * 16 + hi * 8), g1 = *(const f32x4*)(E.gq + d0 * 16 + hi * 8 + 4);
#pragma unroll
      for (int j = 0; j < 4; ++j) { qf[d0][j] = qf[d0][j] * rs * g0[j]; qf[d0][4 + j] = qf[d0][4 + j] * rs * g1[j]; } }
    if constexpr (MODE == 0) {
      const int sp = krel0 + wid * 32 + r32;
#pragma unroll
      for (int h = 0; h < 2; ++h) { const int pos = h == 0 ? (sp >> 6) : (sp & 63);
#pragma unroll
        for (int a = 0; a < 2; ++a) { const float* tb = lutg + (size_t)(pos * 32 + a * 16 + hi * 8) * 2;
#pragma unroll
          for (int jj = 0; jj < 4; ++jj) { const f32x4 cs = *(const f32x4*)(tb + jj * 4);
#pragma unroll
            for (int e = 0; e < 2; ++e) { const int j = 2 * jj + e; const float c = cs[2 * e], sn = cs[2 * e + 1];
              const float x1 = qf[4 * h + a][j], x2 = qf[4 * h + 2 + a][j];
              qf[4 * h + a][j] = x1 * c - x2 * sn; qf[4 * h + 2 + a][j] = x2 * c + x1 * sn; } } } }
    }
#pragma unroll
    for (int d0 = 0; d0 < ND0; ++d0) { u32x4 w; w.x = cvtpk(qf[d0][0], qf[d0][1]); w.y = cvtpk(qf[d0][2], qf[d0][3]); w.z = cvtpk(qf[d0][4], qf[d0][5]); w.w = cvtpk(qf[d0][6], qf[d0][7]);
      qr[d0] = *reinterpret_cast<bf16x8*>(&w); }
  }
  const int sr = tid >> 4, sc = (tid & 15) * 8, vst0 = v_st(sr, sc), vst1 = v_st(32 + sr, sc);
  const int vb0 = (int)(uintptr_t)V_lds + v_rd_base(lane);
  struct { bf16x8 vs0, vs1, ks0, ks1; } sr_[2];
#define SLOAD(i, k0) do { sr_[i].vs0 = *reinterpret_cast<const bf16x8*>(&Vh[(size_t)((k0) + sr) * LDQK + sc]); sr_[i].vs1 = *reinterpret_cast<const bf16x8*>(&Vh[(size_t)((k0) + 32 + sr) * LDQK + sc]); \
    sr_[i].ks0 = *reinterpret_cast<const bf16x8*>(&Kh[(size_t)((k0) + sr) * LDQK + sc]); sr_[i].ks1 = *reinterpret_cast<const bf16x8*>(&Kh[(size_t)((k0) + 32 + sr) * LDQK + sc]); } while (0)
#define SWRITE(b, i) do { *(bf16x8*)(V_lds + (b) * SHM_V + vst0) = sr_[i].vs0;          \
    *(bf16x8*)(V_lds + (b) * SHM_V + vst1) = sr_[i].vs1; int kc = sc * 2;               \
    *(bf16x8*)(K_lds + (b) * SHM_K + KSWZ(sr, kc)) = sr_[i].ks0;                       \
    *(bf16x8*)(K_lds + (b) * SHM_K + KSWZ(32 + sr, kc)) = sr_[i].ks1; } while (0)
#define SWAIT() asm volatile("s_waitcnt vmcnt(4)" ::: "memory")
#define RESC(a) do { if (__any((a) < 1.f)) { if (hi == 0) al_l[r32] = (a); asm volatile("s_waitcnt lgkmcnt(0)" ::: "memory"); \
    _Pragma("unroll") for (int d = 0; d < 4; ++d) _Pragma("unroll") for (int r = 0; r < 16; ++r) o[d][r] *= al_l[crow(r, hi)]; } } while (0)
  const int relq = krel0 - (wid * 32 + r32) + 4 * hi, relwmin = krel0 - (wid * 32 + 31), relwmax = krel0 + 63 - wid * 32;
#define PSM(P0, P1, MN, AL, J) partialSM<MODE>(P0, P1, m_reg, MN, AL, relq + 64 * (J), relwmin + 64 * (J), relwmax + 64 * (J), lut)
  f32x16 pA0, pA1, pB0, pB1; float mnA, mnB, alA, alB; bf16x8 pa0, pa1, pa2, pa3;
  constexpr int SE = 0, SO = 1;
  SLOAD(SE, 0); asm volatile("s_waitcnt vmcnt(0)" ::: "memory"); SWRITE(0, SE); __syncthreads();
  qkt<ND0, DOFF>(pA0, pA1, K_lds, qr, r32, hi); PSM(pA0, pA1, mnA, alA, 0);
  SLOAD(SO, 64); if (2 < NT) SLOAD(SE, 2 * 64);
  SWAIT(); SWRITE(1, SO); __syncthreads();
  for (int j = 1; j + 1 < NT; j += 2) {
    SBAR(); qkt<ND0, DOFF>(pB0, pB1, K_lds + SHM_K, qr, r32, hi);
    finishSM(pA0, pA1, alA, l_reg, pa0, pa1, pa2, pa3); SBAR();
    SLOAD(SO, (j + 2) * 64); SBAR();
    pv_d0(o, vb0, pa0, pa1, pa2, pa3); PSM(pB0, pB1, mnB, alB, j);
    __syncthreads(); SWAIT(); SWRITE(0, SE);
    RESC(alB); __syncthreads();
    SBAR(); qkt<ND0, DOFF>(pA0, pA1, K_lds, qr, r32, hi);
    finishSM(pB0, pB1, alB, l_reg, pa0, pa1, pa2, pa3); SBAR();
    if (j + 3 < NT) SLOAD(SE, (j + 3) * 64); SBAR();
    pv_d0(o, vb0 + SHM_V, pa0, pa1, pa2, pa3); PSM(pA0, pA1, mnA, alA, j + 1);
    __syncthreads(); SWAIT(); SWRITE(1, SO);
    RESC(alA); __syncthreads();
  }
  SBAR(); qkt<ND0, DOFF>(pB0, pB1, K_lds + SHM_K, qr, r32, hi);
  finishSM(pA0, pA1, alA, l_reg, pa0, pa1, pa2, pa3); SBAR();
  pv_d0(o, vb0, pa0, pa1, pa2, pa3); PSM(pB0, pB1, mnB, alB, NT - 1);
  __syncthreads(); RESC(alB);
  finishSM(pB0, pB1, alB, l_reg, pa0, pa1, pa2, pa3); SBAR();
  pv_d0(o, vb0 + SHM_V, pa0, pa1, pa2, pa3);
  if constexpr (MODE == 1) l_reg += __builtin_amdgcn_exp2f(E.sinkl2 - m_reg);
  if (hi == 0) li_l[r32] = l_reg; asm volatile("s_waitcnt lgkmcnt(0)" ::: "memory");
  float rli[16];
#pragma unroll
  for (int r = 0; r < 16; ++r) rli[r] = __builtin_amdgcn_rcpf(li_l[crow(r, hi)]);
  float* pk0 = E.park; float* pk1 = E.park + 64 * 512;
  const int rowb = wid * 32;
  if constexpr (MODE == 0 || MODE == 1) {
#pragma unroll
    for (int r = 0; r < 16; ++r) { const int row = rowb + crow(r, hi);
#pragma unroll
      for (int d0 = 0; d0 < 4; ++d0) { const int idx = (d0 * 16 + r) * 512 + tid;
        const float g = bf2f(E.gate[(size_t)row * GW + d0 * 32 + r32]);
        const float v = o[d0][r] * rli[r] * g;
        if constexpr (MODE == 0) pk0[idx] = v; else pk0[idx] += v; } }
  } else if constexpr (MODE == 2) {
#pragma unroll
    for (int r = 0; r < 16; ++r)
#pragma unroll
      for (int d0 = 0; d0 < 4; ++d0) pk1[(d0 * 16 + r) * 512 + tid] = o[d0][r] * rli[r];
  } else {
    float gs[4];
#pragma unroll
    for (int d0 = 0; d0 < 4; ++d0) gs[d0] = E.gsub[d0 * 32 + r32] * E.oml;
#pragma unroll
    for (int r = 0; r < 16; ++r) { const int row = rowb + crow(r, hi);
      float ss = 0.f;
#pragma unroll
      for (int d0 = 0; d0 < 4; ++d0) { const float c = pk1[(d0 * 16 + r) * 512 + tid] - E.lam * (o[d0][r] * rli[r]); o[d0][r] = c; ss += c * c; }
      ss += __shfl_xor(ss, 1); ss += __shfl_xor(ss, 2); ss += __shfl_xor(ss, 4); ss += __shfl_xor(ss, 8); ss += __shfl_xor(ss, 16);
      const float rs = rsqrtf(ss * (1.f / 128.f) + EPS);
#pragma unroll
      for (int d0 = 0; d0 < 4; ++d0) { const int col = d0 * 32 + r32;
        const float g = bf2f(E.gate[(size_t)row * GW + col]);
        const float y = o[d0][r] * rs * gs[d0] * g + pk0[(d0 * 16 + r) * 512 + tid];
        E.merged[(size_t)row * DM + col] = (bf16_t)(cvtpk(y, y) & 0xffffu); } }
  }
#undef SLOAD
#undef SWRITE
#undef SWAIT
#undef RESC
#undef PSM
}

__device__ __forceinline__ int t5bucket(int rel) {
  const int n = rel < 0 ? -rel : rel;
  const int b = n < 8 ? n : 8 + (n >= 12) + (n >= 16) + (n >= 23) + (n >= 32) + (n >= 46) + (n >= 64) + (n >= 91);
  return b + (rel > 0 ? 16 : 0);
}
__device__ __forceinline__ float wave_sum(float v) {
  v += __shfl_xor(v, 1); v += __shfl_xor(v, 2); v += __shfl_xor(v, 4); v += __shfl_xor(v, 8); v += __shfl_xor(v, 16); v += __shfl_xor(v, 32); return v;
}

__device__ __forceinline__ void phase_setup(const Params& p, unsigned char* shm) {
  int tid_ = threadIdx.x; asm volatile("" : "+v"(tid_)); const int tid = tid_, nb = gridDim.x, bid = blockIdx.x, wid = tid >> 6, lane = tid & 63;
  if (bid == 0) { unsigned* xbar = (unsigned*)(p.ws + WS_BAR); for (int i = tid; i < 3456; i += 512) xbar[i] = 0u; }
  {
    const float4* s0 = (const float4*)p.in[0]; const float4* s1 = (const float4*)p.in[1]; float4* o = (float4*)p.out;
    const size_t n4 = (size_t)16384 * 1024 / 4;
    for (size_t i = (size_t)bid * 512 + tid; i < 2 * n4; i += (size_t)nb * 512) o[i] = i < n4 ? s0[i] : s1[i - n4];
  }
  {
    float* rope = (float*)(p.ws + WS_ROPE);
    for (int i = bid * 512 + tid; i < 256 * 32; i += nb * 512) { const int pos = i >> 5, f = i & 31;
      const float inv = powf(10000.f, -(float)f / 32.f); const float ang = (float)pos * inv; rope[2 * i] = cosf(ang); rope[2 * i + 1] = sinf(ang); }
    float* lut = (float*)(p.ws + WS_LUT);
    for (int i = bid * 512 + tid; i < 16 * 259; i += nb * 512) { const int hh = i / 259, e = i % 259; int rel = e - 129; float v;
      if (hh < 8) { v = (rel < -128 || rel > 128) ? NEGBIG : p.in[23][t5bucket(rel) * 16 + hh] * LOG2E; }
      else { rel = rel < -128 ? -128 : (rel > 128 ? 128 : rel); v = p.in[23][t5bucket(rel) * 16 + hh] * LOG2E; }
      lut[i] = v; }
    if (bid == 0 && tid < 4) { const int l = tid; float s1 = 0.f, s2 = 0.f;
      for (int i = 0; i < 64; ++i) { s1 += p.in[18][l * 64 + i] * p.in[19][l * 64 + i]; s2 += p.in[20][l * 64 + i] * p.in[21][l * 64 + i]; }
      const float lam_init = 0.8f - 0.6f * expf(-0.3f * (float)l);
      float* lam = (float*)(p.ws + WS_LAM); lam[2 * l] = expf(s1) - expf(s2) + lam_init; lam[2 * l + 1] = 1.f - lam_init; }
  }
  {
    float* sc = (float*)shm; float* red = sc + 9 * 1024;
    for (int i = tid; i < 9 * 1024; i += 512) { const float c = i < 8192 ? p.in[2][i] : p.in[3][i - 8192]; sc[i] = c / (1.f + expf(-c)); }
    __syncthreads();
    float* mod = (float*)(p.ws + WS_MOD);
    for (int task = bid; task < 576; task += nb) {
      const int l = task / 144, j0 = (task % 144) * 64;
      const float* w = p.in[4] + (size_t)l * 1024 * 9216 + j0 + lane;
      float a0 = 0, a1 = 0, a2 = 0, a3 = 0, a4 = 0, a5 = 0, a6 = 0, a7 = 0, a8 = 0;
#pragma unroll 16
      for (int k = wid * 128; k < wid * 128 + 128; ++k) { const float wv = w[(size_t)k * 9216];
        a0 += sc[k] * wv; a1 += sc[1024 + k] * wv; a2 += sc[2048 + k] * wv; a3 += sc[3072 + k] * wv; a4 += sc[4096 + k] * wv;
        a5 += sc[5120 + k] * wv; a6 += sc[6144 + k] * wv; a7 += sc[7168 + k] * wv; a8 += sc[8192 + k] * wv; }
      float* rw = red + wid * 9 * 64 + lane;
      rw[0] = a0; rw[64] = a1; rw[128] = a2; rw[192] = a3; rw[256] = a4; rw[320] = a5; rw[384] = a6; rw[448] = a7; rw[512] = a8;
      __syncthreads();
      for (int i = tid; i < 9 * 64; i += 512) { const int b = i >> 6, ln = i & 63; float s = 0.f;
#pragma unroll
        for (int w8 = 0; w8 < 8; ++w8) s += red[w8 * 9 * 64 + b * 64 + ln];
        mod[((size_t)l * 9 + b) * 9216 + j0 + ln] = s + p.in[5][l * 9216 + j0 + ln]; }
      __syncthreads();
    }
  }
}

__device__ __forceinline__ void phase_convert(const Params& p, int l, unsigned char* shm) {
  float* tile = (float*)shm;
  int tid_ = threadIdx.x; asm volatile("" : "+v"(tid_)); const int tid = tid_;
  for (int q = blockIdx.x; q < 6400; q += gridDim.x) {
    const float* W; bf16_t* Bt; int N, K, k0, n0d, n0s;
    if (q < 2816) { const int i = q / 1408, qq = q % 1408; W = p.in[7] + (size_t)(l * 2 + i) * 1024 * 5632; Bt = (bf16_t*)(p.ws + (i ? WB_FFIN1 : WB_FFIN0)); N = 5632; K = 1024;
      k0 = (qq & 15) * 64; n0d = (qq >> 4) * 64; n0s = ((n0d >> 7) & 1) * 2816 + (n0d >> 8) * 128 + (n0d & 127); }
    else if (q < 4224) { const int i = (q - 2816) / 704, qq = (q - 2816) % 704; W = p.in[8] + (size_t)(l * 2 + i) * 2816 * 1024; Bt = (bf16_t*)(p.ws + (i ? WB_FFOUT1 : WB_FFOUT0)); N = 1024; K = 2816;
      k0 = (qq % 44) * 64; n0d = (qq / 44) * 64; n0s = n0d; }
    else if (q < 6144) { const int qq = q - 4224; W = p.in[9] + (size_t)l * 1024 * 7680; Bt = (bf16_t*)(p.ws + WB_WIN); N = 7680; K = 1024;
      k0 = (qq & 15) * 64; n0d = (qq >> 4) * 64; n0s = n0d; }
    else { const int qq = q - 6144; W = p.in[10] + (size_t)l * 1024 * 1024; Bt = (bf16_t*)(p.ws + WB_WO); N = 1024; K = 1024;
      k0 = (qq & 15) * 64; n0d = (qq >> 4) * 64; n0s = n0d; }
    { const int nl = tid & 63, ks = tid >> 6;
#pragma unroll
      for (int i = 0; i < 8; ++i) { const int k = ks + 8 * i; tile[nl * 65 + k] = W[(size_t)(k0 + k) * N + n0s + nl]; } }
    __syncthreads();
    { const int n = tid >> 3, kc = (tid & 7) * 8; const float* tr = tile + n * 65 + kc;
      u32x4 w; w.x = cvtpk(tr[0], tr[1]); w.y = cvtpk(tr[2], tr[3]); w.z = cvtpk(tr[4], tr[5]); w.w = cvtpk(tr[6], tr[7]);
      *(u32x4*)(Bt + (size_t)(n0d + n) * K + k0 + kc) = w; }
    __syncthreads();
  }
}

__device__ __forceinline__ void phase_norm(const float* __restrict__ x, const float* __restrict__ g, const float* __restrict__ modl, int jj, bf16_t* __restrict__ xn) {
  int tid_ = threadIdx.x; asm volatile("" : "+v"(tid_)); const int tid = tid_, wid = tid >> 6, lane = tid & 63;
  for (int row = (blockIdx.x * 8 + wid) * 2; row < T_TOK; row += gridDim.x * 16) {
    const int bi = row < 16384 ? (row >> 11) : 8;
    const float* shift = modl + (size_t)bi * 9216 + (3 * jj) * 1024; const float* scale = shift + 1024;
    const float4* xr = (const float4*)(x + (size_t)row * DM);
    float4 v[8]; float ss0 = 0.f, ss1 = 0.f;
#pragma unroll
    for (int i = 0; i < 8; ++i) v[i] = xr[lane + 64 * i];
#pragma unroll
    for (int i = 0; i < 4; ++i) { ss0 += v[i].x * v[i].x + v[i].y * v[i].y + v[i].z * v[i].z + v[i].w * v[i].w;
      ss1 += v[4 + i].x * v[4 + i].x + v[4 + i].y * v[4 + i].y + v[4 + i].z * v[4 + i].z + v[4 + i].w * v[4 + i].w; }
    ss0 = wave_sum(ss0); ss1 = wave_sum(ss1);
    const float rs0 = rsqrtf(ss0 * (1.f / 1024.f) + EPS), rs1 = rsqrtf(ss1 * (1.f / 1024.f) + EPS);
#pragma unroll
    for (int i = 0; i < 4; ++i) { const int c4 = lane + 64 * i;
      const float4 gg = ((const float4*)g)[c4], sc = ((const float4*)scale)[c4], sh = ((const float4*)shift)[c4];
      const float m0 = gg.x * (1.f + sc.x), m1 = gg.y * (1.f + sc.y), m2 = gg.z * (1.f + sc.z), m3 = gg.w * (1.f + sc.w);
      u32x2 w; w.x = cvtpk(v[i].x * rs0 * m0 + sh.x, v[i].y * rs0 * m1 + sh.y); w.y = cvtpk(v[i].z * rs0 * m2 + sh.z, v[i].w * rs0 * m3 + sh.w);
      *(u32x2*)(xn + (size_t)row * DM + c4 * 4) = w;
      u32x2 w2; w2.x = cvtpk(v[4 + i].x * rs1 * m0 + sh.x, v[4 + i].y * rs1 * m1 + sh.y); w2.y = cvtpk(v[4 + i].z * rs1 * m2 + sh.z, v[4 + i].w * rs1 * m3 + sh.w);
      *(u32x2*)(xn + (size_t)(row + 1) * DM + c4 * 4) = w2; }
  }
}

__device__ __forceinline__ void phase_qknorm(const Params& p, int l) {
  bf16_t* qkv = (bf16_t*)(p.ws + WS_QKV); const float* rope = (const float*)(p.ws + WS_ROPE);
  int tid_ = threadIdx.x; asm volatile("" : "+v"(tid_)); const int tid = tid_, wid = tid >> 6, lane = tid & 63;
  f32x2 gk[3];
  gk[0] = *(const f32x2*)(p.in[12] + l * 128 + 2 * lane); gk[1] = *(const f32x2*)(p.in[14] + l * 128 + 2 * lane);
  gk[2] = *(const f32x2*)(p.in[16] + l * 64 + ((2 * lane) & 63));
  const float sg = (lane & 16) ? 1.f : -1.f;
  for (int tok0 = (blockIdx.x * 8 + wid) * 4; tok0 < T_TOK; tok0 += gridDim.x * 32) {
    unsigned u[4][6];
#pragma unroll
    for (int t = 0; t < 4; ++t)
#pragma unroll
      for (int s = 0; s < 6; ++s) u[t][s] = ((const unsigned*)(qkv + (size_t)(tok0 + t) * QKVW + (s >> 1) * 1536 + 1024 + (s & 1) * 128))[lane];
#pragma unroll
    for (int t = 0; t < 4; ++t) { const int tok = tok0 + t;
      const int sp = tok < 16384 ? (tok & 2047) : (tok - 16384);
      const int pos = lane < 32 ? (sp >> 6) : (sp & 63);
      const f32x4 cs = *(const f32x4*)(rope + (size_t)(pos * 32 + ((2 * lane) & 31)) * 2);
#pragma unroll
      for (int s = 0; s < 6; ++s) { const int br = s >> 1;
        float a = bf_lo(u[t][s]), b = bf_hi(u[t][s]);
        float ss = a * a + b * b;
        ss += __shfl_xor(ss, 1); ss += __shfl_xor(ss, 2); ss += __shfl_xor(ss, 4); ss += __shfl_xor(ss, 8); ss += __shfl_xor(ss, 16);
        float rs;
        if (br < 2) { ss += __shfl_xor(ss, 32); rs = rsqrtf(ss * (1.f / 128.f) + EPS); }
        else rs = rsqrtf(ss * (1.f / 64.f) + EPS);
        a = a * rs * gk[br][0]; b = b * rs * gk[br][1];
        if (br == 0) { const float pa = __shfl_xor(a, 16), pb = __shfl_xor(b, 16);
          a = a * cs[0] + sg * pa * cs[1]; b = b * cs[2] + sg * pb * cs[3]; }
        ((unsigned*)(qkv + (size_t)tok * QKVW + br * 1536 + 1024 + (s & 1) * 128))[lane] = cvtpk(a, b); } }
  }
}

__device__ __forceinline__ void phase_attn(const Params& p, int l, unsigned char* shm) {
  const bf16_t* qkv = (const bf16_t*)(p.ws + WS_QKV); const bf16_t* gates = (const bf16_t*)(p.ws + WS_GATES);
  bf16_t* merged = (bf16_t*)(p.ws + WS_XN);
  const float* lutall = (const float*)(p.ws + WS_LUT); const float* lamp = (const float*)(p.ws + WS_LAM);
  AttnEpi E; E.park = (float*)(p.ws + WS_PARK) + (size_t)blockIdx.x * 65536; E.gsub = p.in[22] + l * 128; E.lam = lamp[2 * l]; E.oml = lamp[2 * l + 1];
  for (int it = blockIdx.x; it < 1024; it += gridDim.x) {
    int S, tok0, h, qb;
    if (it < 512) { S = 16384; tok0 = 16384; h = it & 7; qb = it >> 3; }
    else { const int j = it - 512; S = 2048; h = j & 7; qb = (j >> 3) & 7; tok0 = (j >> 6) * 2048; }
    const int g = h >> 2, q0 = qb * 256;
    const bf16_t* rowQ = qkv + (size_t)(tok0 + q0) * QKVW; const bf16_t* seqK = qkv + (size_t)tok0 * QKVW;
    const bf16_t* grow = gates + (size_t)(tok0 + q0) * GW + h * 128;
    E.merged = merged + (size_t)(tok0 + q0) * DM + h * 128; E.sinkl2 = p.in[17][l * 8 + h] * LOG2E;
    E.gate = grow; E.gq = p.in[11] + l * 128;
    attn_body<0>(rowQ + h * 128, seqK + 1024 + g * 128, seqK + 1280 + g * 128, S / 64, q0, (char*)shm, (const float*)(p.ws + WS_ROPE), E);
    { const int t_lo = max(0, 4 * qb - 2), t_hi = min(S / 64, 4 * qb + 6);
      const bf16_t* kb = seqK + (size_t)t_lo * 64 * QKVW;
      E.gate = grow + 1024; E.gq = p.in[13] + l * 128;
      attn_body<1>(rowQ + 1536 + h * 128, kb + 2560 + g * 128, kb + 2816 + g * 128, t_hi - t_lo, t_lo * 64 - q0, (char*)shm, lutall + h * 259, E); }
    E.gate = grow + 2048; E.gq = p.in[15] + l * 64;
    attn_body<2>(rowQ + 3072 + h * 128, seqK + 4096 + g * 128, seqK + 4352 + g * 128, S / 64, -q0, (char*)shm, lutall + (8 + h) * 259, E);
    attn_body<3>(rowQ + 3072 + h * 128 + 64, seqK + 4096 + g * 128, seqK + 4352 + g * 128, S / 64, -q0, (char*)shm, lutall + (8 + h) * 259, E);
  }
}

__device__ __forceinline__ void gsync(cg::grid_group& g) {
  asm volatile("s_waitcnt vmcnt(0) lgkmcnt(0)" ::: "memory");
  g.sync();
  __builtin_amdgcn_fence(__ATOMIC_ACQUIRE, "agent");
  asm volatile("s_waitcnt vmcnt(0)" ::: "memory");
}
#define XB_TMO      128
#define XB_XCNT(j)  (256  + 64 * (j))
#define XB_XSUB(j)  (1280 + 64 * (j))
#define XB_XGEN(j)  (2304 + 64 * (j))
#define XB_TOP      3328
#define XB_TOPGEN   3392
#define XCD_BAR_WORDS 3456
#define XB_SPIN_CAP (1u << 22)
__device__ __forceinline__ unsigned xb_ld(unsigned* p)              { return __hip_atomic_load(p, __ATOMIC_RELAXED, __HIP_MEMORY_SCOPE_AGENT); }
__device__ __forceinline__ unsigned xb_add(unsigned* p, unsigned v) { return __hip_atomic_fetch_add(p, v, __ATOMIC_RELAXED, __HIP_MEMORY_SCOPE_AGENT); }
__device__ __forceinline__ unsigned xb_xcc_id() { return (unsigned)__builtin_amdgcn_s_getreg((3 << 11) | 20) & 0xFu; }
#define XB_SPIN(cond, bar) do { unsigned _sp = 0; while (cond) { __builtin_amdgcn_s_sleep(1); \
    if ((++_sp & 255u) == 0u) { if (xb_ld(&(bar)[XB_TMO])) break; if (_sp > XB_SPIN_CAP) { atomicAdd(&(bar)[XB_TMO], 1u); break; } } } } while (0)
struct XcdBarrier { unsigned* bar; unsigned x; volatile LAS unsigned* st; };
__device__ __forceinline__ XcdBarrier xcd_barrier_post(unsigned* bar, volatile LAS unsigned* st) {
    XcdBarrier b; b.bar = bar; b.x = xb_xcc_id(); b.st = st;
    if (threadIdx.x == 0) (void)xb_add(&bar[XB_XCNT(b.x)], 1u);
    return b;
}
__device__ __forceinline__ void xcd_barrier_complete(unsigned* bar, unsigned x, unsigned& nloc, unsigned& nx) {
    const unsigned G = gridDim.x * gridDim.y * gridDim.z;
    unsigned sum, cnt, mine, sp = 0u;
    for (;;) {
        sum = 0u; cnt = 0u; mine = 0u;
#pragma unroll
        for (unsigned j = 0; j < 16; ++j) { const unsigned c = xb_ld(&bar[XB_XCNT(j)]); sum += c; cnt += (c > 0u) ? 1u : 0u; mine = (j == x) ? c : mine; }
        if (sum == G) break;
        __builtin_amdgcn_s_sleep(1);
        if ((++sp & 255u) == 0u) { if (xb_ld(&bar[XB_TMO])) break; if (sp > XB_SPIN_CAP) { atomicAdd(&bar[XB_TMO], 1u); break; } }
    }
    nloc = mine > 0u ? mine : 1u; nx = cnt > 0u ? cnt : 1u;
}
__device__ __forceinline__ void xcd_barrier(const XcdBarrier& b) {
    asm volatile("s_waitcnt vmcnt(0)" ::: "memory");
    __syncthreads();
    if (threadIdx.x == 0) {
        unsigned* bar = b.bar;
        __builtin_amdgcn_s_waitcnt(0);
        unsigned nloc = b.st[0], nx = b.st[1];
        if (nloc == 0u) { xcd_barrier_complete(bar, b.x, nloc, nx); b.st[0] = nloc; b.st[1] = nx; }
        const unsigned old = xb_add(&bar[XB_XSUB(b.x)], 1u);
        const unsigned gen = old / nloc;
        if (old + 1u == (gen + 1u) * nloc) {
            __builtin_amdgcn_fence(__ATOMIC_RELEASE, "agent");
            asm volatile("s_waitcnt vmcnt(0)" ::: "memory");
            const unsigned og = xb_add(&bar[XB_TOP], 1u);
            const unsigned tg = og / nx;
            if (og + 1u == (tg + 1u) * nx) xb_add(&bar[XB_TOPGEN], 1u);
            else XB_SPIN(xb_ld(&bar[XB_TOPGEN]) == tg, bar);
            __builtin_amdgcn_fence(__ATOMIC_ACQUIRE, "agent");
            xb_add(&bar[XB_XGEN(b.x)], 1u);
            asm volatile("s_waitcnt vmcnt(0)" ::: "memory");
        } else {
            XB_SPIN(xb_ld(&bar[XB_XGEN(b.x)]) == gen, bar);
            __builtin_amdgcn_fence(__ATOMIC_ACQUIRE, "agent");
            asm volatile("s_waitcnt vmcnt(0)" ::: "memory");
        }
    }
    __syncthreads();
}

constexpr int N_PHASES = 45;
__global__ void __launch_bounds__(512) mega_fwd(Params p, int ph_lo, int ph_hi) {
  extern __shared__ __attribute__((aligned(16))) unsigned char shm[];
  cg::grid_group grid = cg::this_grid();
  LAS unsigned char* lds3 = (LAS unsigned char*)shm;
  float* X = p.out;
  bf16_t* XN = (bf16_t*)(p.ws + WS_XN); bf16_t* Hb = (bf16_t*)(p.ws + WS_QKV);
  pg8::StaticOrder S;
  volatile LAS unsigned* xst = (volatile LAS unsigned*)(lds3 + 131072);
  if (threadIdx.x == 0) { xst[0] = 0u; xst[1] = 0u; }
  unsigned* xbar = (unsigned*)(p.ws + WS_BAR);
  XcdBarrier xb; xb.bar = xbar; xb.x = 0u; xb.st = xst;
#pragma unroll 1
  for (int ph = ph_lo; ph < ph_hi; ++ph) {
    if (ph == 0) { phase_setup(p, shm); }
    else {
      const int l = (ph - 1) / 11, k = (ph - 1) % 11;
      const float* modl = (const float*)(p.ws + WS_MOD) + (size_t)l * 9 * 9216;
      if (k == 0 || k == 3 || k == 8) {
        if (k == 0) phase_convert(p, l, shm);
        const int jj = k == 0 ? 0 : (k == 3 ? 1 : 2);
        phase_norm(X, p.in[6] + (size_t)(l * 3 + jj) * 1024, modl, jj, XN);
      } else if (k == 1 || k == 9) {
        pg8::Gemm g{XN, (const bf16_t*)(p.ws + (k == 9 ? WB_FFIN1 : WB_FFIN0)), T_TOK, NFF2, DM};
        S.init(T_TOK, NFF2, gridDim.x, blockIdx.x); pg8::EpiSwiGLU E{Hb}; pg8::gemm_phase(lds3, g, S, E);
      } else if (k == 2 || k == 10 || k == 7) {
        const bool wo = (k == 7);
        pg8::Gemm g{wo ? XN : Hb, (const bf16_t*)(p.ws + (wo ? WB_WO : (k == 10 ? WB_FFOUT1 : WB_FFOUT0))), T_TOK, DM, wo ? DM : DFF};
        S.init(T_TOK, DM, gridDim.x, blockIdx.x); pg8::EpiResid E{X, modl + (wo ? 5 : (k == 10 ? 8 : 2)) * 1024, wo ? 1.0f : 0.5f}; pg8::gemm_phase(lds3, g, S, E);
      } else if (k == 4) {
        pg8::Gemm g{XN, (const bf16_t*)(p.ws + WB_WIN), T_TOK, WINC, DM};
        S.init(T_TOK, WINC, gridDim.x, blockIdx.x); pg8::EpiQKV E{(bf16_t*)(p.ws + WS_QKV), (bf16_t*)(p.ws + WS_GATES)}; pg8::gemm_phase(lds3, g, S, E);
      } else if (k == 5) { phase_qknorm(p, l); }
      else { phase_attn(p, l, shm); }
    }
    if (ph + 1 < ph_hi) {
      if (ph == 0) { gsync(grid); xb = xcd_barrier_post(xbar, xst); }
      else xcd_barrier(xb);
    }
  }
}

#ifndef N_LAUNCH_MODE
#define N_LAUNCH_MODE 1
#endif
extern "C" void kernel_launch(void* const* d_in, const int* in_sizes, int n_in, void* d_out, int out_size, void* d_ws, size_t ws_size, hipStream_t stream) {
  static int grid = 0;
  if (grid == 0) {
    if (n_in != 24 || out_size != T_TOK * DM || ws_size < WS_END2) { fprintf(stderr, "kernel_launch: unexpected shapes (n_in %d out %d ws %zu need %zu)\n", n_in, out_size, ws_size, (size_t)WS_END2); grid = -1; return; }
    int dev = 0, cus = 0, per_cu = 0;
    (void)hipGetDevice(&dev); (void)hipDeviceGetAttribute(&cus, hipDeviceAttributeMultiprocessorCount, dev);
    if (hipFuncSetAttribute((const void*)mega_fwd, hipFuncAttributeMaxDynamicSharedMemorySize, LDS_BYTES) != hipSuccess) { fprintf(stderr, "kernel_launch: hipFuncSetAttribute failed\n"); grid = -1; return; }
    if (hipOccupancyMaxActiveBlocksPerMultiprocessor(&per_cu, (const void*)mega_fwd, 512, LDS_BYTES) != hipSuccess || per_cu < 1) { fprintf(stderr, "kernel_launch: occupancy query gave %d\n", per_cu); per_cu = 1; }
    (void)hipGetLastError();
    grid = cus;
  }
  if (grid < 0) return;
  Params p{};
  for (int i = 0; i < 24; ++i) p.in[i] = (const float*)d_in[i];
  p.out = (float*)d_out; p.ws = (unsigned char*)d_ws;
#if N_LAUNCH_MODE == 1
  int lo = 0, hi = N_PHASES;
  void* args[] = {&p, &lo, &hi};
  hipError_t e = hipLaunchCooperativeKernel((const void*)mega_fwd, dim3(grid), dim3(512), args, LDS_BYTES, stream);
  if (e != hipSuccess) fprintf(stderr, "kernel_launch: cooperative launch failed: %s (grid %d)\n", hipGetErrorString(e), grid);
#else
  for (int ph = 0; ph < N_PHASES; ++ph) hipLaunchKernelGGL(mega_fwd, dim3(grid), dim3(512), LDS_BYTES, stream, p, ph, ph + 1);
#endif
}
```

```cpp
#include <hip/hip_runtime.h>
#include <hip/hip_bf16.h>
#include <hip/hip_cooperative_groups.h>
#include <cstdio>
#include <cstdint>
#define N_LAUNCH_MODE 1
namespace cg = cooperative_groups;

typedef unsigned short bf16_t;
typedef short bf16x8 __attribute__((ext_vector_type(8)));
typedef short s16x4 __attribute__((ext_vector_type(4)));
typedef float f32x4 __attribute__((ext_vector_type(4)));
typedef float f32x16 __attribute__((ext_vector_type(16)));
typedef unsigned u32x4 __attribute__((ext_vector_type(4)));
typedef unsigned u32x2 __attribute__((ext_vector_type(2)));
#define LAS __attribute__((address_space(3)))

constexpr int T_TOK = 32768, DM = 1024, DFF = 2816, NFF2 = 5632, WINC = 7680, QKVW = 4608, GW = 3072;
constexpr float EPS = 1e-6f, LOG2E = 1.4426950408889634f, NEGBIG = -1e30f;
constexpr size_t WB_FFIN0 = 0, WB_FFIN1 = 11534336, WB_FFOUT0 = 23068672, WB_FFOUT1 = 28835840, WB_WIN = 34603008, WB_WO = 50331648;
constexpr size_t WS_MOD = 52428800, WS_ROPE = 53755904, WS_LUT = 53821440, WS_LAM = 53854208, WS_XN = 53854464;
constexpr size_t WS_QKV = WS_XN + 67108864, WS_GATES = WS_QKV + 301989888, WS_PARK = WS_GATES + 201326592, WS_END = WS_PARK + 67108864;
constexpr size_t WS_BAR = WS_END, WS_PCNT = WS_END + 16384, WS_END2 = WS_END + 65536;
constexpr int LDS_BYTES = 131072 + 16;

struct Params { const float* in[24]; float* out; unsigned char* ws; };

typedef __bf16 bf16v2 __attribute__((ext_vector_type(2)));
typedef float f32x2 __attribute__((ext_vector_type(2)));
__device__ __forceinline__ unsigned cvtpk(float lo, float hi) { f32x2 v = {lo, hi}; bf16v2 b = __builtin_convertvector(v, bf16v2); return __builtin_bit_cast(unsigned, b); }
__device__ __forceinline__ float bf_lo(unsigned u) { return __uint_as_float(u << 16); }
__device__ __forceinline__ float bf_hi(unsigned u) { return __uint_as_float(u & 0xffff0000u); }
__device__ __forceinline__ float bf2f(bf16_t v) { return __uint_as_float(((unsigned)v) << 16); }

namespace pg8 {
constexpr int BM = 256, BK = 64, HALF = 128, HTB = HALF * BK * 2, STAGE_BYTES = 8 * HTB, NXCD = 8, WGM = 8;
__device__ __forceinline__ int lds_byte(int r, int c) { const int st = (r >> 4) * 2 + (c >> 5), rr = r & 15, cc = c & 31, ob = rr * 64 + cc * 2; return st * 1024 + (ob ^ (((ob >> 9) & 1) << 5)); }
__device__ __forceinline__ void stage_rc(int b, int& R, int& C) { const int st = b / 1024, sb = b % 1024, swz = sb ^ (((sb >> 9) & 1) << 5); R = (st >> 1) * 16 + swz / 64; C = (st & 1) * 32 + (swz % 64) / 2; }
__device__ __forceinline__ int perm32(int rho) { const int n = rho >> 4, i = rho & 15; return 8 * (i >> 2) + 4 * n + (i & 3); }
struct Unit { int pm, pn; };
struct Gemm { const bf16_t* A; const bf16_t* Bt; int M, N, K; };
struct StaticOrder {
    int nM, nN, nwg, G, c;
    __device__ void init(int M, int N, int G_, int c_) { nM = M / BM; nN = N / BM; nwg = nM * nN; G = G_; c = c_; }
    __device__ bool next(int i, Unit& u) const {
        const long L = (long)i * G + c; if (L >= nwg) return false;
        int wgid = (int)L; { const int q = nwg / NXCD, r = nwg % NXCD, xcd = wgid % NXCD, off = wgid / NXCD; wgid = (xcd < r ? xcd * (q + 1) : r * (q + 1) + (xcd - r) * q) + off; }
        const int nig = WGM * nN, gid = wgid / nig, fm = gid * WGM, gsz = (nM - fm) < WGM ? (nM - fm) : WGM;
        u.pm = fm + ((wgid % nig) % gsz); u.pn = (wgid % nig) / gsz; return true;
    }
};

template <class Epi>
__device__ __forceinline__ void gemm_phase(LAS unsigned char* lds, const Gemm g, const StaticOrder& S, const Epi& E) {
    int tid_ = threadIdx.x; asm volatile("" : "+v"(tid_));
    const int tid = tid_, wid = __builtin_amdgcn_readfirstlane(tid >> 6), lane = tid & 63, wr = wid >> 2, wc = wid & 3, fr = lane & 15, fq = lane >> 4;
    const int K = g.K, nt = K / BK;
    unsigned voffA[2], voffB[2];
#pragma unroll
    for (int i = 0; i < 2; ++i) { int R, C; stage_rc(tid * 16 + i * 8192, R, C); const int Rb = Epi::PERM ? ((R & ~31) + perm32(R & 31)) : R;
        voffA[i] = (unsigned)(R * K + C) * 2u; voffB[i] = (unsigned)(Rb * K + C) * 2u; }
    const size_t kstep = (size_t)(BK * 2);
    const size_t hstep = (size_t)HALF * K * 2;
    const size_t tstep = 2 * hstep;
    const unsigned ldsw = (unsigned)wid * 1024u;
    const int aoff = lds_byte(wr * 64 + fr, fq * 8), boff = lds_byte(wc * 32 + fr, fq * 8);
#define PG8_SA(b, h) (((b) * 2 + (h)) * HTB)
#define PG8_SB(b, h) ((4 + (b) * 2 + (h)) * HTB)
#define PG8_STAGE(bufoff, gbase, voff) do { _Pragma("unroll") for (int _i = 0; _i < 2; ++_i) \
        __builtin_amdgcn_global_load_lds((const unsigned*)((const char*)(gbase) + (voff)[_i]), (LAS unsigned*)(lds + (bufoff) + ldsw + _i * 8192), 16, 0, 0); } while (0)
#define PG8_LDA(dst, b, h) do { _Pragma("unroll") for (int m = 0; m < 4; ++m) _Pragma("unroll") for (int k = 0; k < 2; ++k) dst[m][k] = *(const LAS bf16x8*)(lds + PG8_SA(b, h) + aoff + m * 2048 + k * 1024); } while (0)
#define PG8_LDB(dst, b, h) do { _Pragma("unroll") for (int n = 0; n < 2; ++n) _Pragma("unroll") for (int k = 0; k < 2; ++k) dst[n][k] = *(const LAS bf16x8*)(lds + PG8_SB(b, h) + boff + n * 2048 + k * 1024); } while (0)
#define PG8_MMA(ai, bj, At, Bt) do { __builtin_amdgcn_s_setprio(1); _Pragma("unroll") for (int m = 0; m < 4; ++m) _Pragma("unroll") for (int n = 0; n < 2; ++n) _Pragma("unroll") for (int k = 0; k < 2; ++k) \
        acc[ai][bj][m][n] = __builtin_amdgcn_mfma_f32_16x16x32_bf16(Bt[n][k], At[m][k], acc[ai][bj][m][n], 0, 0, 0); __builtin_amdgcn_s_setprio(0); } while (0)
#define PG8_WAIT_V(n) asm volatile("s_waitcnt vmcnt(" #n ")" ::: "memory")
#define PG8_WAIT_L(n) asm volatile("s_waitcnt lgkmcnt(" #n ")" ::: "memory")
#define PG8_BAR __builtin_amdgcn_s_barrier()
#define PG8_SCHED __builtin_amdgcn_sched_barrier(0)
    Unit cur, nxt; int ui = 0;
    if (!S.next(0, cur)) return;
    f32x4 acc[2][2][4][2];
#pragma unroll
    for (int a = 0; a < 2; ++a)
#pragma unroll
        for (int b = 0; b < 2; ++b)
#pragma unroll
            for (int m = 0; m < 4; ++m)
#pragma unroll
                for (int n = 0; n < 2; ++n) acc[a][b][m][n] = (f32x4){0.f, 0.f, 0.f, 0.f};
    bf16x8 At[4][2], B0[2][2], B1[2][2];
    const char* cA = (const char*)g.A + (size_t)cur.pm * tstep; const char* cB = (const char*)g.Bt + (size_t)cur.pn * tstep;
    PG8_STAGE(PG8_SB(0, 0), cB, voffB); PG8_STAGE(PG8_SA(0, 0), cA, voffA); PG8_STAGE(PG8_SB(0, 1), cB + hstep, voffB); PG8_STAGE(PG8_SA(0, 1), cA + hstep, voffA);
    if (wr == 1) PG8_BAR;
    PG8_WAIT_V(4); PG8_BAR;
    PG8_STAGE(PG8_SB(1, 0), cB + kstep, voffB); PG8_STAGE(PG8_SA(1, 0), cA + kstep, voffA); PG8_STAGE(PG8_SB(1, 1), cB + hstep + kstep, voffB);
    PG8_WAIT_V(6); PG8_BAR;
    for (;;) {
        const bool has_next = S.next(ui + 1, nxt);
        const char* nA = has_next ? (const char*)g.A + (size_t)nxt.pm * tstep : cA; const char* nB = has_next ? (const char*)g.Bt + (size_t)nxt.pn * tstep : cB;
        for (int t = 0; t < nt; t += 2) {
            const bool last = (t == nt - 2);
            const char* a1 = cA + (size_t)(t + 1) * kstep;
            const char* a2 = last ? nA : cA + (size_t)(t + 2) * kstep; const char* b2 = last ? nB : cB + (size_t)(t + 2) * kstep;
            const char* a3 = a2 + kstep; const char* b3 = b2 + kstep;
            PG8_LDB(B0, 0, 0); PG8_SCHED; PG8_LDA(At, 0, 0); PG8_STAGE(PG8_SA(1, 1), a1 + hstep, voffA);
            PG8_WAIT_L(8); PG8_BAR; PG8_WAIT_L(0); PG8_MMA(0, 0, At, B0); PG8_BAR; PG8_SCHED;
            PG8_LDB(B1, 0, 1); PG8_STAGE(PG8_SB(0, 0), b2, voffB);
            PG8_BAR; PG8_WAIT_L(0); PG8_MMA(0, 1, At, B1); PG8_BAR;
            PG8_LDA(At, 0, 1); PG8_STAGE(PG8_SA(0, 0), a2, voffA);
            PG8_BAR; PG8_WAIT_L(0); PG8_MMA(1, 0, At, B0); PG8_BAR; PG8_SCHED;
            PG8_STAGE(PG8_SB(0, 1), b2 + hstep, voffB);
            PG8_WAIT_V(6); PG8_BAR; PG8_MMA(1, 1, At, B1); PG8_BAR;
            PG8_LDB(B0, 1, 0); PG8_SCHED; PG8_LDA(At, 1, 0); PG8_STAGE(PG8_SA(0, 1), a2 + hstep, voffA);
            PG8_WAIT_L(8); PG8_BAR; PG8_WAIT_L(0); PG8_MMA(0, 0, At, B0); PG8_BAR; PG8_SCHED;
            PG8_LDB(B1, 1, 1); PG8_STAGE(PG8_SB(1, 0), b3, voffB);
            PG8_BAR; PG8_WAIT_L(0); PG8_MMA(0, 1, At, B1); PG8_BAR;
            PG8_LDA(At, 1, 1); PG8_STAGE(PG8_SA(1, 0), a3, voffA);
            PG8_BAR; PG8_WAIT_L(0); PG8_MMA(1, 0, At, B0); PG8_BAR; PG8_SCHED;
            PG8_STAGE(PG8_SB(1, 1), b3 + hstep, voffB);
            PG8_WAIT_V(6); PG8_BAR; PG8_MMA(1, 1, At, B1); PG8_BAR;
        }
        E(acc, cur, wr, wc, fr, fq);
        if (!has_next) break;
#pragma unroll
        for (int a = 0; a < 2; ++a)
#pragma unroll
            for (int b = 0; b < 2; ++b)
#pragma unroll
                for (int m = 0; m < 4; ++m)
#pragma unroll
                    for (int n = 0; n < 2; ++n) acc[a][b][m][n] = (f32x4){0.f, 0.f, 0.f, 0.f};
        cur = nxt; cA = nA; cB = nB; ++ui;
    }
    PG8_WAIT_V(0);
    if (wr == 0) PG8_BAR;
    PG8_BAR;
#undef PG8_SA
#undef PG8_SB
#undef PG8_STAGE
#undef PG8_LDA
#undef PG8_LDB
#undef PG8_MMA
#undef PG8_WAIT_V
#undef PG8_WAIT_L
#undef PG8_BAR
#undef PG8_SCHED
}

__device__ __forceinline__ float silu_f(float g) { return g * __builtin_amdgcn_rcpf(1.f + __expf(-g)); }
__device__ __forceinline__ float sigm_f(float g) { return __builtin_amdgcn_rcpf(1.f + __expf(-g)); }
struct EpiSwiGLU {
    static constexpr bool PERM = true;
    bf16_t* H;
    __device__ __forceinline__ void operator()(const f32x4 (&acc)[2][2][4][2], const Unit& u, int wr, int wc, int fr, int fq) const {
        const int row0 = u.pm * BM + wr * 64 + fr, col0 = u.pn * 128 + wc * 32 + 8 * fq;
#pragma unroll
        for (int ai = 0; ai < 2; ++ai)
#pragma unroll
            for (int m = 0; m < 4; ++m) { bf16_t* rowp = H + (size_t)(row0 + ai * HALF + m * 16) * DFF + col0;
                const f32x4 g0 = acc[ai][0][m][0], g1 = acc[ai][0][m][1], u0 = acc[ai][1][m][0], u1 = acc[ai][1][m][1];
                u32x4 w; w.x = cvtpk(silu_f(g0[0]) * u0[0], silu_f(g0[1]) * u0[1]); w.y = cvtpk(silu_f(g0[2]) * u0[2], silu_f(g0[3]) * u0[3]);
                w.z = cvtpk(silu_f(g1[0]) * u1[0], silu_f(g1[1]) * u1[1]); w.w = cvtpk(silu_f(g1[2]) * u1[2], silu_f(g1[3]) * u1[3]);
                *(u32x4*)rowp = w; }
    }
};
struct EpiResid {
    static constexpr bool PERM = false;
    float* X; const float* modg; float gs;
    __device__ __forceinline__ void operator()(const f32x4 (&acc)[2][2][4][2], const Unit& u, int wr, int wc, int fr, int fq) const {
        const int row0 = u.pm * BM + wr * 64 + fr, col0 = u.pn * BM + wc * 32 + 4 * fq;
        const int bi = u.pm < 64 ? (u.pm >> 3) : 8;
        const float* mg = modg + (size_t)bi * 9216 + col0;
        f32x4 gv[2][2];
#pragma unroll
        for (int bj = 0; bj < 2; ++bj)
#pragma unroll
            for (int n = 0; n < 2; ++n) gv[bj][n] = *(const f32x4*)(mg + bj * HALF + n * 16) * gs;
#pragma unroll
        for (int ai = 0; ai < 2; ++ai)
#pragma unroll
            for (int m = 0; m < 4; ++m) { float* rowp = X + (size_t)(row0 + ai * HALF + m * 16) * DM + col0;
#pragma unroll
                for (int bj = 0; bj < 2; ++bj)
#pragma unroll
                    for (int n = 0; n < 2; ++n) { f32x4* q = (f32x4*)(rowp + bj * HALF + n * 16); *q = *q + gv[bj][n] * acc[ai][bj][m][n]; } }
    }
};
struct EpiQKV {
    static constexpr bool PERM = true;
    bf16_t* QKV; bf16_t* GATES;
    __device__ __forceinline__ void operator()(const f32x4 (&acc)[2][2][4][2], const Unit& u, int wr, int wc, int fr, int fq) const {
        const int row0 = u.pm * BM + wr * 64 + fr;
        if (u.pn < 18) {
            const int col0 = u.pn * BM + wc * 32 + 8 * fq;
#pragma unroll
            for (int ai = 0; ai < 2; ++ai)
#pragma unroll
                for (int m = 0; m < 4; ++m) { bf16_t* rowp = QKV + (size_t)(row0 + ai * HALF + m * 16) * QKVW + col0;
#pragma unroll
                    for (int bj = 0; bj < 2; ++bj) { const f32x4 v0 = acc[ai][bj][m][0], v1 = acc[ai][bj][m][1];
                        u32x4 w; w.x = cvtpk(v0[0], v0[1]); w.y = cvtpk(v0[2], v0[3]); w.z = cvtpk(v1[0], v1[1]); w.w = cvtpk(v1[2], v1[3]);
                        *(u32x4*)(rowp + bj * HALF) = w; } }
        } else {
            const int col0 = (u.pn - 18) * BM + wc * 32 + 8 * fq;
#pragma unroll
            for (int ai = 0; ai < 2; ++ai)
#pragma unroll
                for (int m = 0; m < 4; ++m) { bf16_t* rowp = GATES + (size_t)(row0 + ai * HALF + m * 16) * GW + col0;
#pragma unroll
                    for (int bj = 0; bj < 2; ++bj) { const f32x4 v0 = acc[ai][bj][m][0], v1 = acc[ai][bj][m][1];
                        u32x4 w; w.x = cvtpk(sigm_f(v0[0]), sigm_f(v0[1])); w.y = cvtpk(sigm_f(v0[2]), sigm_f(v0[3])); w.z = cvtpk(sigm_f(v1[0]), sigm_f(v1[1])); w.w = cvtpk(sigm_f(v1[2]), sigm_f(v1[3]));
                        *(u32x4*)(rowp + bj * HALF) = w; } }
        }
    }
};
}

constexpr int LDQK = QKVW;
constexpr int SHM_V = 64 * 128 * 2, SHM_K = 64 * 128 * 2;
constexpr int ATT_NBUF = 3;
constexpr int ATT_WS_OFF = ATT_NBUF * SHM_V + ATT_NBUF * SHM_K, ATT_LUT_OFF = ATT_WS_OFF + 8 * 64 * 4;
#define KSWZ(row, colB) ((row) * 256 + ((colB) ^ (((row) & 7) << 4)))
#define SBAR() __builtin_amdgcn_sched_barrier(0)
__device__ __forceinline__ int crow(int r, int hi) { return (r & 3) + 8 * (r >> 2) + 4 * hi; }

template <int MODE>
__device__ __forceinline__ void partialSM(f32x16& p0, f32x16& p1, float& m_reg, float& mn, float& alpha, int relh, int relw_min, int relw_max, const float* lut) {
  if constexpr (MODE == 0) {
    constexpr float SCALE = 0.088388347648318440f, C = SCALE * LOG2E, THR = 8.f;
    float pmax = p0[0];
#pragma unroll
    for (int r = 1; r < 16; ++r) pmax = fmaxf(pmax, p0[r]);
#pragma unroll
    for (int r = 0; r < 16; ++r) pmax = fmaxf(pmax, p1[r]);
    { auto rr = __builtin_amdgcn_permlane32_swap(__float_as_uint(pmax), __float_as_uint(pmax), false, false);
      pmax = fmaxf(__uint_as_float(rr[0]), __uint_as_float(rr[1])); }
    if (__builtin_expect(__all(pmax - m_reg <= THR / SCALE), 1)) { mn = m_reg; alpha = 1.f; }
    else { mn = fmaxf(m_reg, pmax); alpha = __builtin_amdgcn_exp2f((m_reg - mn) * C); m_reg = mn; }
    const float mnC = -mn * C;
#pragma unroll
    for (int r = 0; r < 16; ++r) p0[r] = fmaf(p0[r], C, mnC);
#pragma unroll
    for (int r = 0; r < 16; ++r) p1[r] = fmaf(p1[r], C, mnC);
#pragma unroll
    for (int r = 0; r < 16; ++r) p0[r] = __builtin_amdgcn_exp2f(p0[r]);
  } else {
    constexpr float C = (MODE == 1 ? 0.088388347648318440f : 0.125f) * LOG2E, THR2 = 8.f * LOG2E;
    bool nearT = true; float cfar = 0.f;
    if constexpr (MODE >= 2) {
      if (relw_max <= -128) { nearT = false; cfar = lut[0]; }
      else if (relw_min >= 128) { nearT = false; cfar = lut[258]; }
      if (!nearT) {
        float pmax = p0[0];
#pragma unroll
        for (int r = 1; r < 16; ++r) pmax = fmaxf(pmax, p0[r]);
#pragma unroll
        for (int r = 0; r < 16; ++r) pmax = fmaxf(pmax, p1[r]);
        { auto rr = __builtin_amdgcn_permlane32_swap(__float_as_uint(pmax), __float_as_uint(pmax), false, false);
          pmax = fmaxf(__uint_as_float(rr[0]), __uint_as_float(rr[1])); }
        const float tmax = fmaf(pmax, C, cfar);
        if (__builtin_expect(__all(tmax - m_reg <= THR2), 1)) { mn = m_reg; alpha = 1.f; }
        else { mn = fmaxf(m_reg, tmax); alpha = __builtin_amdgcn_exp2f(m_reg - mn); m_reg = mn; }
        const float off = cfar - mn;
#pragma unroll
        for (int r = 0; r < 16; ++r) p0[r] = fmaf(p0[r], C, off);
#pragma unroll
        for (int r = 0; r < 16; ++r) p1[r] = fmaf(p1[r], C, off);
#pragma unroll
        for (int r = 0; r < 16; ++r) p0[r] = __builtin_amdgcn_exp2f(p0[r]);
        return;
      }
    }
    if (nearT) {
#pragma unroll
      for (int r = 0; r < 16; ++r) { const int i0 = relh + (r & 3) + 8 * (r >> 2);
        const int a0 = min(max(i0, -129), 129) + 129, a1 = min(max(i0 + 32, -129), 129) + 129;
        p0[r] = fmaf(p0[r], C, lut[a0]); p1[r] = fmaf(p1[r], C, lut[a1]); }
    } else {
#pragma unroll
      for (int r = 0; r < 16; ++r) { p0[r] = fmaf(p0[r], C, cfar); p1[r] = fmaf(p1[r], C, cfar); }
    }
    float pmax = p0[0];
#pragma unroll
    for (int r = 1; r < 16; ++r) pmax = fmaxf(pmax, p0[r]);
#pragma unroll
    for (int r = 0; r < 16; ++r) pmax = fmaxf(pmax, p1[r]);
    { auto rr = __builtin_amdgcn_permlane32_swap(__float_as_uint(pmax), __float_as_uint(pmax), false, false);
      pmax = fmaxf(__uint_as_float(rr[0]), __uint_as_float(rr[1])); }
    if (__builtin_expect(__all(pmax - m_reg <= THR2), 1)) { mn = m_reg; alpha = 1.f; }
    else { mn = fmaxf(m_reg, pmax); alpha = __builtin_amdgcn_exp2f(m_reg - mn); m_reg = mn; }
#pragma unroll
    for (int r = 0; r < 16; ++r) p0[r] = __builtin_amdgcn_exp2f(p0[r] - mn);
#pragma unroll
    for (int r = 0; r < 16; ++r) p1[r] = p1[r] - mn;
  }
}
__device__ __forceinline__ void finishSM(f32x16& p0, f32x16& p1, float alpha, float& l_reg, bf16x8& pa0, bf16x8& pa1, bf16x8& pa2, bf16x8& pa3) {
#pragma unroll
  for (int r = 0; r < 16; ++r) p1[r] = __builtin_amdgcn_exp2f(p1[r]);
  float ps = 0;
#pragma unroll
  for (int r = 0; r < 16; ++r) ps += p0[r];
#pragma unroll
  for (int r = 0; r < 16; ++r) ps += p1[r];
  { auto rr = __builtin_amdgcn_permlane32_swap(__float_as_uint(ps), __float_as_uint(ps), false, false);
    ps = __uint_as_float(rr[0]) + __uint_as_float(rr[1]); }
  l_reg = l_reg * alpha + ps;
#define PK4(P, BASE, OUT) do { unsigned a0 = cvtpk(P[BASE + 0], P[BASE + 1]), a1 = cvtpk(P[BASE + 2], P[BASE + 3]);   \
    unsigned b0 = cvtpk(P[BASE + 4], P[BASE + 5]), b1 = cvtpk(P[BASE + 6], P[BASE + 7]);                              \
    auto r0 = __builtin_amdgcn_permlane32_swap(a0, b0, false, false); auto r1 = __builtin_amdgcn_permlane32_swap(a1, b1, false, false); \
    u32x4 w = {r0[0], r1[0], r0[1], r1[1]}; OUT = *reinterpret_cast<bf16x8*>(&w); } while (0)
  PK4(p0, 0, pa0); PK4(p0, 8, pa1); PK4(p1, 0, pa2); PK4(p1, 8, pa3);
#undef PK4
}
template <int ND0, int DOFF>
__device__ __forceinline__ void qkt(f32x16& p0, f32x16& p1, const char* Ks, const bf16x8* qr, int r32, int hi) {
  p0 = f32x16{}; p1 = f32x16{};
#pragma unroll
  for (int d0 = 0; d0 < ND0; ++d0) { const int cb = ((d0 + DOFF) * 16 + hi * 8) * 2;
    bf16x8 b0 = *reinterpret_cast<const bf16x8*>(Ks + KSWZ(r32, cb));
    bf16x8 b1 = *reinterpret_cast<const bf16x8*>(Ks + KSWZ(32 + r32, cb));
    p0 = __builtin_amdgcn_mfma_f32_32x32x16_bf16(b0, qr[d0], p0, 0, 0, 0);
    p1 = __builtin_amdgcn_mfma_f32_32x32x16_bf16(b1, qr[d0], p1, 0, 0, 0); }
}
__device__ __forceinline__ int v_st(int k, int c) { const int kk = (k & ~0xC) | ((k & 4) << 1) | ((k & 8) >> 1); return ((kk >> 3) * 4 + (c >> 5)) * 512 + ((kk & 7) * 32 + (c & 31)) * 2; }
__device__ __forceinline__ int v_rd_base(int lane) { return ((lane & 3) << 3) | (((lane >> 2) & 3) << 6) | (((lane >> 4) & 1) << 5) | (((lane >> 5) & 1) << 8); }
constexpr int v_rd_off(int d0, int ks, int half) { return d0 * 512 + ks * 4096 + half * 2048; }
template <int OFF> __device__ __forceinline__ s16x4 tr_read(int vb) {
  s16x4 r; asm volatile("ds_read_b64_tr_b16 %0, %1 offset:%2" : "=&v"(r) : "v"(vb), "i"(OFF) : "memory"); return r;
}
template <int D0> __device__ __forceinline__ void pv_one(f32x16& od, int vb, bf16x8 pa0, bf16x8 pa1, bf16x8 pa2, bf16x8 pa3) {
  const s16x4 l0 = tr_read<v_rd_off(D0, 0, 0)>(vb), h0 = tr_read<v_rd_off(D0, 0, 1)>(vb), l1 = tr_read<v_rd_off(D0, 1, 0)>(vb), h1 = tr_read<v_rd_off(D0, 1, 1)>(vb);
  const s16x4 l2 = tr_read<v_rd_off(D0, 2, 0)>(vb), h2 = tr_read<v_rd_off(D0, 2, 1)>(vb), l3 = tr_read<v_rd_off(D0, 3, 0)>(vb), h3 = tr_read<v_rd_off(D0, 3, 1)>(vb);
  asm volatile("s_waitcnt lgkmcnt(0)" ::: "memory"); SBAR();
#define PK(L, H) (bf16x8){L[0], L[1], L[2], L[3], H[0], H[1], H[2], H[3]}
  od = __builtin_amdgcn_mfma_f32_32x32x16_bf16(pa0, PK(l0, h0), od, 0, 0, 0);
  od = __builtin_amdgcn_mfma_f32_32x32x16_bf16(pa1, PK(l1, h1), od, 0, 0, 0);
  od = __builtin_amdgcn_mfma_f32_32x32x16_bf16(pa2, PK(l2, h2), od, 0, 0, 0);
  od = __builtin_amdgcn_mfma_f32_32x32x16_bf16(pa3, PK(l3, h3), od, 0, 0, 0);
#undef PK
}
__device__ __forceinline__ void pv_d0(f32x16* o, int vb, bf16x8 pa0, bf16x8 pa1, bf16x8 pa2, bf16x8 pa3) {
  pv_one<0>(o[0], vb, pa0, pa1, pa2, pa3); pv_one<1>(o[1], vb, pa0, pa1, pa2, pa3); pv_one<2>(o[2], vb, pa0, pa1, pa2, pa3); pv_one<3>(o[3], vb, pa0, pa1, pa2, pa3);
}

struct AttnEpi {
  const bf16_t* gate;
  float* park;
  bf16_t* merged;
  const float* gsub;
  float lam, oml;
  float sinkl2;
  const float* gq;
};

template <int MODE>
__device__ __forceinline__ void attn_body(const bf16_t* __restrict__ Qb, const bf16_t* __restrict__ Kh, const bf16_t* __restrict__ Vh, int NT, int krel0,
                                          char* lds, const float* __restrict__ lutg, const AttnEpi& E) {
  constexpr int ND0 = (MODE < 2) ? 8 : 4, DOFF = (MODE == 3) ? 4 : 0;
  int tid_ = threadIdx.x; asm volatile("" : "+v"(tid_));
  const int tid = tid_, wid = tid >> 6, lane = tid & 63, r32 = lane & 31, hi = lane >> 5;
  char* V_lds = lds; char* K_lds = lds + ATT_NBUF * SHM_V;
  float* wsm = (float*)(lds + ATT_WS_OFF) + wid * 64; float* li_l = wsm; float* al_l = wsm + 32;
  float* lut = (float*)(lds + ATT_LUT_OFF);
  __syncthreads();
  if constexpr (MODE != 0) { if (tid < 259) lut[tid] = lutg[tid]; }
  float m_reg = -1e30f, l_reg = 0; f32x16 o[4] = {}; bf16x8 qr[ND0];
  const bf16_t* Qw = Qb + (size_t)(wid * 32 + r32) * LDQK + hi * 8;
  {
    float qf[ND0][8]; float ss = 0.f;
#pragma unroll
    for (int d0 = 0; d0 < ND0; ++d0) { const bf16x8 raw = *reinterpret_cast<const bf16x8*>(Qw + d0 * 16);
#pragma unroll
      for (int j = 0; j < 8; ++j) { const float v = __uint_as_float(((unsigned)(unsigned short)raw[j]) << 16); qf[d0][j] = v; ss += v * v; } }
    { auto rr = __builtin_amdgcn_permlane32_swap(__float_as_uint(ss), __float_as_uint(ss), false, false);
      ss = __uint_as_float(rr[0]) + __uint_as_float(rr[1]); }
    const float rs = rsqrtf(ss * (MODE < 2 ? (1.f / 128.f) : (1.f / 64.f)) + EPS);
#pragma unroll
    for (int d0 = 0; d0 < ND0; ++d0) { const f32x4 g0 = *(const f32x4*)(E.gq + d0 * 16 + hi * 8), g1 = *(const f32x4*)(E.gq + d0 * 16 + hi * 8 + 4);
#pragma unroll
      for (int j = 0; j < 4; ++j) { qf[d0][j] = qf[d0][j] * rs * g0[j]; qf[d0][4 + j] = qf[d0][4 + j] * rs * g1[j]; } }
    if constexpr (MODE == 0) {
      const int sp = krel0 + wid * 32 + r32;
#pragma unroll
      for (int h = 0; h < 2; ++h) { const int pos = h == 0 ? (sp >> 6) : (sp & 63);
#pragma unroll
        for (int a = 0; a < 2; ++a) { const float* tb = lutg + (size_t)(pos * 32 + a * 16 + hi * 8) * 2;
#pragma unroll
          for (int jj = 0; jj < 4; ++jj) { const f32x4 cs = *(const f32x4*)(tb + jj * 4);
#pragma unroll
            for (int e = 0; e < 2; ++e) { const int j = 2 * jj + e; const float c = cs[2 * e], sn = cs[2 * e + 1];
              const float x1 = qf[4 * h + a][j], x2 = qf[4 * h + 2 + a][j];
              qf[4 * h + a][j] = x1 * c - x2 * sn; qf[4 * h + 2 + a][j] = x2 * c + x1 * sn; } } } }
    }
#pragma unroll
    for (int d0 = 0; d0 < ND0; ++d0) { u32x4 w; w.x = cvtpk(qf[d0][0], qf[d0][1]); w.y = cvtpk(qf[d0][2], qf[d0][3]); w.z = cvtpk(qf[d0][4], qf[d0][5]); w.w = cvtpk(qf[d0][6], qf[d0][7]);
      qr[d0] = *reinterpret_cast<bf16x8*>(&w); }
  }
  const int sr = tid >> 4, sc = (tid & 15) * 8, vst0 = v_st(sr, sc), vst1 = v_st(32 + sr, sc);
  const int vb0 = (int)(uintptr_t)V_lds + v_rd_base(lane);
  struct { bf16x8 vs0, vs1, ks0, ks1; } sr_[2];
#define SLOAD(i, k0) do { sr_[i].vs0 = *reinterpret_cast<const bf16x8*>(&Vh[(size_t)((k0) + sr) * LDQK + sc]); sr_[i].vs1 = *reinterpret_cast<const bf16x8*>(&Vh[(size_t)((k0) + 32 + sr) * LDQK + sc]); \
    sr_[i].ks0 = *reinterpret_cast<const bf16x8*>(&Kh[(size_t)((k0) + sr) * LDQK + sc]); sr_[i].ks1 = *reinterpret_cast<const bf16x8*>(&Kh[(size_t)((k0) + 32 + sr) * LDQK + sc]); } while (0)
#define SWRITE(off, i) do { *(bf16x8*)(V_lds + (off) + vst0) = sr_[i].vs0;          \
    *(bf16x8*)(V_lds + (off) + vst1) = sr_[i].vs1; int kc = sc * 2;               \
    *(bf16x8*)(K_lds + (off) + KSWZ(sr, kc)) = sr_[i].ks0;                       \
    *(bf16x8*)(K_lds + (off) + KSWZ(32 + sr, kc)) = sr_[i].ks1; } while (0)
#define SWAIT() asm volatile("s_waitcnt vmcnt(4)" ::: "memory")
#define RESC(a) do { if (__any((a) < 1.f)) { if (hi == 0) al_l[r32] = (a); asm volatile("s_waitcnt lgkmcnt(0)" ::: "memory"); \
    _Pragma("unroll") for (int d = 0; d < 4; ++d) _Pragma("unroll") for (int r = 0; r < 16; ++r) o[d][r] *= al_l[crow(r, hi)]; } } while (0)
  const int relq = krel0 - (wid * 32 + r32) + 4 * hi, relwmin = krel0 - (wid * 32 + 31), relwmax = krel0 + 63 - wid * 32;
#define PSM(P0, P1, MN, AL, J) partialSM<MODE>(P0, P1, m_reg, MN, AL, relq + 64 * (J), relwmin + 64 * (J), relwmax + 64 * (J), lut)
  f32x16 pA0, pA1, pB0, pB1; float mnA, mnB, alA, alB; bf16x8 pa0, pa1, pa2, pa3;
  constexpr int SE = 0, SO = 1;
  SLOAD(SE, 0); SLOAD(SO, 64); asm volatile("s_waitcnt vmcnt(4)" ::: "memory"); SWRITE(0, SE); __syncthreads();
  qkt<ND0, DOFF>(pA0, pA1, K_lds, qr, r32, hi); PSM(pA0, pA1, mnA, alA, 0);
  if (2 < NT) SLOAD(SE, 2 * 64);
  SWAIT(); SWRITE(SHM_V, SO);
  int op = 0, oq = SHM_V, ow = 2 * SHM_V;
  for (int j = 1; j + 1 < NT; j += 2) {
    __syncthreads();
    SBAR(); qkt<ND0, DOFF>(pB0, pB1, K_lds + oq, qr, r32, hi);
    finishSM(pA0, pA1, alA, l_reg, pa0, pa1, pa2, pa3); SBAR();
    SLOAD(SO, (j + 2) * 64); SBAR();
    pv_d0(o, vb0 + op, pa0, pa1, pa2, pa3); PSM(pB0, pB1, mnB, alB, j);
    SWAIT(); SWRITE(ow, SE);
    RESC(alB);
    { const int t = op; op = oq; oq = ow; ow = t; }
    __syncthreads();
    SBAR(); qkt<ND0, DOFF>(pA0, pA1, K_lds + oq, qr, r32, hi);
    finishSM(pB0, pB1, alB, l_reg, pa0, pa1, pa2, pa3); SBAR();
    if (j + 3 < NT) SLOAD(SE, (j + 3) * 64); SBAR();
    pv_d0(o, vb0 + op, pa0, pa1, pa2, pa3); PSM(pA0, pA1, mnA, alA, j + 1);
    SWAIT(); SWRITE(ow, SO);
    RESC(alA);
    { const int t = op; op = oq; oq = ow; ow = t; }
  }
  __syncthreads();
  SBAR(); qkt<ND0, DOFF>(pB0, pB1, K_lds + oq, qr, r32, hi);
  finishSM(pA0, pA1, alA, l_reg, pa0, pa1, pa2, pa3); SBAR();
  pv_d0(o, vb0 + op, pa0, pa1, pa2, pa3); PSM(pB0, pB1, mnB, alB, NT - 1);
  RESC(alB);
  finishSM(pB0, pB1, alB, l_reg, pa0, pa1, pa2, pa3); SBAR();
  pv_d0(o, vb0 + oq, pa0, pa1, pa2, pa3);
  if constexpr (MODE == 1) l_reg += __builtin_amdgcn_exp2f(E.sinkl2 - m_reg);
  if (hi == 0) li_l[r32] = l_reg; asm volatile("s_waitcnt lgkmcnt(0)" ::: "memory");
  float rli[16];
#pragma unroll
  for (int r = 0; r < 16; ++r) rli[r] = __builtin_amdgcn_rcpf(li_l[crow(r, hi)]);
  float* pk0 = E.park; float* pk1 = E.park + 64 * 512;
  const int rowb = wid * 32;
  if constexpr (MODE == 0 || MODE == 1) {
#pragma unroll
    for (int r = 0; r < 16; ++r) { const int row = rowb + crow(r, hi);
#pragma unroll
      for (int d0 = 0; d0 < 4; ++d0) { const int idx = (d0 * 16 + r) * 512 + tid;
        const float g = bf2f(E.gate[(size_t)row * GW + d0 * 32 + r32]);
        const float v = o[d0][r] * rli[r] * g;
        if constexpr (MODE == 0) pk0[idx] = v; else pk0[idx] += v; } }
  } else if constexpr (MODE == 2) {
#pragma unroll
    for (int r = 0; r < 16; ++r)
#pragma unroll
      for (int d0 = 0; d0 < 4; ++d0) pk1[(d0 * 16 + r) * 512 + tid] = o[d0][r] * rli[r];
  } else {
    float gs[4];
#pragma unroll
    for (int d0 = 0; d0 < 4; ++d0) gs[d0] = E.gsub[d0 * 32 + r32] * E.oml;
#pragma unroll
    for (int r = 0; r < 16; ++r) { const int row = rowb + crow(r, hi);
      float ss = 0.f;
#pragma unroll
      for (int d0 = 0; d0 < 4; ++d0) { const float c = pk1[(d0 * 16 + r) * 512 + tid] - E.lam * (o[d0][r] * rli[r]); o[d0][r] = c; ss += c * c; }
      ss += __shfl_xor(ss, 1); ss += __shfl_xor(ss, 2); ss += __shfl_xor(ss, 4); ss += __shfl_xor(ss, 8); ss += __shfl_xor(ss, 16);
      const float rs = rsqrtf(ss * (1.f / 128.f) + EPS);
#pragma unroll
      for (int d0 = 0; d0 < 4; ++d0) { const int col = d0 * 32 + r32;
        const float g = bf2f(E.gate[(size_t)row * GW + col]);
        const float y = o[d0][r] * rs * gs[d0] * g + pk0[(d0 * 16 + r) * 512 + tid];
        E.merged[(size_t)row * DM + col] = (bf16_t)(cvtpk(y, y) & 0xffffu); } }
  }
#undef SLOAD
#undef SWRITE
#undef SWAIT
#undef RESC
#undef PSM
}

__device__ __forceinline__ int t5bucket(int rel) {
  const int n = rel < 0 ? -rel : rel;
  const int b = n < 8 ? n : 8 + (n >= 12) + (n >= 16) + (n >= 23) + (n >= 32) + (n >= 46) + (n >= 64) + (n >= 91);
  return b + (rel > 0 ? 16 : 0);
}
__device__ __forceinline__ float wave_sum(float v) {
  v += __shfl_xor(v, 1); v += __shfl_xor(v, 2); v += __shfl_xor(v, 4); v += __shfl_xor(v, 8); v += __shfl_xor(v, 16); v += __shfl_xor(v, 32); return v;
}

__device__ __forceinline__ void phase_setup(const Params& p, unsigned char* shm) {
  int tid_ = threadIdx.x; asm volatile("" : "+v"(tid_)); const int tid = tid_, nb = gridDim.x, bid = blockIdx.x, wid = tid >> 6, lane = tid & 63;
  if (bid == 0) { unsigned* xbar = (unsigned*)(p.ws + WS_BAR); for (int i = tid; i < 16384; i += 512) xbar[i] = 0u; }
  {
    const float4* s0 = (const float4*)p.in[0]; const float4* s1 = (const float4*)p.in[1]; float4* o = (float4*)p.out;
    const size_t n4 = (size_t)16384 * 1024 / 4;
    for (size_t i = (size_t)bid * 512 + tid; i < 2 * n4; i += (size_t)nb * 512) o[i] = i < n4 ? s0[i] : s1[i - n4];
  }
  {
    float* rope = (float*)(p.ws + WS_ROPE);
    for (int i = bid * 512 + tid; i < 256 * 32; i += nb * 512) { const int pos = i >> 5, f = i & 31;
      const float inv = powf(10000.f, -(float)f / 32.f); const float ang = (float)pos * inv; rope[2 * i] = cosf(ang); rope[2 * i + 1] = sinf(ang); }
    float* lut = (float*)(p.ws + WS_LUT);
    for (int i = bid * 512 + tid; i < 16 * 259; i += nb * 512) { const int hh = i / 259, e = i % 259; int rel = e - 129; float v;
      if (hh < 8) { v = (rel < -128 || rel > 128) ? NEGBIG : p.in[23][t5bucket(rel) * 16 + hh] * LOG2E; }
      else { rel = rel < -128 ? -128 : (rel > 128 ? 128 : rel); v = p.in[23][t5bucket(rel) * 16 + hh] * LOG2E; }
      lut[i] = v; }
    if (bid == 0 && tid < 4) { const int l = tid; float s1 = 0.f, s2 = 0.f;
      for (int i = 0; i < 64; ++i) { s1 += p.in[18][l * 64 + i] * p.in[19][l * 64 + i]; s2 += p.in[20][l * 64 + i] * p.in[21][l * 64 + i]; }
      const float lam_init = 0.8f - 0.6f * expf(-0.3f * (float)l);
      float* lam = (float*)(p.ws + WS_LAM); lam[2 * l] = expf(s1) - expf(s2) + lam_init; lam[2 * l + 1] = 1.f - lam_init; }
  }
  {
    float* sc = (float*)shm; float* red = sc + 9 * 1024;
    for (int i = tid; i < 9 * 1024; i += 512) { const float c = i < 8192 ? p.in[2][i] : p.in[3][i - 8192]; sc[i] = c / (1.f + expf(-c)); }
    __syncthreads();
    float* mod = (float*)(p.ws + WS_MOD);
    for (int task = bid; task < 576; task += nb) {
      const int l = task / 144, j0 = (task % 144) * 64;
      const float* w = p.in[4] + (size_t)l * 1024 * 9216 + j0 + lane;
      float a0 = 0, a1 = 0, a2 = 0, a3 = 0, a4 = 0, a5 = 0, a6 = 0, a7 = 0, a8 = 0;
#pragma unroll 16
      for (int k = wid * 128; k < wid * 128 + 128; ++k) { const float wv = w[(size_t)k * 9216];
        a0 += sc[k] * wv; a1 += sc[1024 + k] * wv; a2 += sc[2048 + k] * wv; a3 += sc[3072 + k] * wv; a4 += sc[4096 + k] * wv;
        a5 += sc[5120 + k] * wv; a6 += sc[6144 + k] * wv; a7 += sc[7168 + k] * wv; a8 += sc[8192 + k] * wv; }
      float* rw = red + wid * 9 * 64 + lane;
      rw[0] = a0; rw[64] = a1; rw[128] = a2; rw[192] = a3; rw[256] = a4; rw[320] = a5; rw[384] = a6; rw[448] = a7; rw[512] = a8;
      __syncthreads();
      for (int i = tid; i < 9 * 64; i += 512) { const int b = i >> 6, ln = i & 63; float s = 0.f;
#pragma unroll
        for (int w8 = 0; w8 < 8; ++w8) s += red[w8 * 9 * 64 + b * 64 + ln];
        mod[((size_t)l * 9 + b) * 9216 + j0 + ln] = s + p.in[5][l * 9216 + j0 + ln]; }
      __syncthreads();
    }
  }
}

__device__ __forceinline__ void phase_convert(const Params& p, int l, unsigned char* shm) {
  float* tile = (float*)shm;
  int tid_ = threadIdx.x; asm volatile("" : "+v"(tid_)); const int tid = tid_;
  for (int q = blockIdx.x; q < 6400; q += gridDim.x) {
    const float* W; bf16_t* Bt; int N, K, k0, n0d, n0s;
    if (q < 2816) { const int i = q / 1408, qq = q % 1408; W = p.in[7] + (size_t)(l * 2 + i) * 1024 * 5632; Bt = (bf16_t*)(p.ws + (i ? WB_FFIN1 : WB_FFIN0)); N = 5632; K = 1024;
      k0 = (qq & 15) * 64; n0d = (qq >> 4) * 64; n0s = ((n0d >> 7) & 1) * 2816 + (n0d >> 8) * 128 + (n0d & 127); }
    else if (q < 4224) { const int i = (q - 2816) / 704, qq = (q - 2816) % 704; W = p.in[8] + (size_t)(l * 2 + i) * 2816 * 1024; Bt = (bf16_t*)(p.ws + (i ? WB_FFOUT1 : WB_FFOUT0)); N = 1024; K = 2816;
      k0 = (qq % 44) * 64; n0d = (qq / 44) * 64; n0s = n0d; }
    else if (q < 6144) { const int qq = q - 4224; W = p.in[9] + (size_t)l * 1024 * 7680; Bt = (bf16_t*)(p.ws + WB_WIN); N = 7680; K = 1024;
      k0 = (qq & 15) * 64; n0d = (qq >> 4) * 64; n0s = n0d; }
    else { const int qq = q - 6144; W = p.in[10] + (size_t)l * 1024 * 1024; Bt = (bf16_t*)(p.ws + WB_WO); N = 1024; K = 1024;
      k0 = (qq & 15) * 64; n0d = (qq >> 4) * 64; n0s = n0d; }
    { const int nl = tid & 63, ks = tid >> 6;
#pragma unroll
      for (int i = 0; i < 8; ++i) { const int k = ks + 8 * i; tile[nl * 65 + k] = W[(size_t)(k0 + k) * N + n0s + nl]; } }
    __syncthreads();
    { const int n = tid >> 3, kc = (tid & 7) * 8; const float* tr = tile + n * 65 + kc;
      u32x4 w; w.x = cvtpk(tr[0], tr[1]); w.y = cvtpk(tr[2], tr[3]); w.z = cvtpk(tr[4], tr[5]); w.w = cvtpk(tr[6], tr[7]);
      *(u32x4*)(Bt + (size_t)(n0d + n) * K + k0 + kc) = w; }
    __syncthreads();
  }
}

__device__ __forceinline__ void phase_norm(const float* __restrict__ x, const float* __restrict__ g, const float* __restrict__ modl, int jj, bf16_t* __restrict__ xn) {
  int tid_ = threadIdx.x; asm volatile("" : "+v"(tid_)); const int tid = tid_, wid = tid >> 6, lane = tid & 63;
  for (int row = (blockIdx.x * 8 + wid) * 2; row < T_TOK; row += gridDim.x * 16) {
    const int bi = row < 16384 ? (row >> 11) : 8;
    const float* shift = modl + (size_t)bi * 9216 + (3 * jj) * 1024; const float* scale = shift + 1024;
    const float4* xr = (const float4*)(x + (size_t)row * DM);
    float4 v[8]; float ss0 = 0.f, ss1 = 0.f;
#pragma unroll
    for (int i = 0; i < 8; ++i) v[i] = xr[lane + 64 * i];
#pragma unroll
    for (int i = 0; i < 4; ++i) { ss0 += v[i].x * v[i].x + v[i].y * v[i].y + v[i].z * v[i].z + v[i].w * v[i].w;
      ss1 += v[4 + i].x * v[4 + i].x + v[4 + i].y * v[4 + i].y + v[4 + i].z * v[4 + i].z + v[4 + i].w * v[4 + i].w; }
    ss0 = wave_sum(ss0); ss1 = wave_sum(ss1);
    const float rs0 = rsqrtf(ss0 * (1.f / 1024.f) + EPS), rs1 = rsqrtf(ss1 * (1.f / 1024.f) + EPS);
#pragma unroll
    for (int i = 0; i < 4; ++i) { const int c4 = lane + 64 * i;
      const float4 gg = ((const float4*)g)[c4], sc = ((const float4*)scale)[c4], sh = ((const float4*)shift)[c4];
      const float m0 = gg.x * (1.f + sc.x), m1 = gg.y * (1.f + sc.y), m2 = gg.z * (1.f + sc.z), m3 = gg.w * (1.f + sc.w);
      u32x2 w; w.x = cvtpk(v[i].x * rs0 * m0 + sh.x, v[i].y * rs0 * m1 + sh.y); w.y = cvtpk(v[i].z * rs0 * m2 + sh.z, v[i].w * rs0 * m3 + sh.w);
      *(u32x2*)(xn + (size_t)row * DM + c4 * 4) = w;
      u32x2 w2; w2.x = cvtpk(v[4 + i].x * rs1 * m0 + sh.x, v[4 + i].y * rs1 * m1 + sh.y); w2.y = cvtpk(v[4 + i].z * rs1 * m2 + sh.z, v[4 + i].w * rs1 * m3 + sh.w);
      *(u32x2*)(xn + (size_t)(row + 1) * DM + c4 * 4) = w2; }
  }
}

__device__ __forceinline__ void phase_qknorm(const Params& p, int l) {
  bf16_t* qkv = (bf16_t*)(p.ws + WS_QKV); const float* rope = (const float*)(p.ws + WS_ROPE);
  int tid_ = threadIdx.x; asm volatile("" : "+v"(tid_)); const int tid = tid_, wid = tid >> 6, lane = tid & 63;
  f32x2 gk[3];
  gk[0] = *(const f32x2*)(p.in[12] + l * 128 + 2 * lane); gk[1] = *(const f32x2*)(p.in[14] + l * 128 + 2 * lane);
  gk[2] = *(const f32x2*)(p.in[16] + l * 64 + ((2 * lane) & 63));
  const float sg = (lane & 16) ? 1.f : -1.f;
  for (int tok0 = (blockIdx.x * 8 + wid) * 4; tok0 < T_TOK; tok0 += gridDim.x * 32) {
    unsigned u[4][6];
#pragma unroll
    for (int t = 0; t < 4; ++t)
#pragma unroll
      for (int s = 0; s < 6; ++s) u[t][s] = ((const unsigned*)(qkv + (size_t)(tok0 + t) * QKVW + (s >> 1) * 1536 + 1024 + (s & 1) * 128))[lane];
#pragma unroll
    for (int t = 0; t < 4; ++t) { const int tok = tok0 + t;
      const int sp = tok < 16384 ? (tok & 2047) : (tok - 16384);
      const int pos = lane < 32 ? (sp >> 6) : (sp & 63);
      const f32x4 cs = *(const f32x4*)(rope + (size_t)(pos * 32 + ((2 * lane) & 31)) * 2);
#pragma unroll
      for (int s = 0; s < 6; ++s) { const int br = s >> 1;
        float a = bf_lo(u[t][s]), b = bf_hi(u[t][s]);
        float ss = a * a + b * b;
        ss += __shfl_xor(ss, 1); ss += __shfl_xor(ss, 2); ss += __shfl_xor(ss, 4); ss += __shfl_xor(ss, 8); ss += __shfl_xor(ss, 16);
        float rs;
        if (br < 2) { ss += __shfl_xor(ss, 32); rs = rsqrtf(ss * (1.f / 128.f) + EPS); }
        else rs = rsqrtf(ss * (1.f / 64.f) + EPS);
        a = a * rs * gk[br][0]; b = b * rs * gk[br][1];
        if (br == 0) { const float pa = __shfl_xor(a, 16), pb = __shfl_xor(b, 16);
          a = a * cs[0] + sg * pa * cs[1]; b = b * cs[2] + sg * pb * cs[3]; }
        ((unsigned*)(qkv + (size_t)tok * QKVW + br * 1536 + 1024 + (s & 1) * 128))[lane] = cvtpk(a, b); } }
  }
}

__device__ __forceinline__ void phase_attn(const Params& p, int l, unsigned char* shm) {
  const bf16_t* qkv = (const bf16_t*)(p.ws + WS_QKV); const bf16_t* gates = (const bf16_t*)(p.ws + WS_GATES);
  bf16_t* merged = (bf16_t*)(p.ws + WS_XN);
  const float* lutall = (const float*)(p.ws + WS_LUT); const float* lamp = (const float*)(p.ws + WS_LAM);
  AttnEpi E; E.park = (float*)(p.ws + WS_PARK) + (size_t)blockIdx.x * 65536; E.gsub = p.in[22] + l * 128; E.lam = lamp[2 * l]; E.oml = lamp[2 * l + 1];
  for (int it = blockIdx.x; it < 1024; it += gridDim.x) {
    int S, tok0, h, qb;
    if (it < 512) { S = 16384; tok0 = 16384; h = it & 7; qb = it >> 3; }
    else { const int j = it - 512; S = 2048; h = j & 7; qb = (j >> 3) & 7; tok0 = (j >> 6) * 2048; }
    const int g = h >> 2, q0 = qb * 256;
    const bf16_t* rowQ = qkv + (size_t)(tok0 + q0) * QKVW; const bf16_t* seqK = qkv + (size_t)tok0 * QKVW;
    const bf16_t* grow = gates + (size_t)(tok0 + q0) * GW + h * 128;
    E.merged = merged + (size_t)(tok0 + q0) * DM + h * 128; E.sinkl2 = p.in[17][l * 8 + h] * LOG2E;
    E.gate = grow; E.gq = p.in[11] + l * 128;
    attn_body<0>(rowQ + h * 128, seqK + 1024 + g * 128, seqK + 1280 + g * 128, S / 64, q0, (char*)shm, (const float*)(p.ws + WS_ROPE), E);
    { const int t_lo = max(0, 4 * qb - 2), t_hi = min(S / 64, 4 * qb + 6);
      const bf16_t* kb = seqK + (size_t)t_lo * 64 * QKVW;
      E.gate = grow + 1024; E.gq = p.in[13] + l * 128;
      attn_body<1>(rowQ + 1536 + h * 128, kb + 2560 + g * 128, kb + 2816 + g * 128, t_hi - t_lo, t_lo * 64 - q0, (char*)shm, lutall + h * 259, E); }
    E.gate = grow + 2048; E.gq = p.in[15] + l * 64;
    attn_body<2>(rowQ + 3072 + h * 128, seqK + 4096 + g * 128, seqK + 4352 + g * 128, S / 64, -q0, (char*)shm, lutall + (8 + h) * 259, E);
    attn_body<3>(rowQ + 3072 + h * 128 + 64, seqK + 4096 + g * 128, seqK + 4352 + g * 128, S / 64, -q0, (char*)shm, lutall + (8 + h) * 259, E);
  }
}

__device__ __forceinline__ void gsync(cg::grid_group& g) {
  asm volatile("s_waitcnt vmcnt(0) lgkmcnt(0)" ::: "memory");
  g.sync();
  __builtin_amdgcn_fence(__ATOMIC_ACQUIRE, "agent");
  asm volatile("s_waitcnt vmcnt(0)" ::: "memory");
}
#define XB_TMO      128
#define XB_XCNT(j)  (256  + 64 * (j))
#define XB_XSUB(j)  (1280 + 64 * (j))
#define XB_XGEN(j)  (2304 + 64 * (j))
#define XB_TOP      3328
#define XB_TOPGEN   3392
#define XCD_BAR_WORDS 3456
#define XB_SPIN_CAP (1u << 22)
__device__ __forceinline__ unsigned xb_ld(unsigned* p)              { return __hip_atomic_load(p, __ATOMIC_RELAXED, __HIP_MEMORY_SCOPE_AGENT); }
__device__ __forceinline__ unsigned xb_add(unsigned* p, unsigned v) { return __hip_atomic_fetch_add(p, v, __ATOMIC_RELAXED, __HIP_MEMORY_SCOPE_AGENT); }
__device__ __forceinline__ unsigned xb_xcc_id() { return (unsigned)__builtin_amdgcn_s_getreg((3 << 11) | 20) & 0xFu; }
#define XB_SPIN(cond, bar) do { unsigned _sp = 0; while (cond) { __builtin_amdgcn_s_sleep(1); \
    if ((++_sp & 255u) == 0u) { if (xb_ld(&(bar)[XB_TMO])) break; if (_sp > XB_SPIN_CAP) { atomicAdd(&(bar)[XB_TMO], 1u); break; } } } } while (0)
struct XcdBarrier { unsigned* bar; unsigned x; volatile LAS unsigned* st; };
__device__ __forceinline__ XcdBarrier xcd_barrier_post(unsigned* bar, volatile LAS unsigned* st) {
    XcdBarrier b; b.bar = bar; b.x = xb_xcc_id(); b.st = st;
    if (threadIdx.x == 0) (void)xb_add(&bar[XB_XCNT(b.x)], 1u);
    return b;
}
__device__ __forceinline__ void xcd_barrier_complete(unsigned* bar, unsigned x, unsigned& nloc, unsigned& nx) {
    const unsigned G = gridDim.x * gridDim.y * gridDim.z;
    unsigned sum, cnt, mine, sp = 0u;
    for (;;) {
        sum = 0u; cnt = 0u; mine = 0u;
#pragma unroll
        for (unsigned j = 0; j < 16; ++j) { const unsigned c = xb_ld(&bar[XB_XCNT(j)]); sum += c; cnt += (c > 0u) ? 1u : 0u; mine = (j == x) ? c : mine; }
        if (sum == G) break;
        __builtin_amdgcn_s_sleep(1);
        if ((++sp & 255u) == 0u) { if (xb_ld(&bar[XB_TMO])) break; if (sp > XB_SPIN_CAP) { atomicAdd(&bar[XB_TMO], 1u); break; } }
    }
    nloc = mine > 0u ? mine : 1u; nx = cnt > 0u ? cnt : 1u;
}
__device__ __forceinline__ void xcd_barrier(const XcdBarrier& b) {
    asm volatile("s_waitcnt vmcnt(0)" ::: "memory");
    __syncthreads();
    if (threadIdx.x == 0) {
        unsigned* bar = b.bar;
        __builtin_amdgcn_s_waitcnt(0);
        unsigned nloc = b.st[0], nx = b.st[1];
        if (nloc == 0u) { xcd_barrier_complete(bar, b.x, nloc, nx); b.st[0] = nloc; b.st[1] = nx; }
        const unsigned old = xb_add(&bar[XB_XSUB(b.x)], 1u);
        const unsigned gen = old / nloc;
        if (old + 1u == (gen + 1u) * nloc) {
            __builtin_amdgcn_fence(__ATOMIC_RELEASE, "agent");
            asm volatile("s_waitcnt vmcnt(0)" ::: "memory");
            const unsigned og = xb_add(&bar[XB_TOP], 1u);
            const unsigned tg = og / nx;
            if (og + 1u == (tg + 1u) * nx) xb_add(&bar[XB_TOPGEN], 1u);
            else XB_SPIN(xb_ld(&bar[XB_TOPGEN]) == tg, bar);
            __builtin_amdgcn_fence(__ATOMIC_ACQUIRE, "agent");
            xb_add(&bar[XB_XGEN(b.x)], 1u);
            asm volatile("s_waitcnt vmcnt(0)" ::: "memory");
        } else {
            XB_SPIN(xb_ld(&bar[XB_XGEN(b.x)]) == gen, bar);
            __builtin_amdgcn_fence(__ATOMIC_ACQUIRE, "agent");
            asm volatile("s_waitcnt vmcnt(0)" ::: "memory");
        }
    }
    __syncthreads();
}

__device__ __forceinline__ void panel_norm_rows(const float* __restrict__ x, const float* __restrict__ g, const float* __restrict__ modl, int jj, bf16_t* __restrict__ xn, int row0) {
  int tid_ = threadIdx.x; asm volatile("" : "+v"(tid_)); const int tid = tid_, wid = tid >> 6, lane = tid & 63;
#pragma unroll 1
  for (int rr = 0; rr < 8; rr += 2) {
    const int row = row0 + wid * 8 + rr;
    const int bi = row < 16384 ? (row >> 11) : 8;
    const float* shift = modl + (size_t)bi * 9216 + (3 * jj) * 1024; const float* scale = shift + 1024;
    const float4* xr = (const float4*)(x + (size_t)row * DM);
    float4 v[8]; float ss0 = 0.f, ss1 = 0.f;
#pragma unroll
    for (int i = 0; i < 8; ++i) v[i] = xr[lane + 64 * i];
#pragma unroll
    for (int i = 0; i < 4; ++i) { ss0 += v[i].x * v[i].x + v[i].y * v[i].y + v[i].z * v[i].z + v[i].w * v[i].w;
      ss1 += v[4 + i].x * v[4 + i].x + v[4 + i].y * v[4 + i].y + v[4 + i].z * v[4 + i].z + v[4 + i].w * v[4 + i].w; }
    ss0 = wave_sum(ss0); ss1 = wave_sum(ss1);
    const float rs0 = rsqrtf(ss0 * (1.f / 1024.f) + EPS), rs1 = rsqrtf(ss1 * (1.f / 1024.f) + EPS);
#pragma unroll
    for (int i = 0; i < 4; ++i) { const int c4 = lane + 64 * i;
      const float4 gg = ((const float4*)g)[c4], sc = ((const float4*)scale)[c4], sh = ((const float4*)shift)[c4];
      const float m0 = gg.x * (1.f + sc.x), m1 = gg.y * (1.f + sc.y), m2 = gg.z * (1.f + sc.z), m3 = gg.w * (1.f + sc.w);
      u32x2 w; w.x = cvtpk(v[i].x * rs0 * m0 + sh.x, v[i].y * rs0 * m1 + sh.y); w.y = cvtpk(v[i].z * rs0 * m2 + sh.z, v[i].w * rs0 * m3 + sh.w);
      *(u32x2*)(xn + (size_t)row * DM + c4 * 4) = w;
      u32x2 w2; w2.x = cvtpk(v[4 + i].x * rs1 * m0 + sh.x, v[4 + i].y * rs1 * m1 + sh.y); w2.y = cvtpk(v[4 + i].z * rs1 * m2 + sh.z, v[4 + i].w * rs1 * m3 + sh.w);
      *(u32x2*)(xn + (size_t)(row + 1) * DM + c4 * 4) = w2; }
  }
}
__device__ __forceinline__ void panel_norm(const pg8::StaticOrder& S, unsigned* pcnt, unsigned epoch, const float* x, const float* g, const float* modl, int jj, bf16_t* xn) {
  asm volatile("s_waitcnt vmcnt(0)" ::: "memory");
  __syncthreads();
  if (threadIdx.x == 0) {
    __builtin_amdgcn_fence(__ATOMIC_RELEASE, "agent"); asm volatile("s_waitcnt vmcnt(0)" ::: "memory");
    pg8::Unit u;
    for (int i = 0; S.next(i, u); ++i) (void)xb_add(&pcnt[64 * u.pm], 1u);
    for (int i = 0; S.next(i, u); ++i) { unsigned sp = 0; while (xb_ld(&pcnt[64 * u.pm]) < 4u * epoch) { __builtin_amdgcn_s_sleep(1); if (++sp > (1u << 22)) break; } }
    __builtin_amdgcn_fence(__ATOMIC_ACQUIRE, "agent"); asm volatile("s_waitcnt vmcnt(0)" ::: "memory");
  }
  __syncthreads();
  pg8::Unit u;
  for (int i = 0; S.next(i, u); ++i) panel_norm_rows(x, g, modl, jj, xn, u.pm * 256 + u.pn * 64);
}

constexpr int N_PHASES = 45;
__global__ void __launch_bounds__(512) mega_fwd(Params p, int ph_lo, int ph_hi) {
  extern __shared__ __attribute__((aligned(16))) unsigned char shm[];
  cg::grid_group grid = cg::this_grid();
  LAS unsigned char* lds3 = (LAS unsigned char*)shm;
  float* X = p.out;
  bf16_t* XN = (bf16_t*)(p.ws + WS_XN); bf16_t* Hb = (bf16_t*)(p.ws + WS_QKV);
  pg8::StaticOrder S;
  volatile LAS unsigned* xst = (volatile LAS unsigned*)(lds3 + 131072);
  if (threadIdx.x == 0) { xst[0] = 0u; xst[1] = 0u; }
  unsigned* xbar = (unsigned*)(p.ws + WS_BAR);
  XcdBarrier xb; xb.bar = xbar; xb.x = 0u; xb.st = xst;
#pragma unroll 1
  for (int ph = ph_lo; ph < ph_hi; ++ph) {
    if (ph == 0) { phase_setup(p, shm); }
    else {
      const int l = (ph - 1) / 11, k = (ph - 1) % 11;
      const float* modl = (const float*)(p.ws + WS_MOD) + (size_t)l * 9 * 9216;
      if (k == 3 || k == 8) continue;
      if (k == 0) {
        phase_convert(p, l, shm);
        if (l == 0) phase_norm(X, p.in[6], modl, 0, XN);
      } else if (k == 1 || k == 9) {
        pg8::Gemm g{XN, (const bf16_t*)(p.ws + (k == 9 ? WB_FFIN1 : WB_FFIN0)), T_TOK, NFF2, DM};
        S.init(T_TOK, NFF2, gridDim.x, blockIdx.x); pg8::EpiSwiGLU E{Hb}; pg8::gemm_phase(lds3, g, S, E);
      } else if (k == 2 || k == 10 || k == 7) {
        const bool wo = (k == 7);
        pg8::Gemm g{wo ? XN : Hb, (const bf16_t*)(p.ws + (wo ? WB_WO : (k == 10 ? WB_FFOUT1 : WB_FFOUT0))), T_TOK, DM, wo ? DM : DFF};
        S.init(T_TOK, DM, gridDim.x, blockIdx.x); pg8::EpiResid E{X, modl + (wo ? 5 : (k == 10 ? 8 : 2)) * 1024, wo ? 1.0f : 0.5f}; pg8::gemm_phase(lds3, g, S, E);
        const unsigned epoch = (unsigned)(l * 3 + (k == 2 ? 0 : (k == 7 ? 1 : 2)) + 1);
        unsigned* pcnt = (unsigned*)(p.ws + WS_PCNT);
        if (k == 2) panel_norm(S, pcnt, epoch, X, p.in[6] + (size_t)(l * 3 + 1) * 1024, modl, 1, XN);
        else if (k == 7) panel_norm(S, pcnt, epoch, X, p.in[6] + (size_t)(l * 3 + 2) * 1024, modl, 2, XN);
        else if (l < 3) panel_norm(S, pcnt, epoch, X, p.in[6] + (size_t)((l + 1) * 3) * 1024, modl + 9 * 9216, 0, XN);
      } else if (k == 4) {
        pg8::Gemm g{XN, (const bf16_t*)(p.ws + WB_WIN), T_TOK, WINC, DM};
        S.init(T_TOK, WINC, gridDim.x, blockIdx.x); pg8::EpiQKV E{(bf16_t*)(p.ws + WS_QKV), (bf16_t*)(p.ws + WS_GATES)}; pg8::gemm_phase(lds3, g, S, E);
      } else if (k == 5) { phase_qknorm(p, l); }
      else { phase_attn(p, l, shm); }
    }
    if (ph + 1 < ph_hi) {
      if (ph == 0) { gsync(grid); xb = xcd_barrier_post(xbar, xst); }
      else xcd_barrier(xb);
    }
  }
}

#ifndef N_LAUNCH_MODE
#define N_LAUNCH_MODE 1
#endif
extern "C" void kernel_launch(void* const* d_in, const int* in_sizes, int n_in, void* d_out, int out_size, void* d_ws, size_t ws_size, hipStream_t stream) {
  static int grid = 0;
  if (grid == 0) {
    if (n_in != 24 || out_size != T_TOK * DM || ws_size < WS_END2) { fprintf(stderr, "kernel_launch: unexpected shapes (n_in %d out %d ws %zu need %zu)\n", n_in, out_size, ws_size, (size_t)WS_END2); grid = -1; return; }
    int dev = 0, cus = 0, per_cu = 0;
    (void)hipGetDevice(&dev); (void)hipDeviceGetAttribute(&cus, hipDeviceAttributeMultiprocessorCount, dev);
    if (hipFuncSetAttribute((const void*)mega_fwd, hipFuncAttributeMaxDynamicSharedMemorySize, LDS_BYTES) != hipSuccess) { fprintf(stderr, "kernel_launch: hipFuncSetAttribute failed\n"); grid = -1; return; }
    if (hipOccupancyMaxActiveBlocksPerMultiprocessor(&per_cu, (const void*)mega_fwd, 512, LDS_BYTES) != hipSuccess || per_cu < 1) { fprintf(stderr, "kernel_launch: occupancy query gave %d\n", per_cu); per_cu = 1; }
    (void)hipGetLastError();
    grid = cus;
  }
  if (grid < 0) return;
  Params p{};
  for (int i = 0; i < 24; ++i) p.in[i] = (const float*)d_in[i];
  p.out = (float*)d_out; p.ws = (unsigned char*)d_ws;
#if N_LAUNCH_MODE == 1
  int lo = 0, hi = N_PHASES;
  void* args[] = {&p, &lo, &hi};
  hipError_t e = hipLaunchCooperativeKernel((const void*)mega_fwd, dim3(grid), dim3(512), args, LDS_BYTES, stream);
  if (e != hipSuccess) fprintf(stderr, "kernel_launch: cooperative launch failed: %s (grid %d)\n", hipGetErrorString(e), grid);
#else
  for (int ph = 0; ph < N_PHASES; ++ph) hipLaunchKernelGGL(mega_fwd, dim3(grid), dim3(512), LDS_BYTES, stream, p, ph, ph + 1);
#endif
}
```

```cpp
#include <hip/hip_runtime.h>
#include <hip/hip_bf16.h>
#include <hip/hip_cooperative_groups.h>
#include <cstdio>
#include <cstdint>
#define N_LAUNCH_MODE 1
namespace cg = cooperative_groups;

typedef unsigned short bf16_t;
typedef short bf16x8 __attribute__((ext_vector_type(8)));
typedef short s16x4 __attribute__((ext_vector_type(4)));
typedef float f32x4 __attribute__((ext_vector_type(4)));
typedef float f32x16 __attribute__((ext_vector_type(16)));
typedef unsigned u32x4 __attribute__((ext_vector_type(4)));
typedef unsigned u32x2 __attribute__((ext_vector_type(2)));
#define LAS __attribute__((address_space(3)))

constexpr int T_TOK = 32768, DM = 1024, DFF = 2816, NFF2 = 5632, WINC = 7680, QKVW = 4608, GW = 3072;
constexpr float EPS = 1e-6f, LOG2E = 1.4426950408889634f, NEGBIG = -1e30f;
constexpr size_t WB_FFIN0 = 0, WB_FFIN1 = 11534336, WB_FFOUT0 = 23068672, WB_FFOUT1 = 28835840, WB_WIN = 34603008, WB_WO = 50331648;
constexpr size_t WS_MOD = 52428800, WS_ROPE = 53755904, WS_LUT = 53821440, WS_LAM = 53854208, WS_XN = 53854464;
constexpr size_t WS_QKV = WS_XN + 67108864, WS_GATES = WS_QKV + 301989888, WS_PARK = WS_GATES + 201326592, WS_END = WS_PARK + 67108864;
constexpr size_t WS_BAR = WS_END, WS_PCNT = WS_END + 16384, WS_END2 = WS_END + 65536;
constexpr int LDS_BYTES = 131072 + 16;

struct Params { const float* in[24]; float* out; unsigned char* ws; };

typedef __bf16 bf16v2 __attribute__((ext_vector_type(2)));
typedef float f32x2 __attribute__((ext_vector_type(2)));
__device__ __forceinline__ unsigned cvtpk(float lo, float hi) { f32x2 v = {lo, hi}; bf16v2 b = __builtin_convertvector(v, bf16v2); return __builtin_bit_cast(unsigned, b); }
__device__ __forceinline__ float bf_lo(unsigned u) { return __uint_as_float(u << 16); }
__device__ __forceinline__ float bf_hi(unsigned u) { return __uint_as_float(u & 0xffff0000u); }
__device__ __forceinline__ float bf2f(bf16_t v) { return __uint_as_float(((unsigned)v) << 16); }

namespace pg8 {
constexpr int BM = 256, BK = 64, HALF = 128, HTB = HALF * BK * 2, STAGE_BYTES = 8 * HTB, NXCD = 8, WGM = 8;
__device__ __forceinline__ int lds_byte(int r, int c) { const int st = (r >> 4) * 2 + (c >> 5), rr = r & 15, cc = c & 31, ob = rr * 64 + cc * 2; return st * 1024 + (ob ^ (((ob >> 9) & 1) << 5)); }
__device__ __forceinline__ void stage_rc(int b, int& R, int& C) { const int st = b / 1024, sb = b % 1024, swz = sb ^ (((sb >> 9) & 1) << 5); R = (st >> 1) * 16 + swz / 64; C = (st & 1) * 32 + (swz % 64) / 2; }
__device__ __forceinline__ int perm32(int rho) { const int n = rho >> 4, i = rho & 15; return 8 * (i >> 2) + 4 * n + (i & 3); }
struct Unit { int pm, pn; };
struct Gemm { const bf16_t* A; const bf16_t* Bt; int M, N, K; };
struct StaticOrder {
    int nM, nN, nwg, G, c;
    __device__ void init(int M, int N, int G_, int c_) { nM = M / BM; nN = N / BM; nwg = nM * nN; G = G_; c = c_; }
    __device__ bool next(int i, Unit& u) const {
        const long L = (long)i * G + c; if (L >= nwg) return false;
        int wgid = (int)L; { const int q = nwg / NXCD, r = nwg % NXCD, xcd = wgid % NXCD, off = wgid / NXCD; wgid = (xcd < r ? xcd * (q + 1) : r * (q + 1) + (xcd - r) * q) + off; }
        const int nig = WGM * nN, gid = wgid / nig, fm = gid * WGM, gsz = (nM - fm) < WGM ? (nM - fm) : WGM;
        u.pm = fm + ((wgid % nig) % gsz); u.pn = (wgid % nig) / gsz; return true;
    }
};

template <class Epi>
__device__ __forceinline__ void gemm_phase(LAS unsigned char* lds, const Gemm g, const StaticOrder& S, const Epi& E) {
    int tid_ = threadIdx.x; asm volatile("" : "+v"(tid_));
    const int tid = tid_, wid = __builtin_amdgcn_readfirstlane(tid >> 6), lane = tid & 63, wr = wid >> 2, wc = wid & 3, fr = lane & 15, fq = lane >> 4;
    const int K = g.K, nt = K / BK;
    unsigned voffA[2], voffB[2];
#pragma unroll
    for (int i = 0; i < 2; ++i) { int R, C; stage_rc(tid * 16 + i * 8192, R, C); const int Rb = Epi::PERM ? ((R & ~31) + perm32(R & 31)) : R;
        voffA[i] = (unsigned)(R * K + C) * 2u; voffB[i] = (unsigned)(Rb * K + C) * 2u; }
    const size_t kstep = (size_t)(BK * 2);
    const size_t hstep = (size_t)HALF * K * 2;
    const size_t tstep = 2 * hstep;
    const unsigned ldsw = (unsigned)wid * 1024u;
    const int aoff = lds_byte(wr * 64 + fr, fq * 8), boff = lds_byte(wc * 32 + fr, fq * 8);
#define PG8_SA(b, h) (((b) * 2 + (h)) * HTB)
#define PG8_SB(b, h) ((4 + (b) * 2 + (h)) * HTB)
#define PG8_STAGE(bufoff, gbase, voff) do { _Pragma("unroll") for (int _i = 0; _i < 2; ++_i) \
        __builtin_amdgcn_global_load_lds((const unsigned*)((const char*)(gbase) + (voff)[_i]), (LAS unsigned*)(lds + (bufoff) + ldsw + _i * 8192), 16, 0, 0); } while (0)
#define PG8_LDA(dst, b, h) do { _Pragma("unroll") for (int m = 0; m < 4; ++m) _Pragma("unroll") for (int k = 0; k < 2; ++k) dst[m][k] = *(const LAS bf16x8*)(lds + PG8_SA(b, h) + aoff + m * 2048 + k * 1024); } while (0)
#define PG8_LDB(dst, b, h) do { _Pragma("unroll") for (int n = 0; n < 2; ++n) _Pragma("unroll") for (int k = 0; k < 2; ++k) dst[n][k] = *(const LAS bf16x8*)(lds + PG8_SB(b, h) + boff + n * 2048 + k * 1024); } while (0)
#define PG8_MMA(ai, bj, At, Bt) do { __builtin_amdgcn_s_setprio(1); _Pragma("unroll") for (int m = 0; m < 4; ++m) _Pragma("unroll") for (int n = 0; n < 2; ++n) _Pragma("unroll") for (int k = 0; k < 2; ++k) \
        acc[ai][bj][m][n] = __builtin_amdgcn_mfma_f32_16x16x32_bf16(Bt[n][k], At[m][k], acc[ai][bj][m][n], 0, 0, 0); __builtin_amdgcn_s_setprio(0); } while (0)
#define PG8_WAIT_V(n) asm volatile("s_waitcnt vmcnt(" #n ")" ::: "memory")
#define PG8_WAIT_L(n) asm volatile("s_waitcnt lgkmcnt(" #n ")" ::: "memory")
#define PG8_BAR __builtin_amdgcn_s_barrier()
#define PG8_SCHED __builtin_amdgcn_sched_barrier(0)
    Unit cur, nxt; int ui = 0;
    if (!S.next(0, cur)) return;
    f32x4 acc[2][2][4][2];
#pragma unroll
    for (int a = 0; a < 2; ++a)
#pragma unroll
        for (int b = 0; b < 2; ++b)
#pragma unroll
            for (int m = 0; m < 4; ++m)
#pragma unroll
                for (int n = 0; n < 2; ++n) acc[a][b][m][n] = (f32x4){0.f, 0.f, 0.f, 0.f};
    bf16x8 At[4][2], B0[2][2], B1[2][2];
    const char* cA = (const char*)g.A + (size_t)cur.pm * tstep; const char* cB = (const char*)g.Bt + (size_t)cur.pn * tstep;
    PG8_STAGE(PG8_SB(0, 0), cB, voffB); PG8_STAGE(PG8_SA(0, 0), cA, voffA); PG8_STAGE(PG8_SB(0, 1), cB + hstep, voffB); PG8_STAGE(PG8_SA(0, 1), cA + hstep, voffA);
    if (wr == 1) PG8_BAR;
    PG8_WAIT_V(4); PG8_BAR;
    PG8_STAGE(PG8_SB(1, 0), cB + kstep, voffB); PG8_STAGE(PG8_SA(1, 0), cA + kstep, voffA); PG8_STAGE(PG8_SB(1, 1), cB + hstep + kstep, voffB);
    PG8_WAIT_V(6); PG8_BAR;
    for (;;) {
        const bool has_next = S.next(ui + 1, nxt);
        const char* nA = has_next ? (const char*)g.A + (size_t)nxt.pm * tstep : cA; const char* nB = has_next ? (const char*)g.Bt + (size_t)nxt.pn * tstep : cB;
        for (int t = 0; t < nt; t += 2) {
            const bool last = (t == nt - 2);
            const char* a1 = cA + (size_t)(t + 1) * kstep;
            const char* a2 = last ? nA : cA + (size_t)(t + 2) * kstep; const char* b2 = last ? nB : cB + (size_t)(t + 2) * kstep;
            const char* a3 = a2 + kstep; const char* b3 = b2 + kstep;
            PG8_LDB(B0, 0, 0); PG8_SCHED; PG8_LDA(At, 0, 0); PG8_STAGE(PG8_SA(1, 1), a1 + hstep, voffA);
            PG8_WAIT_L(8); PG8_BAR; PG8_WAIT_L(0); PG8_MMA(0, 0, At, B0); PG8_BAR; PG8_SCHED;
            PG8_LDB(B1, 0, 1); PG8_STAGE(PG8_SB(0, 0), b2, voffB);
            PG8_BAR; PG8_WAIT_L(0); PG8_MMA(0, 1, At, B1); PG8_BAR;
            PG8_LDA(At, 0, 1); PG8_STAGE(PG8_SA(0, 0), a2, voffA);
            PG8_BAR; PG8_WAIT_L(0); PG8_MMA(1, 0, At, B0); PG8_BAR; PG8_SCHED;
            PG8_STAGE(PG8_SB(0, 1), b2 + hstep, voffB);
            PG8_WAIT_V(6); PG8_BAR; PG8_MMA(1, 1, At, B1); PG8_BAR;
            PG8_LDB(B0, 1, 0); PG8_SCHED; PG8_LDA(At, 1, 0); PG8_STAGE(PG8_SA(0, 1), a2 + hstep, voffA);
            PG8_WAIT_L(8); PG8_BAR; PG8_WAIT_L(0); PG8_MMA(0, 0, At, B0); PG8_BAR; PG8_SCHED;
            PG8_LDB(B1, 1, 1); PG8_STAGE(PG8_SB(1, 0), b3, voffB);
            PG8_BAR; PG8_WAIT_L(0); PG8_MMA(0, 1, At, B1); PG8_BAR;
            PG8_LDA(At, 1, 1); PG8_STAGE(PG8_SA(1, 0), a3, voffA);
            PG8_BAR; PG8_WAIT_L(0); PG8_MMA(1, 0, At, B0); PG8_BAR; PG8_SCHED;
            PG8_STAGE(PG8_SB(1, 1), b3 + hstep, voffB);
            PG8_WAIT_V(6); PG8_BAR; PG8_MMA(1, 1, At, B1); PG8_BAR;
        }
        E(acc, cur, wr, wc, fr, fq);
        if (!has_next) break;
#pragma unroll
        for (int a = 0; a < 2; ++a)
#pragma unroll
            for (int b = 0; b < 2; ++b)
#pragma unroll
                for (int m = 0; m < 4; ++m)
#pragma unroll
                    for (int n = 0; n < 2; ++n) acc[a][b][m][n] = (f32x4){0.f, 0.f, 0.f, 0.f};
        cur = nxt; cA = nA; cB = nB; ++ui;
    }
    PG8_WAIT_V(0);
    if (wr == 0) PG8_BAR;
    PG8_BAR;
#undef PG8_SA
#undef PG8_SB
#undef PG8_STAGE
#undef PG8_LDA
#undef PG8_LDB
#undef PG8_MMA
#undef PG8_WAIT_V
#undef PG8_WAIT_L
#undef PG8_BAR
#undef PG8_SCHED
}

__device__ __forceinline__ float silu_f(float g) { return g * __builtin_amdgcn_rcpf(1.f + __expf(-g)); }
__device__ __forceinline__ float sigm_f(float g) { return __builtin_amdgcn_rcpf(1.f + __expf(-g)); }
struct EpiSwiGLU {
    static constexpr bool PERM = true;
    bf16_t* H;
    __device__ __forceinline__ void operator()(const f32x4 (&acc)[2][2][4][2], const Unit& u, int wr, int wc, int fr, int fq) const {
        const int row0 = u.pm * BM + wr * 64 + fr, col0 = u.pn * 128 + wc * 32 + 8 * fq;
#pragma unroll
        for (int ai = 0; ai < 2; ++ai)
#pragma unroll
            for (int m = 0; m < 4; ++m) { bf16_t* rowp = H + (size_t)(row0 + ai * HALF + m * 16) * DFF + col0;
                const f32x4 g0 = acc[ai][0][m][0], g1 = acc[ai][0][m][1], u0 = acc[ai][1][m][0], u1 = acc[ai][1][m][1];
                u32x4 w; w.x = cvtpk(silu_f(g0[0]) * u0[0], silu_f(g0[1]) * u0[1]); w.y = cvtpk(silu_f(g0[2]) * u0[2], silu_f(g0[3]) * u0[3]);
                w.z = cvtpk(silu_f(g1[0]) * u1[0], silu_f(g1[1]) * u1[1]); w.w = cvtpk(silu_f(g1[2]) * u1[2], silu_f(g1[3]) * u1[3]);
                *(u32x4*)rowp = w; }
    }
};
struct EpiResid {
    static constexpr bool PERM = false;
    float* X; const float* modg; float gs;
    __device__ __forceinline__ void operator()(const f32x4 (&acc)[2][2][4][2], const Unit& u, int wr, int wc, int fr, int fq) const {
        const int row0 = u.pm * BM + wr * 64 + fr, col0 = u.pn * BM + wc * 32 + 4 * fq;
        const int bi = u.pm < 64 ? (u.pm >> 3) : 8;
        const float* mg = modg + (size_t)bi * 9216 + col0;
        f32x4 gv[2][2];
#pragma unroll
        for (int bj = 0; bj < 2; ++bj)
#pragma unroll
            for (int n = 0; n < 2; ++n) gv[bj][n] = *(const f32x4*)(mg + bj * HALF + n * 16) * gs;
#pragma unroll
        for (int ai = 0; ai < 2; ++ai)
#pragma unroll
            for (int m = 0; m < 4; ++m) { float* rowp = X + (size_t)(row0 + ai * HALF + m * 16) * DM + col0;
#pragma unroll
                for (int bj = 0; bj < 2; ++bj)
#pragma unroll
                    for (int n = 0; n < 2; ++n) { f32x4* q = (f32x4*)(rowp + bj * HALF + n * 16); *q = *q + gv[bj][n] * acc[ai][bj][m][n]; } }
    }
};
struct EpiQKV {
    static constexpr bool PERM = true;
    bf16_t* QKV; bf16_t* GATES;
    __device__ __forceinline__ void operator()(const f32x4 (&acc)[2][2][4][2], const Unit& u, int wr, int wc, int fr, int fq) const {
        const int row0 = u.pm * BM + wr * 64 + fr;
        if (u.pn < 18) {
            const int col0 = u.pn * BM + wc * 32 + 8 * fq;
#pragma unroll
            for (int ai = 0; ai < 2; ++ai)
#pragma unroll
                for (int m = 0; m < 4; ++m) { bf16_t* rowp = QKV + (size_t)(row0 + ai * HALF + m * 16) * QKVW + col0;
#pragma unroll
                    for (int bj = 0; bj < 2; ++bj) { const f32x4 v0 = acc[ai][bj][m][0], v1 = acc[ai][bj][m][1];
                        u32x4 w; w.x = cvtpk(v0[0], v0[1]); w.y = cvtpk(v0[2], v0[3]); w.z = cvtpk(v1[0], v1[1]); w.w = cvtpk(v1[2], v1[3]);
                        *(u32x4*)(rowp + bj * HALF) = w; } }
        } else {
            const int col0 = (u.pn - 18) * BM + wc * 32 + 8 * fq;
#pragma unroll
            for (int ai = 0; ai < 2; ++ai)
#pragma unroll
                for (int m = 0; m < 4; ++m) { bf16_t* rowp = GATES + (size_t)(row0 + ai * HALF + m * 16) * GW + col0;
#pragma unroll
                    for (int bj = 0; bj < 2; ++bj) { const f32x4 v0 = acc[ai][bj][m][0], v1 = acc[ai][bj][m][1];
                        u32x4 w; w.x = cvtpk(sigm_f(v0[0]), sigm_f(v0[1])); w.y = cvtpk(sigm_f(v0[2]), sigm_f(v0[3])); w.z = cvtpk(sigm_f(v1[0]), sigm_f(v1[1])); w.w = cvtpk(sigm_f(v1[2]), sigm_f(v1[3]));
                        *(u32x4*)(rowp + bj * HALF) = w; } }
        }
    }
};
}

constexpr int LDQK = QKVW;
constexpr int SHM_V = 64 * 128 * 2, SHM_K = 64 * 128 * 2;
constexpr int ATT_NBUF = 3;
constexpr int ATT_WS_OFF = ATT_NBUF * SHM_V + ATT_NBUF * SHM_K, ATT_LUT_OFF = ATT_WS_OFF + 8 * 64 * 4;
#define KSWZ(row, colB) ((row) * 256 + ((colB) ^ (((row) & 7) << 4)))
#define SBAR() __builtin_amdgcn_sched_barrier(0)
__device__ __forceinline__ int crow(int r, int hi) { return (r & 3) + 8 * (r >> 2) + 4 * hi; }

template <int MODE>
__device__ __forceinline__ void partialSM(f32x16& p0, f32x16& p1, float& m_reg, float& mn, float& alpha, int relh, int relw_min, int relw_max, const float* lut) {
  if constexpr (MODE == 0) {
    constexpr float SCALE = 0.088388347648318440f, C = SCALE * LOG2E, THR = 8.f;
    float pmax = p0[0];
#pragma unroll
    for (int r = 1; r < 16; ++r) pmax = fmaxf(pmax, p0[r]);
#pragma unroll
    for (int r = 0; r < 16; ++r) pmax = fmaxf(pmax, p1[r]);
    { auto rr = __builtin_amdgcn_permlane32_swap(__float_as_uint(pmax), __float_as_uint(pmax), false, false);
      pmax = fmaxf(__uint_as_float(rr[0]), __uint_as_float(rr[1])); }
    if (__builtin_expect(__all(pmax - m_reg <= THR / SCALE), 1)) { mn = m_reg; alpha = 1.f; }
    else { mn = fmaxf(m_reg, pmax); alpha = __builtin_amdgcn_exp2f((m_reg - mn) * C); m_reg = mn; }
    const float mnC = -mn * C;
#pragma unroll
    for (int r = 0; r < 16; ++r) p0[r] = fmaf(p0[r], C, mnC);
#pragma unroll
    for (int r = 0; r < 16; ++r) p1[r] = fmaf(p1[r], C, mnC);
#pragma unroll
    for (int r = 0; r < 16; ++r) p0[r] = __builtin_amdgcn_exp2f(p0[r]);
  } else {
    constexpr float C = (MODE == 1 ? 0.088388347648318440f : 0.125f) * LOG2E, THR2 = 8.f * LOG2E;
    bool nearT = true; float cfar = 0.f;
    if constexpr (MODE >= 2) {
      if (relw_max <= -128) { nearT = false; cfar = lut[0]; }
      else if (relw_min >= 128) { nearT = false; cfar = lut[258]; }
      if (!nearT) {
        float pmax = p0[0];
#pragma unroll
        for (int r = 1; r < 16; ++r) pmax = fmaxf(pmax, p0[r]);
#pragma unroll
        for (int r = 0; r < 16; ++r) pmax = fmaxf(pmax, p1[r]);
        { auto rr = __builtin_amdgcn_permlane32_swap(__float_as_uint(pmax), __float_as_uint(pmax), false, false);
          pmax = fmaxf(__uint_as_float(rr[0]), __uint_as_float(rr[1])); }
        const float tmax = fmaf(pmax, C, cfar);
        if (__builtin_expect(__all(tmax - m_reg <= THR2), 1)) { mn = m_reg; alpha = 1.f; }
        else { mn = fmaxf(m_reg, tmax); alpha = __builtin_amdgcn_exp2f(m_reg - mn); m_reg = mn; }
        const float off = cfar - mn;
#pragma unroll
        for (int r = 0; r < 16; ++r) p0[r] = fmaf(p0[r], C, off);
#pragma unroll
        for (int r = 0; r < 16; ++r) p1[r] = fmaf(p1[r], C, off);
#pragma unroll
        for (int r = 0; r < 16; ++r) p0[r] = __builtin_amdgcn_exp2f(p0[r]);
        return;
      }
    }
    if (nearT) {
#pragma unroll
      for (int r = 0; r < 16; ++r) { const int i0 = relh + (r & 3) + 8 * (r >> 2);
        const int a0 = min(max(i0, -129), 129) + 129, a1 = min(max(i0 + 32, -129), 129) + 129;
        p0[r] = fmaf(p0[r], C, lut[a0]); p1[r] = fmaf(p1[r], C, lut[a1]); }
    } else {
#pragma unroll
      for (int r = 0; r < 16; ++r) { p0[r] = fmaf(p0[r], C, cfar); p1[r] = fmaf(p1[r], C, cfar); }
    }
    float pmax = p0[0];
#pragma unroll
    for (int r = 1; r < 16; ++r) pmax = fmaxf(pmax, p0[r]);
#pragma unroll
    for (int r = 0; r < 16; ++r) pmax = fmaxf(pmax, p1[r]);
    { auto rr = __builtin_amdgcn_permlane32_swap(__float_as_uint(pmax), __float_as_uint(pmax), false, false);
      pmax = fmaxf(__uint_as_float(rr[0]), __uint_as_float(rr[1])); }
    if (__builtin_expect(__all(pmax - m_reg <= THR2), 1)) { mn = m_reg; alpha = 1.f; }
    else { mn = fmaxf(m_reg, pmax); alpha = __builtin_amdgcn_exp2f(m_reg - mn); m_reg = mn; }
#pragma unroll
    for (int r = 0; r < 16; ++r) p0[r] = __builtin_amdgcn_exp2f(p0[r] - mn);
#pragma unroll
    for (int r = 0; r < 16; ++r) p1[r] = p1[r] - mn;
  }
}
__device__ __forceinline__ void finishSM(f32x16& p0, f32x16& p1, float alpha, float& l_reg, bf16x8& pa0, bf16x8& pa1, bf16x8& pa2, bf16x8& pa3) {
#pragma unroll
  for (int r = 0; r < 16; ++r) p1[r] = __builtin_amdgcn_exp2f(p1[r]);
  float ps = 0;
#pragma unroll
  for (int r = 0; r < 16; ++r) ps += p0[r];
#pragma unroll
  for (int r = 0; r < 16; ++r) ps += p1[r];
  { auto rr = __builtin_amdgcn_permlane32_swap(__float_as_uint(ps), __float_as_uint(ps), false, false);
    ps = __uint_as_float(rr[0]) + __uint_as_float(rr[1]); }
  l_reg = l_reg * alpha + ps;
#define PK4(P, BASE, OUT) do { unsigned a0 = cvtpk(P[BASE + 0], P[BASE + 1]), a1 = cvtpk(P[BASE + 2], P[BASE + 3]);   \
    unsigned b0 = cvtpk(P[BASE + 4], P[BASE + 5]), b1 = cvtpk(P[BASE + 6], P[BASE + 7]);                              \
    auto r0 = __builtin_amdgcn_permlane32_swap(a0, b0, false, false); auto r1 = __builtin_amdgcn_permlane32_swap(a1, b1, false, false); \
    u32x4 w = {r0[0], r1[0], r0[1], r1[1]}; OUT = *reinterpret_cast<bf16x8*>(&w); } while (0)
  PK4(p0, 0, pa0); PK4(p0, 8, pa1); PK4(p1, 0, pa2); PK4(p1, 8, pa3);
#undef PK4
}
template <int ND0, int DOFF>
__device__ __forceinline__ void qkt(f32x16& p0, f32x16& p1, const char* Ks, const bf16x8* qr, int r32, int hi) {
  p0 = f32x16{}; p1 = f32x16{};
#pragma unroll
  for (int d0 = 0; d0 < ND0; ++d0) { const int cb = ((d0 + DOFF) * 16 + hi * 8) * 2;
    bf16x8 b0 = *reinterpret_cast<const bf16x8*>(Ks + KSWZ(r32, cb));
    bf16x8 b1 = *reinterpret_cast<const bf16x8*>(Ks + KSWZ(32 + r32, cb));
    p0 = __builtin_amdgcn_mfma_f32_32x32x16_bf16(b0, qr[d0], p0, 0, 0, 0);
    p1 = __builtin_amdgcn_mfma_f32_32x32x16_bf16(b1, qr[d0], p1, 0, 0, 0); }
}
__device__ __forceinline__ int v_st(int k, int c) { const int kk = (k & ~0xC) | ((k & 4) << 1) | ((k & 8) >> 1); return ((kk >> 3) * 4 + (c >> 5)) * 512 + ((kk & 7) * 32 + (c & 31)) * 2; }
__device__ __forceinline__ int v_rd_base(int lane) { return ((lane & 3) << 3) | (((lane >> 2) & 3) << 6) | (((lane >> 4) & 1) << 5) | (((lane >> 5) & 1) << 8); }
constexpr int v_rd_off(int d0, int ks, int half) { return d0 * 512 + ks * 4096 + half * 2048; }
template <int OFF> __device__ __forceinline__ s16x4 tr_read(int vb) {
  s16x4 r; asm volatile("ds_read_b64_tr_b16 %0, %1 offset:%2" : "=&v"(r) : "v"(vb), "i"(OFF) : "memory"); return r;
}
template <int D0> __device__ __forceinline__ void pv_one(f32x16& od, int vb, bf16x8 pa0, bf16x8 pa1, bf16x8 pa2, bf16x8 pa3) {
  const s16x4 l0 = tr_read<v_rd_off(D0, 0, 0)>(vb), h0 = tr_read<v_rd_off(D0, 0, 1)>(vb), l1 = tr_read<v_rd_off(D0, 1, 0)>(vb), h1 = tr_read<v_rd_off(D0, 1, 1)>(vb);
  const s16x4 l2 = tr_read<v_rd_off(D0, 2, 0)>(vb), h2 = tr_read<v_rd_off(D0, 2, 1)>(vb), l3 = tr_read<v_rd_off(D0, 3, 0)>(vb), h3 = tr_read<v_rd_off(D0, 3, 1)>(vb);
  asm volatile("s_waitcnt lgkmcnt(0)" ::: "memory"); SBAR();
#define PK(L, H) (bf16x8){L[0], L[1], L[2], L[3], H[0], H[1], H[2], H[3]}
  od = __builtin_amdgcn_mfma_f32_32x32x16_bf16(pa0, PK(l0, h0), od, 0, 0, 0);
  od = __builtin_amdgcn_mfma_f32_32x32x16_bf16(pa1, PK(l1, h1), od, 0, 0, 0);
  od = __builtin_amdgcn_mfma_f32_32x32x16_bf16(pa2, PK(l2, h2), od, 0, 0, 0);
  od = __builtin_amdgcn_mfma_f32_32x32x16_bf16(pa3, PK(l3, h3), od, 0, 0, 0);
#undef PK
}
__device__ __forceinline__ void pv_d0(f32x16* o, int vb, bf16x8 pa0, bf16x8 pa1, bf16x8 pa2, bf16x8 pa3) {
  pv_one<0>(o[0], vb, pa0, pa1, pa2, pa3); pv_one<1>(o[1], vb, pa0, pa1, pa2, pa3); pv_one<2>(o[2], vb, pa0, pa1, pa2, pa3); pv_one<3>(o[3], vb, pa0, pa1, pa2, pa3);
}

struct AttnEpi {
  const bf16_t* gate;
  float* park;
  bf16_t* merged;
  const float* gsub;
  float lam, oml;
  float sinkl2;
  const float* gq;
};

template <int MODE>
__device__ __forceinline__ void attn_body(const bf16_t* __restrict__ Qb, const bf16_t* __restrict__ Kh, const bf16_t* __restrict__ Vh, int NT, int krel0,
                                          char* lds, const float* __restrict__ lutg, const AttnEpi& E) {
  constexpr int ND0 = (MODE < 2) ? 8 : 4, DOFF = (MODE == 3) ? 4 : 0;
  int tid_ = threadIdx.x; asm volatile("" : "+v"(tid_));
  const int tid = tid_, wid = tid >> 6, lane = tid & 63, r32 = lane & 31, hi = lane >> 5;
  char* V_lds = lds; char* K_lds = lds + ATT_NBUF * SHM_V;
  float* wsm = (float*)(lds + ATT_WS_OFF) + wid * 64; float* li_l = wsm; float* al_l = wsm + 32;
  float* lut = (float*)(lds + ATT_LUT_OFF);
  __syncthreads();
  if constexpr (MODE != 0) { if (tid < 259) lut[tid] = lutg[tid]; }
  float m_reg = -1e30f, l_reg = 0; f32x16 o[4] = {}; bf16x8 qr[ND0];
  const bf16_t* Qw = Qb + (size_t)(wid * 32 + r32) * LDQK + hi * 8;
  {
    float qf[ND0][8]; float ss = 0.f;
#pragma unroll
    for (int d0 = 0; d0 < ND0; ++d0) { const bf16x8 raw = *reinterpret_cast<const bf16x8*>(Qw + d0 * 16);
#pragma unroll
      for (int j = 0; j < 8; ++j) { const float v = __uint_as_float(((unsigned)(unsigned short)raw[j]) << 16); qf[d0][j] = v; ss += v * v; } }
    { auto rr = __builtin_amdgcn_permlane32_swap(__float_as_uint(ss), __float_as_uint(ss), false, false);
      ss = __uint_as_float(rr[0]) + __uint_as_float(rr[1]); }
    const float rs = rsqrtf(ss * (MODE < 2 ? (1.f / 128.f) : (1.f / 64.f)) + EPS);
#pragma unroll
    for (int d0 = 0; d0 < ND0; ++d0) { const f32x4 g0 = *(const f32x4*)(E.gq + d0 * 16 + hi * 8), g1 = *(const f32x4*)(E.gq + d0 * 16 + hi * 8 + 4);
#pragma unroll
      for (int j = 0; j < 4; ++j) { qf[d0][j] = qf[d0][j] * rs * g0[j]; qf[d0][4 + j] = qf[d0][4 + j] * rs * g1[j]; } }
    if constexpr (MODE == 0) {
      const int sp = krel0 + wid * 32 + r32;
#pragma unroll
      for (int h = 0; h < 2; ++h) { const int pos = h == 0 ? (sp >> 6) : (sp & 63);
#pragma unroll
        for (int a = 0; a < 2; ++a) { const float* tb = lutg + (size_t)(pos * 32 + a * 16 + hi * 8) * 2;
#pragma unroll
          for (int jj = 0; jj < 4; ++jj) { const f32x4 cs = *(const f32x4*)(tb + jj * 4);
#pragma unroll
            for (int e = 0; e < 2; ++e) { const int j = 2 * jj + e; const float c = cs[2 * e], sn = cs[2 * e + 1];
              const float x1 = qf[4 * h + a][j], x2 = qf[4 * h + 2 + a][j];
              qf[4 * h + a][j] = x1 * c - x2 * sn; qf[4 * h + 2 + a][j] = x2 * c + x1 * sn; } } } }
    }
#pragma unroll
    for (int d0 = 0; d0 < ND0; ++d0) { u32x4 w; w.x = cvtpk(qf[d0][0], qf[d0][1]); w.y = cvtpk(qf[d0][2], qf[d0][3]); w.z = cvtpk(qf[d0][4], qf[d0][5]); w.w = cvtpk(qf[d0][6], qf[d0][7]);
      qr[d0] = *reinterpret_cast<bf16x8*>(&w); }
  }
  const int sr = tid >> 4, sc = (tid & 15) * 8, vst0 = v_st(sr, sc), vst1 = v_st(32 + sr, sc);
  const int vb0 = (int)(uintptr_t)V_lds + v_rd_base(lane);
  struct { bf16x8 vs0, vs1, ks0, ks1; } sr_[2];
#define SLOAD(i, k0) do { sr_[i].vs0 = *reinterpret_cast<const bf16x8*>(&Vh[(size_t)((k0) + sr) * LDQK + sc]); sr_[i].vs1 = *reinterpret_cast<const bf16x8*>(&Vh[(size_t)((k0) + 32 + sr) * LDQK + sc]); \
    sr_[i].ks0 = *reinterpret_cast<const bf16x8*>(&Kh[(size_t)((k0) + sr) * LDQK + sc]); sr_[i].ks1 = *reinterpret_cast<const bf16x8*>(&Kh[(size_t)((k0) + 32 + sr) * LDQK + sc]); } while (0)
#define SWRITE(off, i) do { *(bf16x8*)(V_lds + (off) + vst0) = sr_[i].vs0;          \
    *(bf16x8*)(V_lds + (off) + vst1) = sr_[i].vs1; int kc = sc * 2;               \
    *(bf16x8*)(K_lds + (off) + KSWZ(sr, kc)) = sr_[i].ks0;                       \
    *(bf16x8*)(K_lds + (off) + KSWZ(32 + sr, kc)) = sr_[i].ks1; } while (0)
#define SWAIT() asm volatile("s_waitcnt vmcnt(4)" ::: "memory")
#define RESC(a) do { if (__any((a) < 1.f)) { if (hi == 0) al_l[r32] = (a); asm volatile("s_waitcnt lgkmcnt(0)" ::: "memory"); \
    _Pragma("unroll") for (int d = 0; d < 4; ++d) _Pragma("unroll") for (int r = 0; r < 16; ++r) o[d][r] *= al_l[crow(r, hi)]; } } while (0)
  const int relq = krel0 - (wid * 32 + r32) + 4 * hi, relwmin = krel0 - (wid * 32 + 31), relwmax = krel0 + 63 - wid * 32;
#define PSM(P0, P1, MN, AL, J) partialSM<MODE>(P0, P1, m_reg, MN, AL, relq + 64 * (J), relwmin + 64 * (J), relwmax + 64 * (J), lut)
  f32x16 pA0, pA1, pB0, pB1; float mnA, mnB, alA, alB; bf16x8 pa0, pa1, pa2, pa3;
  constexpr int SE = 0, SO = 1;
  SLOAD(SE, 0); SLOAD(SO, 64); asm volatile("s_waitcnt vmcnt(4)" ::: "memory"); SWRITE(0, SE); __syncthreads();
  qkt<ND0, DOFF>(pA0, pA1, K_lds, qr, r32, hi); PSM(pA0, pA1, mnA, alA, 0);
  if (2 < NT) SLOAD(SE, 2 * 64);
  SWAIT(); SWRITE(SHM_V, SO);
  int op = 0, oq = SHM_V, ow = 2 * SHM_V;
  for (int j = 1; j + 1 < NT; j += 2) {
    __syncthreads();
    SBAR(); qkt<ND0, DOFF>(pB0, pB1, K_lds + oq, qr, r32, hi);
    finishSM(pA0, pA1, alA, l_reg, pa0, pa1, pa2, pa3); SBAR();
    SLOAD(SO, (j + 2) * 64); SBAR();
    pv_d0(o, vb0 + op, pa0, pa1, pa2, pa3); PSM(pB0, pB1, mnB, alB, j);
    SWAIT(); SWRITE(ow, SE);
    RESC(alB);
    { const int t = op; op = oq; oq = ow; ow = t; }
    __syncthreads();
    SBAR(); qkt<ND0, DOFF>(pA0, pA1, K_lds + oq, qr, r32, hi);
    finishSM(pB0, pB1, alB, l_reg, pa0, pa1, pa2, pa3); SBAR();
    if (j + 3 < NT) SLOAD(SE, (j + 3) * 64); SBAR();
    pv_d0(o, vb0 + op, pa0, pa1, pa2, pa3); PSM(pA0, pA1, mnA, alA, j + 1);
    SWAIT(); SWRITE(ow, SO);
    RESC(alA);
    { const int t = op; op = oq; oq = ow; ow = t; }
  }
  __syncthreads();
  SBAR(); qkt<ND0, DOFF>(pB0, pB1, K_lds + oq, qr, r32, hi);
  finishSM(pA0, pA1, alA, l_reg, pa0, pa1, pa2, pa3); SBAR();
  pv_d0(o, vb0 + op, pa0, pa1, pa2, pa3); PSM(pB0, pB1, mnB, alB, NT - 1);
  RESC(alB);
  finishSM(pB0, pB1, alB, l_reg, pa0, pa1, pa2, pa3); SBAR();
  pv_d0(o, vb0 + oq, pa0, pa1, pa2, pa3);
  if constexpr (MODE == 1) l_reg += __builtin_amdgcn_exp2f(E.sinkl2 - m_reg);
  if (hi == 0) li_l[r32] = l_reg; asm volatile("s_waitcnt lgkmcnt(0)" ::: "memory");
  float rli[16];
#pragma unroll
  for (int r = 0; r < 16; ++r) rli[r] = __builtin_amdgcn_rcpf(li_l[crow(r, hi)]);
  float* pk0 = E.park; float* pk1 = E.park + 64 * 512;
  const int rowb = wid * 32;
  if constexpr (MODE == 0 || MODE == 1) {
#pragma unroll
    for (int r = 0; r < 16; ++r) { const int row = rowb + crow(r, hi);
#pragma unroll
      for (int d0 = 0; d0 < 4; ++d0) { const int idx = (d0 * 16 + r) * 512 + tid;
        const float g = bf2f(E.gate[(size_t)row * GW + d0 * 32 + r32]);
        const float v = o[d0][r] * rli[r] * g;
        if constexpr (MODE == 0) pk0[idx] = v; else pk0[idx] += v; } }
  } else if constexpr (MODE == 2) {
#pragma unroll
    for (int r = 0; r < 16; ++r)
#pragma unroll
      for (int d0 = 0; d0 < 4; ++d0) pk1[(d0 * 16 + r) * 512 + tid] = o[d0][r] * rli[r];
  } else {
    float gs[4];
#pragma unroll
    for (int d0 = 0; d0 < 4; ++d0) gs[d0] = E.gsub[d0 * 32 + r32] * E.oml;
#pragma unroll
    for (int r = 0; r < 16; ++r) { const int row = rowb + crow(r, hi);
      float ss = 0.f;
#pragma unroll
      for (int d0 = 0; d0 < 4; ++d0) { const float c = pk1[(d0 * 16 + r) * 512 + tid] - E.lam * (o[d0][r] * rli[r]); o[d0][r] = c; ss += c * c; }
      ss += __shfl_xor(ss, 1); ss += __shfl_xor(ss, 2); ss += __shfl_xor(ss, 4); ss += __shfl_xor(ss, 8); ss += __shfl_xor(ss, 16);
      const float rs = rsqrtf(ss * (1.f / 128.f) + EPS);
#pragma unroll
      for (int d0 = 0; d0 < 4; ++d0) { const int col = d0 * 32 + r32;
        const float g = bf2f(E.gate[(size_t)row * GW + col]);
        const float y = o[d0][r] * rs * gs[d0] * g + pk0[(d0 * 16 + r) * 512 + tid];
        E.merged[(size_t)row * DM + col] = (bf16_t)(cvtpk(y, y) & 0xffffu); } }
  }
#undef SLOAD
#undef SWRITE
#undef SWAIT
#undef RESC
#undef PSM
}

__device__ __forceinline__ int t5bucket(int rel) {
  const int n = rel < 0 ? -rel : rel;
  const int b = n < 8 ? n : 8 + (n >= 12) + (n >= 16) + (n >= 23) + (n >= 32) + (n >= 46) + (n >= 64) + (n >= 91);
  return b + (rel > 0 ? 16 : 0);
}
__device__ __forceinline__ float wave_sum(float v) {
  v += __shfl_xor(v, 1); v += __shfl_xor(v, 2); v += __shfl_xor(v, 4); v += __shfl_xor(v, 8); v += __shfl_xor(v, 16); v += __shfl_xor(v, 32); return v;
}

__device__ __forceinline__ void phase_setup(const Params& p, unsigned char* shm) {
  int tid_ = threadIdx.x; asm volatile("" : "+v"(tid_)); const int tid = tid_, nb = gridDim.x, bid = blockIdx.x, wid = tid >> 6, lane = tid & 63;
  if (bid == 0) { unsigned* xbar = (unsigned*)(p.ws + WS_BAR); for (int i = tid; i < 16384; i += 512) xbar[i] = 0u; }
  {
    const float4* s0 = (const float4*)p.in[0]; const float4* s1 = (const float4*)p.in[1]; float4* o = (float4*)p.out;
    const size_t n4 = (size_t)16384 * 1024 / 4;
    for (size_t i = (size_t)bid * 512 + tid; i < 2 * n4; i += (size_t)nb * 512) o[i] = i < n4 ? s0[i] : s1[i - n4];
  }
  {
    float* rope = (float*)(p.ws + WS_ROPE);
    for (int i = bid * 512 + tid; i < 256 * 32; i += nb * 512) { const int pos = i >> 5, f = i & 31;
      const float inv = powf(10000.f, -(float)f / 32.f); const float ang = (float)pos * inv; rope[2 * i] = cosf(ang); rope[2 * i + 1] = sinf(ang); }
    float* lut = (float*)(p.ws + WS_LUT);
    for (int i = bid * 512 + tid; i < 16 * 259; i += nb * 512) { const int hh = i / 259, e = i % 259; int rel = e - 129; float v;
      if (hh < 8) { v = (rel < -128 || rel > 128) ? NEGBIG : p.in[23][t5bucket(rel) * 16 + hh] * LOG2E; }
      else { rel = rel < -128 ? -128 : (rel > 128 ? 128 : rel); v = p.in[23][t5bucket(rel) * 16 + hh] * LOG2E; }
      lut[i] = v; }
    if (bid == 0 && tid < 4) { const int l = tid; float s1 = 0.f, s2 = 0.f;
      for (int i = 0; i < 64; ++i) { s1 += p.in[18][l * 64 + i] * p.in[19][l * 64 + i]; s2 += p.in[20][l * 64 + i] * p.in[21][l * 64 + i]; }
      const float lam_init = 0.8f - 0.6f * expf(-0.3f * (float)l);
      float* lam = (float*)(p.ws + WS_LAM); lam[2 * l] = expf(s1) - expf(s2) + lam_init; lam[2 * l + 1] = 1.f - lam_init; }
  }
  {
    float* sc = (float*)shm; float* red = sc + 9 * 1024;
    for (int i = tid; i < 9 * 1024; i += 512) { const float c = i < 8192 ? p.in[2][i] : p.in[3][i - 8192]; sc[i] = c / (1.f + expf(-c)); }
    __syncthreads();
    float* mod = (float*)(p.ws + WS_MOD);
    for (int task = bid; task < 144; task += nb) {
      const int l = task / 36, j0 = (task % 36) * 256;
      const f32x4* w = (const f32x4*)(p.in[4] + (size_t)l * 1024 * 9216 + j0) + lane;
      f32x4 a0 = {0.f, 0.f, 0.f, 0.f}, a1 = a0, a2 = a0, a3 = a0, a4 = a0, a5 = a0, a6 = a0, a7 = a0, a8 = a0;
#pragma unroll 8
      for (int k = wid * 128; k < wid * 128 + 128; ++k) { const f32x4 wv = w[(size_t)k * 2304];
        a0 += sc[k] * wv; a1 += sc[1024 + k] * wv; a2 += sc[2048 + k] * wv; a3 += sc[3072 + k] * wv; a4 += sc[4096 + k] * wv;
        a5 += sc[5120 + k] * wv; a6 += sc[6144 + k] * wv; a7 += sc[7168 + k] * wv; a8 += sc[8192 + k] * wv; }
      f32x4* rw = (f32x4*)(red + wid * 9 * 256) + lane;
      rw[0] = a0; rw[64] = a1; rw[128] = a2; rw[192] = a3; rw[256] = a4; rw[320] = a5; rw[384] = a6; rw[448] = a7; rw[512] = a8;
      __syncthreads();
      for (int i = tid; i < 9 * 256; i += 512) { const int b = i >> 8, cc = i & 255; float s_ = 0.f;
#pragma unroll
        for (int w8 = 0; w8 < 8; ++w8) s_ += red[w8 * 9 * 256 + b * 256 + cc];
        mod[((size_t)l * 9 + b) * 9216 + j0 + cc] = s_ + p.in[5][l * 9216 + j0 + cc]; }
      __syncthreads();
    }
  }
}

__device__ __forceinline__ void phase_convert(const Params& p, int l, unsigned char* shm) {
  float* tile = (float*)shm;
  int tid_ = threadIdx.x; asm volatile("" : "+v"(tid_)); const int tid = tid_;
  for (int q = blockIdx.x; q < 6400; q += gridDim.x) {
    const float* W; bf16_t* Bt; int N, K, k0, n0d, n0s;
    if (q < 2816) { const int i = q / 1408, qq = q % 1408; W = p.in[7] + (size_t)(l * 2 + i) * 1024 * 5632; Bt = (bf16_t*)(p.ws + (i ? WB_FFIN1 : WB_FFIN0)); N = 5632; K = 1024;
      k0 = (qq & 15) * 64; n0d = (qq >> 4) * 64; n0s = ((n0d >> 7) & 1) * 2816 + (n0d >> 8) * 128 + (n0d & 127); }
    else if (q < 4224) { const int i = (q - 2816) / 704, qq = (q - 2816) % 704; W = p.in[8] + (size_t)(l * 2 + i) * 2816 * 1024; Bt = (bf16_t*)(p.ws + (i ? WB_FFOUT1 : WB_FFOUT0)); N = 1024; K = 2816;
      k0 = (qq % 44) * 64; n0d = (qq / 44) * 64; n0s = n0d; }
    else if (q < 6144) { const int qq = q - 4224; W = p.in[9] + (size_t)l * 1024 * 7680; Bt = (bf16_t*)(p.ws + WB_WIN); N = 7680; K = 1024;
      k0 = (qq & 15) * 64; n0d = (qq >> 4) * 64; n0s = n0d; }
    else { const int qq = q - 6144; W = p.in[10] + (size_t)l * 1024 * 1024; Bt = (bf16_t*)(p.ws + WB_WO); N = 1024; K = 1024;
      k0 = (qq & 15) * 64; n0d = (qq >> 4) * 64; n0s = n0d; }
    { const int nl = tid & 63, ks = tid >> 6;
#pragma unroll
      for (int i = 0; i < 8; ++i) { const int k = ks + 8 * i; tile[nl * 65 + k] = W[(size_t)(k0 + k) * N + n0s + nl]; } }
    __syncthreads();
    { const int n = tid >> 3, kc = (tid & 7) * 8; const float* tr = tile + n * 65 + kc;
      u32x4 w; w.x = cvtpk(tr[0], tr[1]); w.y = cvtpk(tr[2], tr[3]); w.z = cvtpk(tr[4], tr[5]); w.w = cvtpk(tr[6], tr[7]);
      *(u32x4*)(Bt + (size_t)(n0d + n) * K + k0 + kc) = w; }
    __syncthreads();
  }
}

__device__ __forceinline__ void phase_norm(const float* __restrict__ x, const float* __restrict__ g, const float* __restrict__ modl, int jj, bf16_t* __restrict__ xn) {
  int tid_ = threadIdx.x; asm volatile("" : "+v"(tid_)); const int tid = tid_, wid = tid >> 6, lane = tid & 63;
  for (int row = (blockIdx.x * 8 + wid) * 2; row < T_TOK; row += gridDim.x * 16) {
    const int bi = row < 16384 ? (row >> 11) : 8;
    const float* shift = modl + (size_t)bi * 9216 + (3 * jj) * 1024; const float* scale = shift + 1024;
    const float4* xr = (const float4*)(x + (size_t)row * DM);
    float4 v[8]; float ss0 = 0.f, ss1 = 0.f;
#pragma unroll
    for (int i = 0; i < 8; ++i) v[i] = xr[lane + 64 * i];
#pragma unroll
    for (int i = 0; i < 4; ++i) { ss0 += v[i].x * v[i].x + v[i].y * v[i].y + v[i].z * v[i].z + v[i].w * v[i].w;
      ss1 += v[4 + i].x * v[4 + i].x + v[4 + i].y * v[4 + i].y + v[4 + i].z * v[4 + i].z + v[4 + i].w * v[4 + i].w; }
    ss0 = wave_sum(ss0); ss1 = wave_sum(ss1);
    const float rs0 = rsqrtf(ss0 * (1.f / 1024.f) + EPS), rs1 = rsqrtf(ss1 * (1.f / 1024.f) + EPS);
#pragma unroll
    for (int i = 0; i < 4; ++i) { const int c4 = lane + 64 * i;
      const float4 gg = ((const float4*)g)[c4], sc = ((const float4*)scale)[c4], sh = ((const float4*)shift)[c4];
      const float m0 = gg.x * (1.f + sc.x), m1 = gg.y * (1.f + sc.y), m2 = gg.z * (1.f + sc.z), m3 = gg.w * (1.f + sc.w);
      u32x2 w; w.x = cvtpk(v[i].x * rs0 * m0 + sh.x, v[i].y * rs0 * m1 + sh.y); w.y = cvtpk(v[i].z * rs0 * m2 + sh.z, v[i].w * rs0 * m3 + sh.w);
      *(u32x2*)(xn + (size_t)row * DM + c4 * 4) = w;
      u32x2 w2; w2.x = cvtpk(v[4 + i].x * rs1 * m0 + sh.x, v[4 + i].y * rs1 * m1 + sh.y); w2.y = cvtpk(v[4 + i].z * rs1 * m2 + sh.z, v[4 + i].w * rs1 * m3 + sh.w);
      *(u32x2*)(xn + (size_t)(row + 1) * DM + c4 * 4) = w2; }
  }
}

__device__ __forceinline__ void phase_qknorm(const Params& p, int l) {
  bf16_t* qkv = (bf16_t*)(p.ws + WS_QKV); const float* rope = (const float*)(p.ws + WS_ROPE);
  int tid_ = threadIdx.x; asm volatile("" : "+v"(tid_)); const int tid = tid_, wid = tid >> 6, lane = tid & 63;
  f32x2 gk[3];
  gk[0] = *(const f32x2*)(p.in[12] + l * 128 + 2 * lane); gk[1] = *(const f32x2*)(p.in[14] + l * 128 + 2 * lane);
  gk[2] = *(const f32x2*)(p.in[16] + l * 64 + ((2 * lane) & 63));
  const float sg = (lane & 16) ? 1.f : -1.f;
  for (int tok0 = (blockIdx.x * 8 + wid) * 4; tok0 < T_TOK; tok0 += gridDim.x * 32) {
    unsigned u[4][6];
#pragma unroll
    for (int t = 0; t < 4; ++t)
#pragma unroll
      for (int s = 0; s < 6; ++s) u[t][s] = ((const unsigned*)(qkv + (size_t)(tok0 + t) * QKVW + (s >> 1) * 1536 + 1024 + (s & 1) * 128))[lane];
#pragma unroll
    for (int t = 0; t < 4; ++t) { const int tok = tok0 + t;
      const int sp = tok < 16384 ? (tok & 2047) : (tok - 16384);
      const int pos = lane < 32 ? (sp >> 6) : (sp & 63);
      const f32x4 cs = *(const f32x4*)(rope + (size_t)(pos * 32 + ((2 * lane) & 31)) * 2);
#pragma unroll
      for (int s = 0; s < 6; ++s) { const int br = s >> 1;
        float a = bf_lo(u[t][s]), b = bf_hi(u[t][s]);
        float ss = a * a + b * b;
        ss += __shfl_xor(ss, 1); ss += __shfl_xor(ss, 2); ss += __shfl_xor(ss, 4); ss += __shfl_xor(ss, 8); ss += __shfl_xor(ss, 16);
        float rs;
        if (br < 2) { ss += __shfl_xor(ss, 32); rs = rsqrtf(ss * (1.f / 128.f) + EPS); }
        else rs = rsqrtf(ss * (1.f / 64.f) + EPS);
        a = a * rs * gk[br][0]; b = b * rs * gk[br][1];
        if (br == 0) { const float pa = __shfl_xor(a, 16), pb = __shfl_xor(b, 16);
          a = a * cs[0] + sg * pa * cs[1]; b = b * cs[2] + sg * pb * cs[3]; }
        ((unsigned*)(qkv + (size_t)tok * QKVW + br * 1536 + 1024 + (s & 1) * 128))[lane] = cvtpk(a, b); } }
  }
}

__device__ __forceinline__ void phase_attn(const Params& p, int l, unsigned char* shm) {
  const bf16_t* qkv = (const bf16_t*)(p.ws + WS_QKV); const bf16_t* gates = (const bf16_t*)(p.ws + WS_GATES);
  bf16_t* merged = (bf16_t*)(p.ws + WS_XN);
  const float* lutall = (const float*)(p.ws + WS_LUT); const float* lamp = (const float*)(p.ws + WS_LAM);
  AttnEpi E; E.park = (float*)(p.ws + WS_PARK) + (size_t)blockIdx.x * 65536; E.gsub = p.in[22] + l * 128; E.lam = lamp[2 * l]; E.oml = lamp[2 * l + 1];
  for (int it = blockIdx.x; it < 1024; it += gridDim.x) {
    int S, tok0, h, qb;
    if (it < 512) { S = 16384; tok0 = 16384; h = it & 7; qb = it >> 3; }
    else { const int j = it - 512; S = 2048; h = j & 7; qb = (j >> 3) & 7; tok0 = (j >> 6) * 2048; }
    const int g = h >> 2, q0 = qb * 256;
    const bf16_t* rowQ = qkv + (size_t)(tok0 + q0) * QKVW; const bf16_t* seqK = qkv + (size_t)tok0 * QKVW;
    const bf16_t* grow = gates + (size_t)(tok0 + q0) * GW + h * 128;
    E.merged = merged + (size_t)(tok0 + q0) * DM + h * 128; E.sinkl2 = p.in[17][l * 8 + h] * LOG2E;
    E.gate = grow; E.gq = p.in[11] + l * 128;
    attn_body<0>(rowQ + h * 128, seqK + 1024 + g * 128, seqK + 1280 + g * 128, S / 64, q0, (char*)shm, (const float*)(p.ws + WS_ROPE), E);
    { const int t_lo = max(0, 4 * qb - 2), t_hi = min(S / 64, 4 * qb + 6);
      const bf16_t* kb = seqK + (size_t)t_lo * 64 * QKVW;
      E.gate = grow + 1024; E.gq = p.in[13] + l * 128;
      attn_body<1>(rowQ + 1536 + h * 128, kb + 2560 + g * 128, kb + 2816 + g * 128, t_hi - t_lo, t_lo * 64 - q0, (char*)shm, lutall + h * 259, E); }
    E.gate = grow + 2048; E.gq = p.in[15] + l * 64;
    attn_body<2>(rowQ + 3072 + h * 128, seqK + 4096 + g * 128, seqK + 4352 + g * 128, S / 64, -q0, (char*)shm, lutall + (8 + h) * 259, E);
    attn_body<3>(rowQ + 3072 + h * 128 + 64, seqK + 4096 + g * 128, seqK + 4352 + g * 128, S / 64, -q0, (char*)shm, lutall + (8 + h) * 259, E);
  }
}

__device__ __forceinline__ void gsync(cg::grid_group& g) {
  asm volatile("s_waitcnt vmcnt(0) lgkmcnt(0)" ::: "memory");
  g.sync();
  __builtin_amdgcn_fence(__ATOMIC_ACQUIRE, "agent");
  asm volatile("s_waitcnt vmcnt(0)" ::: "memory");
}
#define XB_TMO      128
#define XB_XCNT(j)  (256  + 64 * (j))
#define XB_XSUB(j)  (1280 + 64 * (j))
#define XB_XGEN(j)  (2304 + 64 * (j))
#define XB_TOP      3328
#define XB_TOPGEN   3392
#define XCD_BAR_WORDS 3456
#define XB_SPIN_CAP (1u << 22)
__device__ __forceinline__ unsigned xb_ld(unsigned* p)              { return __hip_atomic_load(p, __ATOMIC_RELAXED, __HIP_MEMORY_SCOPE_AGENT); }
__device__ __forceinline__ unsigned xb_add(unsigned* p, unsigned v) { return __hip_atomic_fetch_add(p, v, __ATOMIC_RELAXED, __HIP_MEMORY_SCOPE_AGENT); }
__device__ __forceinline__ unsigned xb_xcc_id() { return (unsigned)__builtin_amdgcn_s_getreg((3 << 11) | 20) & 0xFu; }
#define XB_SPIN(cond, bar) do { unsigned _sp = 0; while (cond) { __builtin_amdgcn_s_sleep(1); \
    if ((++_sp & 255u) == 0u) { if (xb_ld(&(bar)[XB_TMO])) break; if (_sp > XB_SPIN_CAP) { atomicAdd(&(bar)[XB_TMO], 1u); break; } } } } while (0)
struct XcdBarrier { unsigned* bar; unsigned x; volatile LAS unsigned* st; };
__device__ __forceinline__ XcdBarrier xcd_barrier_post(unsigned* bar, volatile LAS unsigned* st) {
    XcdBarrier b; b.bar = bar; b.x = xb_xcc_id(); b.st = st;
    if (threadIdx.x == 0) (void)xb_add(&bar[XB_XCNT(b.x)], 1u);
    return b;
}
__device__ __forceinline__ void xcd_barrier_complete(unsigned* bar, unsigned x, unsigned& nloc, unsigned& nx) {
    const unsigned G = gridDim.x * gridDim.y * gridDim.z;
    unsigned sum, cnt, mine, sp = 0u;
    for (;;) {
        sum = 0u; cnt = 0u; mine = 0u;
#pragma unroll
        for (unsigned j = 0; j < 16; ++j) { const unsigned c = xb_ld(&bar[XB_XCNT(j)]); sum += c; cnt += (c > 0u) ? 1u : 0u; mine = (j == x) ? c : mine; }
        if (sum == G) break;
        __builtin_amdgcn_s_sleep(1);
        if ((++sp & 255u) == 0u) { if (xb_ld(&bar[XB_TMO])) break; if (sp > XB_SPIN_CAP) { atomicAdd(&bar[XB_TMO], 1u); break; } }
    }
    nloc = mine > 0u ? mine : 1u; nx = cnt > 0u ? cnt : 1u;
}
__device__ __forceinline__ void xcd_barrier(const XcdBarrier& b) {
    asm volatile("s_waitcnt vmcnt(0)" ::: "memory");
    __syncthreads();
    if (threadIdx.x == 0) {
        unsigned* bar = b.bar;
        __builtin_amdgcn_s_waitcnt(0);
        unsigned nloc = b.st[0], nx = b.st[1];
        if (nloc == 0u) { xcd_barrier_complete(bar, b.x, nloc, nx); b.st[0] = nloc; b.st[1] = nx; }
        const unsigned old = xb_add(&bar[XB_XSUB(b.x)], 1u);
        const unsigned gen = old / nloc;
        if (old + 1u == (gen + 1u) * nloc) {
            __builtin_amdgcn_fence(__ATOMIC_RELEASE, "agent");
            asm volatile("s_waitcnt vmcnt(0)" ::: "memory");
            const unsigned og = xb_add(&bar[XB_TOP], 1u);
            const unsigned tg = og / nx;
            if (og + 1u == (tg + 1u) * nx) xb_add(&bar[XB_TOPGEN], 1u);
            else XB_SPIN(xb_ld(&bar[XB_TOPGEN]) == tg, bar);
            __builtin_amdgcn_fence(__ATOMIC_ACQUIRE, "agent");
            xb_add(&bar[XB_XGEN(b.x)], 1u);
            asm volatile("s_waitcnt vmcnt(0)" ::: "memory");
        } else {
            XB_SPIN(xb_ld(&bar[XB_XGEN(b.x)]) == gen, bar);
            __builtin_amdgcn_fence(__ATOMIC_ACQUIRE, "agent");
            asm volatile("s_waitcnt vmcnt(0)" ::: "memory");
        }
    }
    __syncthreads();
}

__device__ __forceinline__ void panel_norm_rows(const float* __restrict__ x, const float* __restrict__ g, const float* __restrict__ modl, int jj, bf16_t* __restrict__ xn, int row0) {
  int tid_ = threadIdx.x; asm volatile("" : "+v"(tid_)); const int tid = tid_, wid = tid >> 6, lane = tid & 63;
#pragma unroll 1
  for (int rr = 0; rr < 8; rr += 2) {
    const int row = row0 + wid * 8 + rr;
    const int bi = row < 16384 ? (row >> 11) : 8;
    const float* shift = modl + (size_t)bi * 9216 + (3 * jj) * 1024; const float* scale = shift + 1024;
    const float4* xr = (const float4*)(x + (size_t)row * DM);
    float4 v[8]; float ss0 = 0.f, ss1 = 0.f;
#pragma unroll
    for (int i = 0; i < 8; ++i) v[i] = xr[lane + 64 * i];
#pragma unroll
    for (int i = 0; i < 4; ++i) { ss0 += v[i].x * v[i].x + v[i].y * v[i].y + v[i].z * v[i].z + v[i].w * v[i].w;
      ss1 += v[4 + i].x * v[4 + i].x + v[4 + i].y * v[4 + i].y + v[4 + i].z * v[4 + i].z + v[4 + i].w * v[4 + i].w; }
    ss0 = wave_sum(ss0); ss1 = wave_sum(ss1);
    const float rs0 = rsqrtf(ss0 * (1.f / 1024.f) + EPS), rs1 = rsqrtf(ss1 * (1.f / 1024.f) + EPS);
#pragma unroll
    for (int i = 0; i < 4; ++i) { const int c4 = lane + 64 * i;
      const float4 gg = ((const float4*)g)[c4], sc = ((const float4*)scale)[c4], sh = ((const float4*)shift)[c4];
      const float m0 = gg.x * (1.f + sc.x), m1 = gg.y * (1.f + sc.y), m2 = gg.z * (1.f + sc.z), m3 = gg.w * (1.f + sc.w);
      u32x2 w; w.x = cvtpk(v[i].x * rs0 * m0 + sh.x, v[i].y * rs0 * m1 + sh.y); w.y = cvtpk(v[i].z * rs0 * m2 + sh.z, v[i].w * rs0 * m3 + sh.w);
      *(u32x2*)(xn + (size_t)row * DM + c4 * 4) = w;
      u32x2 w2; w2.x = cvtpk(v[4 + i].x * rs1 * m0 + sh.x, v[4 + i].y * rs1 * m1 + sh.y); w2.y = cvtpk(v[4 + i].z * rs1 * m2 + sh.z, v[4 + i].w * rs1 * m3 + sh.w);
      *(u32x2*)(xn + (size_t)(row + 1) * DM + c4 * 4) = w2; }
  }
}
__device__ __forceinline__ void panel_norm(const pg8::StaticOrder& S, unsigned* pcnt, unsigned epoch, const float* x, const float* g, const float* modl, int jj, bf16_t* xn) {
  asm volatile("s_waitcnt vmcnt(0)" ::: "memory");
  __syncthreads();
  if (threadIdx.x == 0) {
    __builtin_amdgcn_fence(__ATOMIC_RELEASE, "agent"); asm volatile("s_waitcnt vmcnt(0)" ::: "memory");
    pg8::Unit u;
    for (int i = 0; S.next(i, u); ++i) (void)xb_add(&pcnt[64 * u.pm], 1u);
    for (int i = 0; S.next(i, u); ++i) { unsigned sp = 0; while (xb_ld(&pcnt[64 * u.pm]) < 4u * epoch) { __builtin_amdgcn_s_sleep(1); if (++sp > (1u << 22)) break; } }
    __builtin_amdgcn_fence(__ATOMIC_ACQUIRE, "agent"); asm volatile("s_waitcnt vmcnt(0)" ::: "memory");
  }
  __syncthreads();
  pg8::Unit u;
  for (int i = 0; S.next(i, u); ++i) panel_norm_rows(x, g, modl, jj, xn, u.pm * 256 + u.pn * 64);
}

constexpr int N_PHASES = 45;
__global__ void __launch_bounds__(512) mega_fwd(Params p, int ph_lo, int ph_hi) {
  extern __shared__ __attribute__((aligned(16))) unsigned char shm[];
  cg::grid_group grid = cg::this_grid();
  LAS unsigned char* lds3 = (LAS unsigned char*)shm;
  float* X = p.out;
  bf16_t* XN = (bf16_t*)(p.ws + WS_XN); bf16_t* Hb = (bf16_t*)(p.ws + WS_QKV);
  pg8::StaticOrder S;
  volatile LAS unsigned* xst = (volatile LAS unsigned*)(lds3 + 131072);
  if (threadIdx.x == 0) { xst[0] = 0u; xst[1] = 0u; }
  unsigned* xbar = (unsigned*)(p.ws + WS_BAR);
  XcdBarrier xb; xb.bar = xbar; xb.x = 0u; xb.st = xst;
#pragma unroll 1
  for (int ph = ph_lo; ph < ph_hi; ++ph) {
    if (ph == 0) { phase_setup(p, shm); }
    else {
      const int l = (ph - 1) / 11, k = (ph - 1) % 11;
      const float* modl = (const float*)(p.ws + WS_MOD) + (size_t)l * 9 * 9216;
      if (k == 3 || k == 8) continue;
      if (k == 0) {
        phase_convert(p, l, shm);
        if (l == 0) phase_norm(X, p.in[6], modl, 0, XN);
      } else if (k == 1 || k == 9) {
        pg8::Gemm g{XN, (const bf16_t*)(p.ws + (k == 9 ? WB_FFIN1 : WB_FFIN0)), T_TOK, NFF2, DM};
        S.init(T_TOK, NFF2, gridDim.x, blockIdx.x); pg8::EpiSwiGLU E{Hb}; pg8::gemm_phase(lds3, g, S, E);
      } else if (k == 2 || k == 10 || k == 7) {
        const bool wo = (k == 7);
        pg8::Gemm g{wo ? XN : Hb, (const bf16_t*)(p.ws + (wo ? WB_WO : (k == 10 ? WB_FFOUT1 : WB_FFOUT0))), T_TOK, DM, wo ? DM : DFF};
        S.init(T_TOK, DM, gridDim.x, blockIdx.x); pg8::EpiResid E{X, modl + (wo ? 5 : (k == 10 ? 8 : 2)) * 1024, wo ? 1.0f : 0.5f}; pg8::gemm_phase(lds3, g, S, E);
        const unsigned epoch = (unsigned)(l * 3 + (k == 2 ? 0 : (k == 7 ? 1 : 2)) + 1);
        unsigned* pcnt = (unsigned*)(p.ws + WS_PCNT);
        if (k == 2) panel_norm(S, pcnt, epoch, X, p.in[6] + (size_t)(l * 3 + 1) * 1024, modl, 1, XN);
        else if (k == 7) panel_norm(S, pcnt, epoch, X, p.in[6] + (size_t)(l * 3 + 2) * 1024, modl, 2, XN);
        else if (l < 3) panel_norm(S, pcnt, epoch, X, p.in[6] + (size_t)((l + 1) * 3) * 1024, modl + 9 * 9216, 0, XN);
      } else if (k == 4) {
        pg8::Gemm g{XN, (const bf16_t*)(p.ws + WB_WIN), T_TOK, WINC, DM};
        S.init(T_TOK, WINC, gridDim.x, blockIdx.x); pg8::EpiQKV E{(bf16_t*)(p.ws + WS_QKV), (bf16_t*)(p.ws + WS_GATES)}; pg8::gemm_phase(lds3, g, S, E);
      } else if (k == 5) { phase_qknorm(p, l); }
      else { phase_attn(p, l, shm); }
    }
    if (ph + 1 < ph_hi) {
      if (ph == 0) { gsync(grid); xb = xcd_barrier_post(xbar, xst); }
      else xcd_barrier(xb);
    }
  }
}

#ifndef N_LAUNCH_MODE
#define N_LAUNCH_MODE 1
#endif
extern "C" void kernel_launch(void* const* d_in, const int* in_sizes, int n_in, void* d_out, int out_size, void* d_ws, size_t ws_size, hipStream_t stream) {
  static int grid = 0;
  if (grid == 0) {
    if (n_in != 24 || out_size != T_TOK * DM || ws_size < WS_END2) { fprintf(stderr, "kernel_launch: unexpected shapes (n_in %d out %d ws %zu need %zu)\n", n_in, out_size, ws_size, (size_t)WS_END2); grid = -1; return; }
    int dev = 0, cus = 0, per_cu = 0;
    (void)hipGetDevice(&dev); (void)hipDeviceGetAttribute(&cus, hipDeviceAttributeMultiprocessorCount, dev);
    if (hipFuncSetAttribute((const void*)mega_fwd, hipFuncAttributeMaxDynamicSharedMemorySize, LDS_BYTES) != hipSuccess) { fprintf(stderr, "kernel_launch: hipFuncSetAttribute failed\n"); grid = -1; return; }
    if (hipOccupancyMaxActiveBlocksPerMultiprocessor(&per_cu, (const void*)mega_fwd, 512, LDS_BYTES) != hipSuccess || per_cu < 1) { fprintf(stderr, "kernel_launch: occupancy query gave %d\n", per_cu); per_cu = 1; }
    (void)hipGetLastError();
    grid = cus;
  }
  if (grid < 0) return;
  Params p{};
  for (int i = 0; i < 24; ++i) p.in[i] = (const float*)d_in[i];
  p.out = (float*)d_out; p.ws = (unsigned char*)d_ws;
#if N_LAUNCH_MODE == 1
  int lo = 0, hi = N_PHASES;
  void* args[] = {&p, &lo, &hi};
  hipError_t e = hipLaunchCooperativeKernel((const void*)mega_fwd, dim3(grid), dim3(512), args, LDS_BYTES, stream);
  if (e != hipSuccess) fprintf(stderr, "kernel_launch: cooperative launch failed: %s (grid %d)\n", hipGetErrorString(e), grid);
#else
  for (int ph = 0; ph < N_PHASES; ++ph) hipLaunchKernelGGL(mega_fwd, dim3(grid), dim3(512), LDS_BYTES, stream, p, ph, ph + 1);
#endif
}
```

```cpp
#include <hip/hip_runtime.h>
#include <hip/hip_bf16.h>
#include <hip/hip_cooperative_groups.h>
#include <cstdio>
#include <cstdint>
#define N_LAUNCH_MODE 1
namespace cg = cooperative_groups;

typedef unsigned short bf16_t;
typedef short bf16x8 __attribute__((ext_vector_type(8)));
typedef short s16x4 __attribute__((ext_vector_type(4)));
typedef float f32x4 __attribute__((ext_vector_type(4)));
typedef float f32x16 __attribute__((ext_vector_type(16)));
typedef unsigned u32x4 __attribute__((ext_vector_type(4)));
typedef unsigned u32x2 __attribute__((ext_vector_type(2)));
#define LAS __attribute__((address_space(3)))

constexpr int T_TOK = 32768, DM = 1024, DFF = 2816, NFF2 = 5632, WINC = 7680, QKVW = 4608, GW = 3072;
constexpr float EPS = 1e-6f, LOG2E = 1.4426950408889634f, NEGBIG = -1e30f;
constexpr size_t WB_FFIN0 = 0, WB_FFIN1 = 11534336, WB_FFOUT0 = 23068672, WB_FFOUT1 = 28835840, WB_WIN = 34603008, WB_WO = 50331648;
constexpr size_t WS_MOD = 52428800, WS_ROPE = 53755904, WS_LUT = 53821440, WS_LAM = 53854208, WS_XN = 53854464;
constexpr size_t WS_QKV = WS_XN + 67108864, WS_GATES = WS_QKV + 301989888, WS_PARK = WS_GATES + 201326592, WS_END = WS_PARK + 67108864;
constexpr size_t WS_BAR = WS_END, WS_PCNT = WS_END + 16384, WS_END2 = WS_END + 65536;
constexpr int LDS_BYTES = 131072 + 16;

struct Params { const float* in[24]; float* out; unsigned char* ws; };

typedef __bf16 bf16v2 __attribute__((ext_vector_type(2)));
typedef float f32x2 __attribute__((ext_vector_type(2)));
__device__ __forceinline__ unsigned cvtpk(float lo, float hi) { f32x2 v = {lo, hi}; bf16v2 b = __builtin_convertvector(v, bf16v2); return __builtin_bit_cast(unsigned, b); }
__device__ __forceinline__ float bf_lo(unsigned u) { return __uint_as_float(u << 16); }
__device__ __forceinline__ float bf_hi(unsigned u) { return __uint_as_float(u & 0xffff0000u); }
__device__ __forceinline__ float bf2f(bf16_t v) { return __uint_as_float(((unsigned)v) << 16); }

namespace pg8 {
constexpr int BM = 256, BK = 64, HALF = 128, HTB = HALF * BK * 2, STAGE_BYTES = 8 * HTB, NXCD = 8, WGM = 8;
__device__ __forceinline__ int lds_byte(int r, int c) { const int st = (r >> 4) * 2 + (c >> 5), rr = r & 15, cc = c & 31, ob = rr * 64 + cc * 2; return st * 1024 + (ob ^ (((ob >> 9) & 1) << 5)); }
__device__ __forceinline__ void stage_rc(int b, int& R, int& C) { const int st = b / 1024, sb = b % 1024, swz = sb ^ (((sb >> 9) & 1) << 5); R = (st >> 1) * 16 + swz / 64; C = (st & 1) * 32 + (swz % 64) / 2; }
__device__ __forceinline__ int perm32(int rho) { const int n = rho >> 4, i = rho & 15; return 8 * (i >> 2) + 4 * n + (i & 3); }
struct Unit { int pm, pn; };
struct Gemm { const bf16_t* A; const bf16_t* Bt; int M, N, K; };
struct StaticOrder {
    int nM, nN, nwg, G, c;
    __device__ void init(int M, int N, int G_, int c_) { nM = M / BM; nN = N / BM; nwg = nM * nN; G = G_; c = c_; }
    __device__ bool next(int i, Unit& u) const {
        const long L = (long)i * G + c; if (L >= nwg) return false;
        int wgid = (int)L; { const int q = nwg / NXCD, r = nwg % NXCD, xcd = wgid % NXCD, off = wgid / NXCD; wgid = (xcd < r ? xcd * (q + 1) : r * (q + 1) + (xcd - r) * q) + off; }
        const int nig = WGM * nN, gid = wgid / nig, fm = gid * WGM, gsz = (nM - fm) < WGM ? (nM - fm) : WGM;
        u.pm = fm + ((wgid % nig) % gsz); u.pn = (wgid % nig) / gsz; return true;
    }
};

template <class Epi>
__device__ __forceinline__ void gemm_phase(LAS unsigned char* lds, const Gemm g, const StaticOrder& S, const Epi& E) {
    int tid_ = threadIdx.x; asm volatile("" : "+v"(tid_));
    const int tid = tid_, wid = __builtin_amdgcn_readfirstlane(tid >> 6), lane = tid & 63, wr = wid >> 2, wc = wid & 3, fr = lane & 15, fq = lane >> 4;
    const int K = g.K, nt = K / BK;
    unsigned voffA[2], voffB[2];
#pragma unroll
    for (int i = 0; i < 2; ++i) { int R, C; stage_rc(tid * 16 + i * 8192, R, C); const int Rb = Epi::PERM ? ((R & ~31) + perm32(R & 31)) : R;
        voffA[i] = (unsigned)(R * K + C) * 2u; voffB[i] = (unsigned)(Rb * K + C) * 2u; }
    const size_t kstep = (size_t)(BK * 2);
    const size_t hstep = (size_t)HALF * K * 2;
    const size_t tstep = 2 * hstep;
    const unsigned ldsw = (unsigned)wid * 1024u;
    const int aoff = lds_byte(wr * 64 + fr, fq * 8), boff = lds_byte(wc * 32 + fr, fq * 8);
#define PG8_SA(b, h) (((b) * 2 + (h)) * HTB)
#define PG8_SB(b, h) ((4 + (b) * 2 + (h)) * HTB)
#define PG8_STAGE(bufoff, gbase, voff) do { _Pragma("unroll") for (int _i = 0; _i < 2; ++_i) \
        __builtin_amdgcn_global_load_lds((const unsigned*)((const char*)(gbase) + (voff)[_i]), (LAS unsigned*)(lds + (bufoff) + ldsw + _i * 8192), 16, 0, 0); } while (0)
#define PG8_LDA(dst, b, h) do { _Pragma("unroll") for (int m = 0; m < 4; ++m) _Pragma("unroll") for (int k = 0; k < 2; ++k) dst[m][k] = *(const LAS bf16x8*)(lds + PG8_SA(b, h) + aoff + m * 2048 + k * 1024); } while (0)
#define PG8_LDB(dst, b, h) do { _Pragma("unroll") for (int n = 0; n < 2; ++n) _Pragma("unroll") for (int k = 0; k < 2; ++k) dst[n][k] = *(const LAS bf16x8*)(lds + PG8_SB(b, h) + boff + n * 2048 + k * 1024); } while (0)
#define PG8_MMA(ai, bj, At, Bt) do { __builtin_amdgcn_s_setprio(1); _Pragma("unroll") for (int m = 0; m < 4; ++m) _Pragma("unroll") for (int n = 0; n < 2; ++n) _Pragma("unroll") for (int k = 0; k < 2; ++k) \
        acc[ai][bj][m][n] = __builtin_amdgcn_mfma_f32_16x16x32_bf16(Bt[n][k], At[m][k], acc[ai][bj][m][n], 0, 0, 0); __builtin_amdgcn_s_setprio(0); } while (0)
#define PG8_WAIT_V(n) asm volatile("s_waitcnt vmcnt(" #n ")" ::: "memory")
#define PG8_WAIT_L(n) asm volatile("s_waitcnt lgkmcnt(" #n ")" ::: "memory")
#define PG8_BAR __builtin_amdgcn_s_barrier()
#define PG8_SCHED __builtin_amdgcn_sched_barrier(0)
    Unit cur, nxt; int ui = 0;
    if (!S.next(0, cur)) return;
    f32x4 acc[2][2][4][2];
#pragma unroll
    for (int a = 0; a < 2; ++a)
#pragma unroll
        for (int b = 0; b < 2; ++b)
#pragma unroll
            for (int m = 0; m < 4; ++m)
#pragma unroll
                for (int n = 0; n < 2; ++n) acc[a][b][m][n] = (f32x4){0.f, 0.f, 0.f, 0.f};
    bf16x8 At[4][2], B0[2][2], B1[2][2];
    const char* cA = (const char*)g.A + (size_t)cur.pm * tstep; const char* cB = (const char*)g.Bt + (size_t)cur.pn * tstep;
    PG8_STAGE(PG8_SB(0, 0), cB, voffB); PG8_STAGE(PG8_SA(0, 0), cA, voffA); PG8_STAGE(PG8_SB(0, 1), cB + hstep, voffB); PG8_STAGE(PG8_SA(0, 1), cA + hstep, voffA);
    if (wr == 1) PG8_BAR;
    PG8_WAIT_V(4); PG8_BAR;
    PG8_STAGE(PG8_SB(1, 0), cB + kstep, voffB); PG8_STAGE(PG8_SA(1, 0), cA + kstep, voffA); PG8_STAGE(PG8_SB(1, 1), cB + hstep + kstep, voffB);
    PG8_WAIT_V(6); PG8_BAR;
    for (;;) {
        const bool has_next = S.next(ui + 1, nxt);
        const char* nA = has_next ? (const char*)g.A + (size_t)nxt.pm * tstep : cA; const char* nB = has_next ? (const char*)g.Bt + (size_t)nxt.pn * tstep : cB;
        for (int t = 0; t < nt; t += 2) {
            const bool last = (t == nt - 2);
            const char* a1 = cA + (size_t)(t + 1) * kstep;
            const char* a2 = last ? nA : cA + (size_t)(t + 2) * kstep; const char* b2 = last ? nB : cB + (size_t)(t + 2) * kstep;
            const char* a3 = a2 + kstep; const char* b3 = b2 + kstep;
            PG8_LDB(B0, 0, 0); PG8_SCHED; PG8_LDA(At, 0, 0); PG8_STAGE(PG8_SA(1, 1), a1 + hstep, voffA);
            PG8_WAIT_L(8); PG8_BAR; PG8_WAIT_L(0); PG8_MMA(0, 0, At, B0); PG8_BAR; PG8_SCHED;
            PG8_LDB(B1, 0, 1); PG8_STAGE(PG8_SB(0, 0), b2, voffB);
            PG8_BAR; PG8_WAIT_L(0); PG8_MMA(0, 1, At, B1); PG8_BAR;
            PG8_LDA(At, 0, 1); PG8_STAGE(PG8_SA(0, 0), a2, voffA);
            PG8_BAR; PG8_WAIT_L(0); PG8_MMA(1, 0, At, B0); PG8_BAR; PG8_SCHED;
            PG8_STAGE(PG8_SB(0, 1), b2 + hstep, voffB);
            PG8_WAIT_V(6); PG8_BAR; PG8_MMA(1, 1, At, B1); PG8_BAR;
            PG8_LDB(B0, 1, 0); PG8_SCHED; PG8_LDA(At, 1, 0); PG8_STAGE(PG8_SA(0, 1), a2 + hstep, voffA);
            PG8_WAIT_L(8); PG8_BAR; PG8_WAIT_L(0); PG8_MMA(0, 0, At, B0); PG8_BAR; PG8_SCHED;
            PG8_LDB(B1, 1, 1); PG8_STAGE(PG8_SB(1, 0), b3, voffB);
            PG8_BAR; PG8_WAIT_L(0); PG8_MMA(0, 1, At, B1); PG8_BAR;
            PG8_LDA(At, 1, 1); PG8_STAGE(PG8_SA(1, 0), a3, voffA);
            PG8_BAR; PG8_WAIT_L(0); PG8_MMA(1, 0, At, B0); PG8_BAR; PG8_SCHED;
            PG8_STAGE(PG8_SB(1, 1), b3 + hstep, voffB);
            PG8_WAIT_V(6); PG8_BAR; PG8_MMA(1, 1, At, B1); PG8_BAR;
        }
        E(acc, cur, wr, wc, fr, fq);
        if (!has_next) break;
#pragma unroll
        for (int a = 0; a < 2; ++a)
#pragma unroll
            for (int b = 0; b < 2; ++b)
#pragma unroll
                for (int m = 0; m < 4; ++m)
#pragma unroll
                    for (int n = 0; n < 2; ++n) acc[a][b][m][n] = (f32x4){0.f, 0.f, 0.f, 0.f};
        cur = nxt; cA = nA; cB = nB; ++ui;
    }
    PG8_WAIT_V(0);
    if (wr == 0) PG8_BAR;
    PG8_BAR;
#undef PG8_SA
#undef PG8_SB
#undef PG8_STAGE
#undef PG8_LDA
#undef PG8_LDB
#undef PG8_MMA
#undef PG8_WAIT_V
#undef PG8_WAIT_L
#undef PG8_BAR
#undef PG8_SCHED
}

__device__ __forceinline__ float silu_f(float g) { return g * __builtin_amdgcn_rcpf(1.f + __expf(-g)); }
__device__ __forceinline__ float sigm_f(float g) { return __builtin_amdgcn_rcpf(1.f + __expf(-g)); }
struct EpiSwiGLU {
    static constexpr bool PERM = true;
    bf16_t* H;
    __device__ __forceinline__ void operator()(const f32x4 (&acc)[2][2][4][2], const Unit& u, int wr, int wc, int fr, int fq) const {
        const int row0 = u.pm * BM + wr * 64 + fr, col0 = u.pn * 128 + wc * 32 + 8 * fq;
#pragma unroll
        for (int ai = 0; ai < 2; ++ai)
#pragma unroll
            for (int m = 0; m < 4; ++m) { bf16_t* rowp = H + (size_t)(row0 + ai * HALF + m * 16) * DFF + col0;
                const f32x4 g0 = acc[ai][0][m][0], g1 = acc[ai][0][m][1], u0 = acc[ai][1][m][0], u1 = acc[ai][1][m][1];
                u32x4 w; w.x = cvtpk(silu_f(g0[0]) * u0[0], silu_f(g0[1]) * u0[1]); w.y = cvtpk(silu_f(g0[2]) * u0[2], silu_f(g0[3]) * u0[3]);
                w.z = cvtpk(silu_f(g1[0]) * u1[0], silu_f(g1[1]) * u1[1]); w.w = cvtpk(silu_f(g1[2]) * u1[2], silu_f(g1[3]) * u1[3]);
                *(u32x4*)rowp = w; }
    }
};
struct EpiResid {
    static constexpr bool PERM = false;
    float* X; const float* modg; float gs;
    __device__ __forceinline__ void operator()(const f32x4 (&acc)[2][2][4][2], const Unit& u, int wr, int wc, int fr, int fq) const {
        const int row0 = u.pm * BM + wr * 64 + fr, col0 = u.pn * BM + wc * 32 + 4 * fq;
        const int bi = u.pm < 64 ? (u.pm >> 3) : 8;
        const float* mg = modg + (size_t)bi * 9216 + col0;
        f32x4 gv[2][2];
#pragma unroll
        for (int bj = 0; bj < 2; ++bj)
#pragma unroll
            for (int n = 0; n < 2; ++n) gv[bj][n] = *(const f32x4*)(mg + bj * HALF + n * 16) * gs;
#pragma unroll
        for (int ai = 0; ai < 2; ++ai)
#pragma unroll
            for (int m = 0; m < 4; ++m) { float* rowp = X + (size_t)(row0 + ai * HALF + m * 16) * DM + col0;
#pragma unroll
                for (int bj = 0; bj < 2; ++bj)
#pragma unroll
                    for (int n = 0; n < 2; ++n) { f32x4* q = (f32x4*)(rowp + bj * HALF + n * 16); *q = *q + gv[bj][n] * acc[ai][bj][m][n]; } }
    }
};
struct EpiQKV {
    static constexpr bool PERM = true;
    bf16_t* QKV; bf16_t* GATES;
    __device__ __forceinline__ void operator()(const f32x4 (&acc)[2][2][4][2], const Unit& u, int wr, int wc, int fr, int fq) const {
        const int row0 = u.pm * BM + wr * 64 + fr;
        if (u.pn < 18) {
            const int col0 = u.pn * BM + wc * 32 + 8 * fq;
#pragma unroll
            for (int ai = 0; ai < 2; ++ai)
#pragma unroll
                for (int m = 0; m < 4; ++m) { bf16_t* rowp = QKV + (size_t)(row0 + ai * HALF + m * 16) * QKVW + col0;
#pragma unroll
                    for (int bj = 0; bj < 2; ++bj) { const f32x4 v0 = acc[ai][bj][m][0], v1 = acc[ai][bj][m][1];
                        u32x4 w; w.x = cvtpk(v0[0], v0[1]); w.y = cvtpk(v0[2], v0[3]); w.z = cvtpk(v1[0], v1[1]); w.w = cvtpk(v1[2], v1[3]);
                        *(u32x4*)(rowp + bj * HALF) = w; } }
        } else {
            const int col0 = (u.pn - 18) * BM + wc * 32 + 8 * fq;
#pragma unroll
            for (int ai = 0; ai < 2; ++ai)
#pragma unroll
                for (int m = 0; m < 4; ++m) { bf16_t* rowp = GATES + (size_t)(row0 + ai * HALF + m * 16) * GW + col0;
#pragma unroll
                    for (int bj = 0; bj < 2; ++bj) { const f32x4 v0 = acc[ai][bj][m][0], v1 = acc[ai][bj][m][1];
                        u32x4 w; w.x = cvtpk(sigm_f(v0[0]), sigm_f(v0[1])); w.y = cvtpk(sigm_f(v0[2]), sigm_f(v0[3])); w.z = cvtpk(sigm_f(v1[0]), sigm_f(v1[1])); w.w = cvtpk(sigm_f(v1[2]), sigm_f(v1[3]));
                        *(u32x4*)(rowp + bj * HALF) = w; } }
        }
    }
};
}

constexpr int LDQK = QKVW;
constexpr int SHM_V = 64 * 128 * 2, SHM_K = 64 * 128 * 2;
constexpr int ATT_NBUF = 3;
constexpr int ATT_WS_OFF = ATT_NBUF * SHM_V + ATT_NBUF * SHM_K, ATT_LUT_OFF = ATT_WS_OFF + 8 * 64 * 4;
#define KSWZ(row, colB) ((row) * 256 + ((colB) ^ (((row) & 7) << 4)))
#define SBAR() __builtin_amdgcn_sched_barrier(0)
__device__ __forceinline__ int crow(int r, int hi) { return (r & 3) + 8 * (r >> 2) + 4 * hi; }

template <int MODE>
__device__ __forceinline__ void partialSM(f32x16& p0, f32x16& p1, float& m_reg, float& mn, float& alpha, int relh, int relw_min, int relw_max, const float* lut) {
  if constexpr (MODE == 0) {
    constexpr float SCALE = 0.088388347648318440f, C = SCALE * LOG2E, THR = 8.f;
    float pmax = p0[0];
#pragma unroll
    for (int r = 1; r < 16; ++r) pmax = fmaxf(pmax, p0[r]);
#pragma unroll
    for (int r = 0; r < 16; ++r) pmax = fmaxf(pmax, p1[r]);
    { auto rr = __builtin_amdgcn_permlane32_swap(__float_as_uint(pmax), __float_as_uint(pmax), false, false);
      pmax = fmaxf(__uint_as_float(rr[0]), __uint_as_float(rr[1])); }
    if (__builtin_expect(__all(pmax - m_reg <= THR / SCALE), 1)) { mn = m_reg; alpha = 1.f; }
    else { mn = fmaxf(m_reg, pmax); alpha = __builtin_amdgcn_exp2f((m_reg - mn) * C); m_reg = mn; }
    const float mnC = -mn * C;
#pragma unroll
    for (int r = 0; r < 16; ++r) p0[r] = fmaf(p0[r], C, mnC);
#pragma unroll
    for (int r = 0; r < 16; ++r) p1[r] = fmaf(p1[r], C, mnC);
#pragma unroll
    for (int r = 0; r < 16; ++r) p0[r] = __builtin_amdgcn_exp2f(p0[r]);
  } else {
    constexpr float C = (MODE == 1 ? 0.088388347648318440f : 0.125f) * LOG2E, THR2 = 8.f * LOG2E;
    bool nearT = true; float cfar = 0.f;
    if constexpr (MODE >= 2) {
      if (relw_max <= -128) { nearT = false; cfar = lut[0]; }
      else if (relw_min >= 128) { nearT = false; cfar = lut[258]; }
      if (!nearT) {
        float pmax = p0[0];
#pragma unroll
        for (int r = 1; r < 16; ++r) pmax = fmaxf(pmax, p0[r]);
#pragma unroll
        for (int r = 0; r < 16; ++r) pmax = fmaxf(pmax, p1[r]);
        { auto rr = __builtin_amdgcn_permlane32_swap(__float_as_uint(pmax), __float_as_uint(pmax), false, false);
          pmax = fmaxf(__uint_as_float(rr[0]), __uint_as_float(rr[1])); }
        const float tmax = fmaf(pmax, C, cfar);
        if (__builtin_expect(__all(tmax - m_reg <= THR2), 1)) { mn = m_reg; alpha = 1.f; }
        else { mn = fmaxf(m_reg, tmax); alpha = __builtin_amdgcn_exp2f(m_reg - mn); m_reg = mn; }
        const float off = cfar - mn;
#pragma unroll
        for (int r = 0; r < 16; ++r) p0[r] = fmaf(p0[r], C, off);
#pragma unroll
        for (int r = 0; r < 16; ++r) p1[r] = fmaf(p1[r], C, off);
#pragma unroll
        for (int r = 0; r < 16; ++r) p0[r] = __builtin_amdgcn_exp2f(p0[r]);
        return;
      }
    }
    if (nearT) {
#pragma unroll
      for (int r = 0; r < 16; ++r) { const int i0 = relh + (r & 3) + 8 * (r >> 2);
        const int a0 = min(max(i0, -129), 129) + 129, a1 = min(max(i0 + 32, -129), 129) + 129;
        p0[r] = fmaf(p0[r], C, lut[a0]); p1[r] = fmaf(p1[r], C, lut[a1]); }
    } else {
#pragma unroll
      for (int r = 0; r < 16; ++r) { p0[r] = fmaf(p0[r], C, cfar); p1[r] = fmaf(p1[r], C, cfar); }
    }
    float pmax = p0[0];
#pragma unroll
    for (int r = 1; r < 16; ++r) pmax = fmaxf(pmax, p0[r]);
#pragma unroll
    for (int r = 0; r < 16; ++r) pmax = fmaxf(pmax, p1[r]);
    { auto rr = __builtin_amdgcn_permlane32_swap(__float_as_uint(pmax), __float_as_uint(pmax), false, false);
      pmax = fmaxf(__uint_as_float(rr[0]), __uint_as_float(rr[1])); }
    if (__builtin_expect(__all(pmax - m_reg <= THR2), 1)) { mn = m_reg; alpha = 1.f; }
    else { mn = fmaxf(m_reg, pmax); alpha = __builtin_amdgcn_exp2f(m_reg - mn); m_reg = mn; }
#pragma unroll
    for (int r = 0; r < 16; ++r) p0[r] = __builtin_amdgcn_exp2f(p0[r] - mn);
#pragma unroll
    for (int r = 0; r < 16; ++r) p1[r] = p1[r] - mn;
  }
}
__device__ __forceinline__ void finishSM(f32x16& p0, f32x16& p1, float alpha, float& l_reg, bf16x8& pa0, bf16x8& pa1, bf16x8& pa2, bf16x8& pa3) {
#pragma unroll
  for (int r = 0; r < 16; ++r) p1[r] = __builtin_amdgcn_exp2f(p1[r]);
  float ps = 0;
#pragma unroll
  for (int r = 0; r < 16; ++r) ps += p0[r];
#pragma unroll
  for (int r = 0; r < 16; ++r) ps += p1[r];
  { auto rr = __builtin_amdgcn_permlane32_swap(__float_as_uint(ps), __float_as_uint(ps), false, false);
    ps = __uint_as_float(rr[0]) + __uint_as_float(rr[1]); }
  l_reg = l_reg * alpha + ps;
#define PK4(P, BASE, OUT) do { unsigned a0 = cvtpk(P[BASE + 0], P[BASE + 1]), a1 = cvtpk(P[BASE + 2], P[BASE + 3]);   \
    unsigned b0 = cvtpk(P[BASE + 4], P[BASE + 5]), b1 = cvtpk(P[BASE + 6], P[BASE + 7]);                              \
    auto r0 = __builtin_amdgcn_permlane32_swap(a0, b0, false, false); auto r1 = __builtin_amdgcn_permlane32_swap(a1, b1, false, false); \
    u32x4 w = {r0[0], r1[0], r0[1], r1[1]}; OUT = *reinterpret_cast<bf16x8*>(&w); } while (0)
  PK4(p0, 0, pa0); PK4(p0, 8, pa1); PK4(p1, 0, pa2); PK4(p1, 8, pa3);
#undef PK4
}
template <int ND0, int DOFF>
__device__ __forceinline__ void qkt(f32x16& p0, f32x16& p1, const char* Ks, const bf16x8* qr, int r32, int hi) {
  p0 = f32x16{}; p1 = f32x16{};
#pragma unroll
  for (int d0 = 0; d0 < ND0; ++d0) { const int cb = ((d0 + DOFF) * 16 + hi * 8) * 2;
    bf16x8 b0 = *reinterpret_cast<const bf16x8*>(Ks + KSWZ(r32, cb));
    bf16x8 b1 = *reinterpret_cast<const bf16x8*>(Ks + KSWZ(32 + r32, cb));
    p0 = __builtin_amdgcn_mfma_f32_32x32x16_bf16(b0, qr[d0], p0, 0, 0, 0);
    p1 = __builtin_amdgcn_mfma_f32_32x32x16_bf16(b1, qr[d0], p1, 0, 0, 0); }
}
__device__ __forceinline__ int v_st(int k, int c) { const int kk = (k & ~0xC) | ((k & 4) << 1) | ((k & 8) >> 1); return ((kk >> 3) * 4 + (c >> 5)) * 512 + ((kk & 7) * 32 + (c & 31)) * 2; }
__device__ __forceinline__ int v_rd_base(int lane) { return ((lane & 3) << 3) | (((lane >> 2) & 3) << 6) | (((lane >> 4) & 1) << 5) | (((lane >> 5) & 1) << 8); }
constexpr int v_rd_off(int d0, int ks, int half) { return d0 * 512 + ks * 4096 + half * 2048; }
template <int OFF> __device__ __forceinline__ s16x4 tr_read(int vb) {
  s16x4 r; asm volatile("ds_read_b64_tr_b16 %0, %1 offset:%2" : "=&v"(r) : "v"(vb), "i"(OFF) : "memory"); return r;
}
template <int D0> __device__ __forceinline__ void pv_one(f32x16& od, int vb, bf16x8 pa0, bf16x8 pa1, bf16x8 pa2, bf16x8 pa3) {
  const s16x4 l0 = tr_read<v_rd_off(D0, 0, 0)>(vb), h0 = tr_read<v_rd_off(D0, 0, 1)>(vb), l1 = tr_read<v_rd_off(D0, 1, 0)>(vb), h1 = tr_read<v_rd_off(D0, 1, 1)>(vb);
  const s16x4 l2 = tr_read<v_rd_off(D0, 2, 0)>(vb), h2 = tr_read<v_rd_off(D0, 2, 1)>(vb), l3 = tr_read<v_rd_off(D0, 3, 0)>(vb), h3 = tr_read<v_rd_off(D0, 3, 1)>(vb);
  asm volatile("s_waitcnt lgkmcnt(0)" ::: "memory"); SBAR();
#define PK(L, H) (bf16x8){L[0], L[1], L[2], L[3], H[0], H[1], H[2], H[3]}
  od = __builtin_amdgcn_mfma_f32_32x32x16_bf16(pa0, PK(l0, h0), od, 0, 0, 0);
  od = __builtin_amdgcn_mfma_f32_32x32x16_bf16(pa1, PK(l1, h1), od, 0, 0, 0);
  od = __builtin_amdgcn_mfma_f32_32x32x16_bf16(pa2, PK(l2, h2), od, 0, 0, 0);
  od = __builtin_amdgcn_mfma_f32_32x32x16_bf16(pa3, PK(l3, h3), od, 0, 0, 0);
#undef PK
}
__device__ __forceinline__ void pv_d0(f32x16* o, int vb, bf16x8 pa0, bf16x8 pa1, bf16x8 pa2, bf16x8 pa3) {
  pv_one<0>(o[0], vb, pa0, pa1, pa2, pa3); pv_one<1>(o[1], vb, pa0, pa1, pa2, pa3); pv_one<2>(o[2], vb, pa0, pa1, pa2, pa3); pv_one<3>(o[3], vb, pa0, pa1, pa2, pa3);
}

struct AttnEpi {
  const bf16_t* gate;
  float* park;
  bf16_t* merged;
  const float* gsub;
  float lam, oml;
  float sinkl2;
  const float* gq;
};

template <int MODE>
__device__ __forceinline__ void attn_body(const bf16_t* __restrict__ Qb, const bf16_t* __restrict__ Kh, const bf16_t* __restrict__ Vh, int NT, int krel0,
                                          char* lds, const float* __restrict__ lutg, const AttnEpi& E) {
  constexpr int ND0 = (MODE < 2) ? 8 : 4, DOFF = (MODE == 3) ? 4 : 0;
  int tid_ = threadIdx.x; asm volatile("" : "+v"(tid_));
  const int tid = tid_, wid = tid >> 6, lane = tid & 63, r32 = lane & 31, hi = lane >> 5;
  char* V_lds = lds; char* K_lds = lds + ATT_NBUF * SHM_V;
  float* wsm = (float*)(lds + ATT_WS_OFF) + wid * 64; float* li_l = wsm; float* al_l = wsm + 32;
  float* lut = (float*)(lds + ATT_LUT_OFF);
  __syncthreads();
  if constexpr (MODE != 0) { if (tid < 259) lut[tid] = lutg[tid]; }
  float m_reg = -1e30f, l_reg = 0; f32x16 o[4] = {}; bf16x8 qr[ND0];
  const bf16_t* Qw = Qb + (size_t)(wid * 32 + r32) * LDQK + hi * 8;
  {
    float qf[ND0][8]; float ss = 0.f;
#pragma unroll
    for (int d0 = 0; d0 < ND0; ++d0) { const bf16x8 raw = *reinterpret_cast<const bf16x8*>(Qw + d0 * 16);
#pragma unroll
      for (int j = 0; j < 8; ++j) { const float v = __uint_as_float(((unsigned)(unsigned short)raw[j]) << 16); qf[d0][j] = v; ss += v * v; } }
    { auto rr = __builtin_amdgcn_permlane32_swap(__float_as_uint(ss), __float_as_uint(ss), false, false);
      ss = __uint_as_float(rr[0]) + __uint_as_float(rr[1]); }
    const float rs = rsqrtf(ss * (MODE < 2 ? (1.f / 128.f) : (1.f / 64.f)) + EPS);
#pragma unroll
    for (int d0 = 0; d0 < ND0; ++d0) { const f32x4 g0 = *(const f32x4*)(E.gq + d0 * 16 + hi * 8), g1 = *(const f32x4*)(E.gq + d0 * 16 + hi * 8 + 4);
#pragma unroll
      for (int j = 0; j < 4; ++j) { qf[d0][j] = qf[d0][j] * rs * g0[j]; qf[d0][4 + j] = qf[d0][4 + j] * rs * g1[j]; } }
    if constexpr (MODE == 0) {
      const int sp = krel0 + wid * 32 + r32;
#pragma unroll
      for (int h = 0; h < 2; ++h) { const int pos = h == 0 ? (sp >> 6) : (sp & 63);
#pragma unroll
        for (int a = 0; a < 2; ++a) { const float* tb = lutg + (size_t)(pos * 32 + a * 16 + hi * 8) * 2;
#pragma unroll
          for (int jj = 0; jj < 4; ++jj) { const f32x4 cs = *(const f32x4*)(tb + jj * 4);
#pragma unroll
            for (int e = 0; e < 2; ++e) { const int j = 2 * jj + e; const float c = cs[2 * e], sn = cs[2 * e + 1];
              const float x1 = qf[4 * h + a][j], x2 = qf[4 * h + 2 + a][j];
              qf[4 * h + a][j] = x1 * c - x2 * sn; qf[4 * h + 2 + a][j] = x2 * c + x1 * sn; } } } }
    }
#pragma unroll
    for (int d0 = 0; d0 < ND0; ++d0) { u32x4 w; w.x = cvtpk(qf[d0][0], qf[d0][1]); w.y = cvtpk(qf[d0][2], qf[d0][3]); w.z = cvtpk(qf[d0][4], qf[d0][5]); w.w = cvtpk(qf[d0][6], qf[d0][7]);
      qr[d0] = *reinterpret_cast<bf16x8*>(&w); }
  }
  const int sr = tid >> 4, sc = (tid & 15) * 8, vst0 = v_st(sr, sc), vst1 = v_st(32 + sr, sc);
  const int vb0 = (int)(uintptr_t)V_lds + v_rd_base(lane);
  struct { bf16x8 vs0, vs1, ks0, ks1; } sr_[2];
#define SLOAD(i, k0) do { sr_[i].vs0 = *reinterpret_cast<const bf16x8*>(&Vh[(size_t)((k0) + sr) * LDQK + sc]); sr_[i].vs1 = *reinterpret_cast<const bf16x8*>(&Vh[(size_t)((k0) + 32 + sr) * LDQK + sc]); \
    sr_[i].ks0 = *reinterpret_cast<const bf16x8*>(&Kh[(size_t)((k0) + sr) * LDQK + sc]); sr_[i].ks1 = *reinterpret_cast<const bf16x8*>(&Kh[(size_t)((k0) + 32 + sr) * LDQK + sc]); } while (0)
#define SWRITE(off, i) do { *(bf16x8*)(V_lds + (off) + vst0) = sr_[i].vs0;          \
    *(bf16x8*)(V_lds + (off) + vst1) = sr_[i].vs1; int kc = sc * 2;               \
    *(bf16x8*)(K_lds + (off) + KSWZ(sr, kc)) = sr_[i].ks0;                       \
    *(bf16x8*)(K_lds + (off) + KSWZ(32 + sr, kc)) = sr_[i].ks1; } while (0)
#define SWAIT() asm volatile("s_waitcnt vmcnt(4)" ::: "memory")
#define RESC(a) do { if (__any((a) < 1.f)) { if (hi == 0) al_l[r32] = (a); asm volatile("s_waitcnt lgkmcnt(0)" ::: "memory"); \
    _Pragma("unroll") for (int d = 0; d < 4; ++d) _Pragma("unroll") for (int r = 0; r < 16; ++r) o[d][r] *= al_l[crow(r, hi)]; } } while (0)
  const int relq = krel0 - (wid * 32 + r32) + 4 * hi, relwmin = krel0 - (wid * 32 + 31), relwmax = krel0 + 63 - wid * 32;
#define PSM(P0, P1, MN, AL, J) partialSM<MODE>(P0, P1, m_reg, MN, AL, relq + 64 * (J), relwmin + 64 * (J), relwmax + 64 * (J), lut)
  f32x16 pA0, pA1, pB0, pB1; float mnA, mnB, alA, alB; bf16x8 pa0, pa1, pa2, pa3;
  constexpr int SE = 0, SO = 1;
  SLOAD(SE, 0); SLOAD(SO, 64); asm volatile("s_waitcnt vmcnt(4)" ::: "memory"); SWRITE(0, SE); __syncthreads();
  qkt<ND0, DOFF>(pA0, pA1, K_lds, qr, r32, hi); PSM(pA0, pA1, mnA, alA, 0);
  if (2 < NT) SLOAD(SE, 2 * 64);
  SWAIT(); SWRITE(SHM_V, SO);
  int op = 0, oq = SHM_V, ow = 2 * SHM_V;
  for (int j = 1; j + 1 < NT; j += 2) {
    __syncthreads();
    SBAR(); qkt<ND0, DOFF>(pB0, pB1, K_lds + oq, qr, r32, hi);
    finishSM(pA0, pA1, alA, l_reg, pa0, pa1, pa2, pa3); SBAR();
    SLOAD(SO, (j + 2) * 64); SBAR();
    pv_d0(o, vb0 + op, pa0, pa1, pa2, pa3); PSM(pB0, pB1, mnB, alB, j);
    SWAIT(); SWRITE(ow, SE);
    RESC(alB);
    { const int t = op; op = oq; oq = ow; ow = t; }
    __syncthreads();
    SBAR(); qkt<ND0, DOFF>(pA0, pA1, K_lds + oq, qr, r32, hi);
    finishSM(pB0, pB1, alB, l_reg, pa0, pa1, pa2, pa3); SBAR();
    if (j + 3 < NT) SLOAD(SE, (j + 3) * 64); SBAR();
    pv_d0(o, vb0 + op, pa0, pa1, pa2, pa3); PSM(pA0, pA1, mnA, alA, j + 1);
    SWAIT(); SWRITE(ow, SO);
    RESC(alA);
    { const int t = op; op = oq; oq = ow; ow = t; }
  }
  __syncthreads();
  SBAR(); qkt<ND0, DOFF>(pB0, pB1, K_lds + oq, qr, r32, hi);
  finishSM(pA0, pA1, alA, l_reg, pa0, pa1, pa2, pa3); SBAR();
  pv_d0(o, vb0 + op, pa0, pa1, pa2, pa3); PSM(pB0, pB1, mnB, alB, NT - 1);
  RESC(alB);
  finishSM(pB0, pB1, alB, l_reg, pa0, pa1, pa2, pa3); SBAR();
  pv_d0(o, vb0 + oq, pa0, pa1, pa2, pa3);
  if constexpr (MODE == 1) l_reg += __builtin_amdgcn_exp2f(E.sinkl2 - m_reg);
  if (hi == 0) li_l[r32] = l_reg; asm volatile("s_waitcnt lgkmcnt(0)" ::: "memory");
  float rli[16];
#pragma unroll
  for (int r = 0; r < 16; ++r) rli[r] = __builtin_amdgcn_rcpf(li_l[crow(r, hi)]);
  float* pk0 = E.park; float* pk1 = E.park + 64 * 512;
  const int rowb = wid * 32;
  if constexpr (MODE == 0 || MODE == 1) {
#pragma unroll
    for (int r = 0; r < 16; ++r) { const int row = rowb + crow(r, hi);
#pragma unroll
      for (int d0 = 0; d0 < 4; ++d0) { const int idx = (d0 * 16 + r) * 512 + tid;
        const float g = bf2f(E.gate[(size_t)row * GW + d0 * 32 + r32]);
        const float v = o[d0][r] * rli[r] * g;
        if constexpr (MODE == 0) pk0[idx] = v; else pk0[idx] += v; } }
  } else if constexpr (MODE == 2) {
#pragma unroll
    for (int r = 0; r < 16; ++r)
#pragma unroll
      for (int d0 = 0; d0 < 4; ++d0) pk1[(d0 * 16 + r) * 512 + tid] = o[d0][r] * rli[r];
  } else {
    float gs[4];
#pragma unroll
    for (int d0 = 0; d0 < 4; ++d0) gs[d0] = E.gsub[d0 * 32 + r32] * E.oml;
#pragma unroll
    for (int r = 0; r < 16; ++r) { const int row = rowb + crow(r, hi);
      float ss = 0.f;
#pragma unroll
      for (int d0 = 0; d0 < 4; ++d0) { const float c = pk1[(d0 * 16 + r) * 512 + tid] - E.lam * (o[d0][r] * rli[r]); o[d0][r] = c; ss += c * c; }
      ss += __shfl_xor(ss, 1); ss += __shfl_xor(ss, 2); ss += __shfl_xor(ss, 4); ss += __shfl_xor(ss, 8); ss += __shfl_xor(ss, 16);
      const float rs = rsqrtf(ss * (1.f / 128.f) + EPS);
#pragma unroll
      for (int d0 = 0; d0 < 4; ++d0) { const int col = d0 * 32 + r32;
        const float g = bf2f(E.gate[(size_t)row * GW + col]);
        const float y = o[d0][r] * rs * gs[d0] * g + pk0[(d0 * 16 + r) * 512 + tid];
        E.merged[(size_t)row * DM + col] = (bf16_t)(cvtpk(y, y) & 0xffffu); } }
  }
#undef SLOAD
#undef SWRITE
#undef SWAIT
#undef RESC
#undef PSM
}

__device__ __forceinline__ int t5bucket(int rel) {
  const int n = rel < 0 ? -rel : rel;
  const int b = n < 8 ? n : 8 + (n >= 12) + (n >= 16) + (n >= 23) + (n >= 32) + (n >= 46) + (n >= 64) + (n >= 91);
  return b + (rel > 0 ? 16 : 0);
}
__device__ __forceinline__ float wave_sum(float v) {
  v += __shfl_xor(v, 1); v += __shfl_xor(v, 2); v += __shfl_xor(v, 4); v += __shfl_xor(v, 8); v += __shfl_xor(v, 16); v += __shfl_xor(v, 32); return v;
}

__device__ __forceinline__ void phase_setup(const Params& p, unsigned char* shm) {
  int tid_ = threadIdx.x; asm volatile("" : "+v"(tid_)); const int tid = tid_, nb = gridDim.x, bid = blockIdx.x, wid = tid >> 6, lane = tid & 63;
  if (bid == 0) { unsigned* xbar = (unsigned*)(p.ws + WS_BAR); for (int i = tid; i < 16384; i += 512) xbar[i] = 0u; }
  {
    const float4* s0 = (const float4*)p.in[0]; const float4* s1 = (const float4*)p.in[1]; float4* o = (float4*)p.out;
    const size_t n4 = (size_t)16384 * 1024 / 4;
    for (size_t i = (size_t)bid * 512 + tid; i < 2 * n4; i += (size_t)nb * 512) o[i] = i < n4 ? s0[i] : s1[i - n4];
  }
  {
    float* rope = (float*)(p.ws + WS_ROPE);
    for (int i = bid * 512 + tid; i < 256 * 32; i += nb * 512) { const int pos = i >> 5, f = i & 31;
      const float inv = powf(10000.f, -(float)f / 32.f); const float ang = (float)pos * inv; rope[2 * i] = cosf(ang); rope[2 * i + 1] = sinf(ang); }
    float* lut = (float*)(p.ws + WS_LUT);
    for (int i = bid * 512 + tid; i < 16 * 259; i += nb * 512) { const int hh = i / 259, e = i % 259; int rel = e - 129; float v;
      if (hh < 8) { v = (rel < -128 || rel > 128) ? NEGBIG : p.in[23][t5bucket(rel) * 16 + hh] * LOG2E; }
      else { rel = rel < -128 ? -128 : (rel > 128 ? 128 : rel); v = p.in[23][t5bucket(rel) * 16 + hh] * LOG2E; }
      lut[i] = v; }
    if (bid == 0 && tid < 4) { const int l = tid; float s1 = 0.f, s2 = 0.f;
      for (int i = 0; i < 64; ++i) { s1 += p.in[18][l * 64 + i] * p.in[19][l * 64 + i]; s2 += p.in[20][l * 64 + i] * p.in[21][l * 64 + i]; }
      const float lam_init = 0.8f - 0.6f * expf(-0.3f * (float)l);
      float* lam = (float*)(p.ws + WS_LAM); lam[2 * l] = expf(s1) - expf(s2) + lam_init; lam[2 * l + 1] = 1.f - lam_init; }
  }
  {
    float* sc = (float*)shm; float* red = sc + 9 * 1024;
    for (int i = tid; i < 9 * 1024; i += 512) { const float c = i < 8192 ? p.in[2][i] : p.in[3][i - 8192]; sc[i] = c / (1.f + expf(-c)); }
    __syncthreads();
    float* mod = (float*)(p.ws + WS_MOD);
    for (int task = bid; task < 144; task += nb) {
      const int l = task / 36, j0 = (task % 36) * 256;
      const f32x4* w = (const f32x4*)(p.in[4] + (size_t)l * 1024 * 9216 + j0) + lane;
      f32x4 a0 = {0.f, 0.f, 0.f, 0.f}, a1 = a0, a2 = a0, a3 = a0, a4 = a0, a5 = a0, a6 = a0, a7 = a0, a8 = a0;
#pragma unroll 8
      for (int k = wid * 128; k < wid * 128 + 128; ++k) { const f32x4 wv = w[(size_t)k * 2304];
        a0 += sc[k] * wv; a1 += sc[1024 + k] * wv; a2 += sc[2048 + k] * wv; a3 += sc[3072 + k] * wv; a4 += sc[4096 + k] * wv;
        a5 += sc[5120 + k] * wv; a6 += sc[6144 + k] * wv; a7 += sc[7168 + k] * wv; a8 += sc[8192 + k] * wv; }
      f32x4* rw = (f32x4*)(red + wid * 9 * 256) + lane;
      rw[0] = a0; rw[64] = a1; rw[128] = a2; rw[192] = a3; rw[256] = a4; rw[320] = a5; rw[384] = a6; rw[448] = a7; rw[512] = a8;
      __syncthreads();
      for (int i = tid; i < 9 * 256; i += 512) { const int b = i >> 8, cc = i & 255; float s_ = 0.f;
#pragma unroll
        for (int w8 = 0; w8 < 8; ++w8) s_ += red[w8 * 9 * 256 + b * 256 + cc];
        mod[((size_t)l * 9 + b) * 9216 + j0 + cc] = s_ + p.in[5][l * 9216 + j0 + cc]; }
      __syncthreads();
    }
  }
}

__device__ __forceinline__ void phase_convert(const Params& p, int l, unsigned char* shm) {
  float* tile = (float*)shm;
  int tid_ = threadIdx.x; asm volatile("" : "+v"(tid_)); const int tid = tid_;
  for (int q = blockIdx.x; q < 6400; q += gridDim.x) {
    const float* W; bf16_t* Bt; int N, K, k0, n0d, n0s;
    if (q < 2816) { const int i = q / 1408, qq = q % 1408; W = p.in[7] + (size_t)(l * 2 + i) * 1024 * 5632; Bt = (bf16_t*)(p.ws + (i ? WB_FFIN1 : WB_FFIN0)); N = 5632; K = 1024;
      k0 = (qq & 15) * 64; n0d = (qq >> 4) * 64; n0s = ((n0d >> 7) & 1) * 2816 + (n0d >> 8) * 128 + (n0d & 127); }
    else if (q < 4224) { const int i = (q - 2816) / 704, qq = (q - 2816) % 704; W = p.in[8] + (size_t)(l * 2 + i) * 2816 * 1024; Bt = (bf16_t*)(p.ws + (i ? WB_FFOUT1 : WB_FFOUT0)); N = 1024; K = 2816;
      k0 = (qq % 44) * 64; n0d = (qq / 44) * 64; n0s = n0d; }
    else if (q < 6144) { const int qq = q - 4224; W = p.in[9] + (size_t)l * 1024 * 7680; Bt = (bf16_t*)(p.ws + WB_WIN); N = 7680; K = 1024;
      k0 = (qq & 15) * 64; n0d = (qq >> 4) * 64; n0s = n0d; }
    else { const int qq = q - 6144; W = p.in[10] + (size_t)l * 1024 * 1024; Bt = (bf16_t*)(p.ws + WB_WO); N = 1024; K = 1024;
      k0 = (qq & 15) * 64; n0d = (qq >> 4) * 64; n0s = n0d; }
    { const int nl = tid & 63, ks = tid >> 6;
#pragma unroll
      for (int i = 0; i < 8; ++i) { const int k = ks + 8 * i; tile[nl * 65 + k] = W[(size_t)(k0 + k) * N + n0s + nl]; } }
    __syncthreads();
    { const int n = tid >> 3, kc = (tid & 7) * 8; const float* tr = tile + n * 65 + kc;
      u32x4 w; w.x = cvtpk(tr[0], tr[1]); w.y = cvtpk(tr[2], tr[3]); w.z = cvtpk(tr[4], tr[5]); w.w = cvtpk(tr[6], tr[7]);
      *(u32x4*)(Bt + (size_t)(n0d + n) * K + k0 + kc) = w; }
    __syncthreads();
  }
}

__device__ __forceinline__ void phase_norm(const float* __restrict__ x, const float* __restrict__ g, const float* __restrict__ modl, int jj, bf16_t* __restrict__ xn) {
  int tid_ = threadIdx.x; asm volatile("" : "+v"(tid_)); const int tid = tid_, wid = tid >> 6, lane = tid & 63;
  for (int row = (blockIdx.x * 8 + wid) * 2; row < T_TOK; row += gridDim.x * 16) {
    const int bi = row < 16384 ? (row >> 11) : 8;
    const float* shift = modl + (size_t)bi * 9216 + (3 * jj) * 1024; const float* scale = shift + 1024;
    const float4* xr = (const float4*)(x + (size_t)row * DM);
    float4 v[8]; float ss0 = 0.f, ss1 = 0.f;
#pragma unroll
    for (int i = 0; i < 8; ++i) v[i] = xr[lane + 64 * i];
#pragma unroll
    for (int i = 0; i < 4; ++i) { ss0 += v[i].x * v[i].x + v[i].y * v[i].y + v[i].z * v[i].z + v[i].w * v[i].w;
      ss1 += v[4 + i].x * v[4 + i].x + v[4 + i].y * v[4 + i].y + v[4 + i].z * v[4 + i].z + v[4 + i].w * v[4 + i].w; }
    ss0 = wave_sum(ss0); ss1 = wave_sum(ss1);
    const float rs0 = rsqrtf(ss0 * (1.f / 1024.f) + EPS), rs1 = rsqrtf(ss1 * (1.f / 1024.f) + EPS);
#pragma unroll
    for (int i = 0; i < 4; ++i) { const int c4 = lane + 64 * i;
      const float4 gg = ((const float4*)g)[c4], sc = ((const float4*)scale)[c4], sh = ((const float4*)shift)[c4];
      const float m0 = gg.x * (1.f + sc.x), m1 = gg.y * (1.f + sc.y), m2 = gg.z * (1.f + sc.z), m3 = gg.w * (1.f + sc.w);
      u32x2 w; w.x = cvtpk(v[i].x * rs0 * m0 + sh.x, v[i].y * rs0 * m1 + sh.y); w.y = cvtpk(v[i].z * rs0 * m2 + sh.z, v[i].w * rs0 * m3 + sh.w);
      *(u32x2*)(xn + (size_t)row * DM + c4 * 4) = w;
      u32x2 w2; w2.x = cvtpk(v[4 + i].x * rs1 * m0 + sh.x, v[4 + i].y * rs1 * m1 + sh.y); w2.y = cvtpk(v[4 + i].z * rs1 * m2 + sh.z, v[4 + i].w * rs1 * m3 + sh.w);
      *(u32x2*)(xn + (size_t)(row + 1) * DM + c4 * 4) = w2; }
  }
}

__device__ __forceinline__ void phase_qknorm(const Params& p, int l) {
  bf16_t* qkv = (bf16_t*)(p.ws + WS_QKV); const float* rope = (const float*)(p.ws + WS_ROPE);
  int tid_ = threadIdx.x; asm volatile("" : "+v"(tid_)); const int tid = tid_, wid = tid >> 6, lane = tid & 63;
  f32x2 gk[3];
  gk[0] = *(const f32x2*)(p.in[12] + l * 128 + 2 * lane); gk[1] = *(const f32x2*)(p.in[14] + l * 128 + 2 * lane);
  gk[2] = *(const f32x2*)(p.in[16] + l * 64 + ((2 * lane) & 63));
  const float sg = (lane & 16) ? 1.f : -1.f;
  for (int tok0 = (blockIdx.x * 8 + wid) * 8; tok0 < T_TOK; tok0 += gridDim.x * 64) {
    unsigned u[8][6];
#pragma unroll
    for (int t = 0; t < 8; ++t)
#pragma unroll
      for (int s = 0; s < 6; ++s) u[t][s] = ((const unsigned*)(qkv + (size_t)(tok0 + t) * QKVW + (s >> 1) * 1536 + 1024 + (s & 1) * 128))[lane];
#pragma unroll
    for (int t = 0; t < 8; ++t) { const int tok = tok0 + t;
      const int sp = tok < 16384 ? (tok & 2047) : (tok - 16384);
      const int pos = lane < 32 ? (sp >> 6) : (sp & 63);
      const f32x4 cs = *(const f32x4*)(rope + (size_t)(pos * 32 + ((2 * lane) & 31)) * 2);
#pragma unroll
      for (int s = 0; s < 6; ++s) { const int br = s >> 1;
        float a = bf_lo(u[t][s]), b = bf_hi(u[t][s]);
        float ss = a * a + b * b;
        ss += __shfl_xor(ss, 1); ss += __shfl_xor(ss, 2); ss += __shfl_xor(ss, 4); ss += __shfl_xor(ss, 8); ss += __shfl_xor(ss, 16);
        float rs;
        if (br < 2) { ss += __shfl_xor(ss, 32); rs = rsqrtf(ss * (1.f / 128.f) + EPS); }
        else rs = rsqrtf(ss * (1.f / 64.f) + EPS);
        a = a * rs * gk[br][0]; b = b * rs * gk[br][1];
        if (br == 0) { const float pa = __shfl_xor(a, 16), pb = __shfl_xor(b, 16);
          a = a * cs[0] + sg * pa * cs[1]; b = b * cs[2] + sg * pb * cs[3]; }
        ((unsigned*)(qkv + (size_t)tok * QKVW + br * 1536 + 1024 + (s & 1) * 128))[lane] = cvtpk(a, b); } }
  }
}

__device__ __forceinline__ void phase_attn(const Params& p, int l, unsigned char* shm) {
  const bf16_t* qkv = (const bf16_t*)(p.ws + WS_QKV); const bf16_t* gates = (const bf16_t*)(p.ws + WS_GATES);
  bf16_t* merged = (bf16_t*)(p.ws + WS_XN);
  const float* lutall = (const float*)(p.ws + WS_LUT); const float* lamp = (const float*)(p.ws + WS_LAM);
  AttnEpi E; E.park = (float*)(p.ws + WS_PARK) + (size_t)blockIdx.x * 65536; E.gsub = p.in[22] + l * 128; E.lam = lamp[2 * l]; E.oml = lamp[2 * l + 1];
  for (int it = blockIdx.x; it < 1024; it += gridDim.x) {
    int S, tok0, h, qb;
    if (it < 512) { S = 16384; tok0 = 16384; h = it & 7; qb = it >> 3; }
    else { const int j = it - 512; S = 2048; h = j & 7; qb = (j >> 3) & 7; tok0 = (j >> 6) * 2048; }
    const int g = h >> 2, q0 = qb * 256;
    const bf16_t* rowQ = qkv + (size_t)(tok0 + q0) * QKVW; const bf16_t* seqK = qkv + (size_t)tok0 * QKVW;
    const bf16_t* grow = gates + (size_t)(tok0 + q0) * GW + h * 128;
    E.merged = merged + (size_t)(tok0 + q0) * DM + h * 128; E.sinkl2 = p.in[17][l * 8 + h] * LOG2E;
    E.gate = grow; E.gq = p.in[11] + l * 128;
    attn_body<0>(rowQ + h * 128, seqK + 1024 + g * 128, seqK + 1280 + g * 128, S / 64, q0, (char*)shm, (const float*)(p.ws + WS_ROPE), E);
    { const int t_lo = max(0, 4 * qb - 2), t_hi = min(S / 64, 4 * qb + 6);
      const bf16_t* kb = seqK + (size_t)t_lo * 64 * QKVW;
      E.gate = grow + 1024; E.gq = p.in[13] + l * 128;
      attn_body<1>(rowQ + 1536 + h * 128, kb + 2560 + g * 128, kb + 2816 + g * 128, t_hi - t_lo, t_lo * 64 - q0, (char*)shm, lutall + h * 259, E); }
    E.gate = grow + 2048; E.gq = p.in[15] + l * 64;
    attn_body<2>(rowQ + 3072 + h * 128, seqK + 4096 + g * 128, seqK + 4352 + g * 128, S / 64, -q0, (char*)shm, lutall + (8 + h) * 259, E);
    attn_body<3>(rowQ + 3072 + h * 128 + 64, seqK + 4096 + g * 128, seqK + 4352 + g * 128, S / 64, -q0, (char*)shm, lutall + (8 + h) * 259, E);
  }
}

__device__ __forceinline__ void gsync(cg::grid_group& g) {
  asm volatile("s_waitcnt vmcnt(0) lgkmcnt(0)" ::: "memory");
  g.sync();
  __builtin_amdgcn_fence(__ATOMIC_ACQUIRE, "agent");
  asm volatile("s_waitcnt vmcnt(0)" ::: "memory");
}
#define XB_TMO      128
#define XB_XCNT(j)  (256  + 64 * (j))
#define XB_XSUB(j)  (1280 + 64 * (j))
#define XB_XGEN(j)  (2304 + 64 * (j))
#define XB_TOP      3328
#define XB_TOPGEN   3392
#define XCD_BAR_WORDS 3456
#define XB_SPIN_CAP (1u << 22)
__device__ __forceinline__ unsigned xb_ld(unsigned* p)              { return __hip_atomic_load(p, __ATOMIC_RELAXED, __HIP_MEMORY_SCOPE_AGENT); }
__device__ __forceinline__ unsigned xb_add(unsigned* p, unsigned v) { return __hip_atomic_fetch_add(p, v, __ATOMIC_RELAXED, __HIP_MEMORY_SCOPE_AGENT); }
__device__ __forceinline__ unsigned xb_xcc_id() { return (unsigned)__builtin_amdgcn_s_getreg((3 << 11) | 20) & 0xFu; }
#define XB_SPIN(cond, bar) do { unsigned _sp = 0; while (cond) { __builtin_amdgcn_s_sleep(1); \
    if ((++_sp & 255u) == 0u) { if (xb_ld(&(bar)[XB_TMO])) break; if (_sp > XB_SPIN_CAP) { atomicAdd(&(bar)[XB_TMO], 1u); break; } } } } while (0)
struct XcdBarrier { unsigned* bar; unsigned x; volatile LAS unsigned* st; };
__device__ __forceinline__ XcdBarrier xcd_barrier_post(unsigned* bar, volatile LAS unsigned* st) {
    XcdBarrier b; b.bar = bar; b.x = xb_xcc_id(); b.st = st;
    if (threadIdx.x == 0) (void)xb_add(&bar[XB_XCNT(b.x)], 1u);
    return b;
}
__device__ __forceinline__ void xcd_barrier_complete(unsigned* bar, unsigned x, unsigned& nloc, unsigned& nx) {
    const unsigned G = gridDim.x * gridDim.y * gridDim.z;
    unsigned sum, cnt, mine, sp = 0u;
    for (;;) {
        sum = 0u; cnt = 0u; mine = 0u;
#pragma unroll
        for (unsigned j = 0; j < 16; ++j) { const unsigned c = xb_ld(&bar[XB_XCNT(j)]); sum += c; cnt += (c > 0u) ? 1u : 0u; mine = (j == x) ? c : mine; }
        if (sum == G) break;
        __builtin_amdgcn_s_sleep(1);
        if ((++sp & 255u) == 0u) { if (xb_ld(&bar[XB_TMO])) break; if (sp > XB_SPIN_CAP) { atomicAdd(&bar[XB_TMO], 1u); break; } }
    }
    nloc = mine > 0u ? mine : 1u; nx = cnt > 0u ? cnt : 1u;
}
__device__ __forceinline__ void xcd_barrier(const XcdBarrier& b) {
    asm volatile("s_waitcnt vmcnt(0)" ::: "memory");
    __syncthreads();
    if (threadIdx.x == 0) {
        unsigned* bar = b.bar;
        __builtin_amdgcn_s_waitcnt(0);
        unsigned nloc = b.st[0], nx = b.st[1];
        if (nloc == 0u) { xcd_barrier_complete(bar, b.x, nloc, nx); b.st[0] = nloc; b.st[1] = nx; }
        const unsigned old = xb_add(&bar[XB_XSUB(b.x)], 1u);
        const unsigned gen = old / nloc;
        if (old + 1u == (gen + 1u) * nloc) {
            __builtin_amdgcn_fence(__ATOMIC_RELEASE, "agent");
            asm volatile("s_waitcnt vmcnt(0)" ::: "memory");
            const unsigned og = xb_add(&bar[XB_TOP], 1u);
            const unsigned tg = og / nx;
            if (og + 1u == (tg + 1u) * nx) xb_add(&bar[XB_TOPGEN], 1u);
            else XB_SPIN(xb_ld(&bar[XB_TOPGEN]) == tg, bar);
            __builtin_amdgcn_fence(__ATOMIC_ACQUIRE, "agent");
            xb_add(&bar[XB_XGEN(b.x)], 1u);
            asm volatile("s_waitcnt vmcnt(0)" ::: "memory");
        } else {
            XB_SPIN(xb_ld(&bar[XB_XGEN(b.x)]) == gen, bar);
            __builtin_amdgcn_fence(__ATOMIC_ACQUIRE, "agent");
            asm volatile("s_waitcnt vmcnt(0)" ::: "memory");
        }
    }
    __syncthreads();
}

__device__ __forceinline__ void panel_norm_rows(const float* __restrict__ x, const float* __restrict__ g, const float* __restrict__ modl, int jj, bf16_t* __restrict__ xn, int row0) {
  int tid_ = threadIdx.x; asm volatile("" : "+v"(tid_)); const int tid = tid_, wid = tid >> 6, lane = tid & 63;
#pragma unroll 1
  for (int rr = 0; rr < 8; rr += 4) {
    const int row = row0 + wid * 8 + rr;
    const int bi = row < 16384 ? (row >> 11) : 8;
    const float* shift = modl + (size_t)bi * 9216 + (3 * jj) * 1024; const float* scale = shift + 1024;
    const float4* xr = (const float4*)(x + (size_t)row * DM);
    float4 v[16]; float ss[4] = {0.f, 0.f, 0.f, 0.f};
#pragma unroll
    for (int i = 0; i < 16; ++i) v[i] = xr[lane + 64 * i];
#pragma unroll
    for (int r = 0; r < 4; ++r)
#pragma unroll
      for (int i = 0; i < 4; ++i) { const float4 t = v[4 * r + i]; ss[r] += t.x * t.x + t.y * t.y + t.z * t.z + t.w * t.w; }
    float rs[4];
#pragma unroll
    for (int r = 0; r < 4; ++r) rs[r] = rsqrtf(wave_sum(ss[r]) * (1.f / 1024.f) + EPS);
#pragma unroll
    for (int i = 0; i < 4; ++i) { const int c4 = lane + 64 * i;
      const float4 gg = ((const float4*)g)[c4], sc = ((const float4*)scale)[c4], sh = ((const float4*)shift)[c4];
      const float m0 = gg.x * (1.f + sc.x), m1 = gg.y * (1.f + sc.y), m2 = gg.z * (1.f + sc.z), m3 = gg.w * (1.f + sc.w);
#pragma unroll
      for (int r = 0; r < 4; ++r) { const float4 t = v[4 * r + i];
        u32x2 w; w.x = cvtpk(t.x * rs[r] * m0 + sh.x, t.y * rs[r] * m1 + sh.y); w.y = cvtpk(t.z * rs[r] * m2 + sh.z, t.w * rs[r] * m3 + sh.w);
        *(u32x2*)(xn + (size_t)(row + r) * DM + c4 * 4) = w; } }
  }
}
__device__ __forceinline__ void panel_norm(const pg8::StaticOrder& S, unsigned* pcnt, unsigned epoch, const float* x, const float* g, const float* modl, int jj, bf16_t* xn) {
  asm volatile("s_waitcnt vmcnt(0)" ::: "memory");
  __syncthreads();
  if (threadIdx.x == 0) {
    __builtin_amdgcn_fence(__ATOMIC_RELEASE, "agent"); asm volatile("s_waitcnt vmcnt(0)" ::: "memory");
    pg8::Unit u;
    for (int i = 0; S.next(i, u); ++i) (void)xb_add(&pcnt[64 * u.pm], 1u);
    for (int i = 0; S.next(i, u); ++i) { unsigned sp = 0; while (xb_ld(&pcnt[64 * u.pm]) < 4u * epoch) { __builtin_amdgcn_s_sleep(1); if (++sp > (1u << 22)) break; } }
    __builtin_amdgcn_fence(__ATOMIC_ACQUIRE, "agent"); asm volatile("s_waitcnt vmcnt(0)" ::: "memory");
  }
  __syncthreads();
  pg8::Unit u;
  for (int i = 0; S.next(i, u); ++i) panel_norm_rows(x, g, modl, jj, xn, u.pm * 256 + u.pn * 64);
}

constexpr int N_PHASES = 45;
__global__ void __launch_bounds__(512) mega_fwd(Params p, int ph_lo, int ph_hi) {
  extern __shared__ __attribute__((aligned(16))) unsigned char shm[];
  cg::grid_group grid = cg::this_grid();
  LAS unsigned char* lds3 = (LAS unsigned char*)shm;
  float* X = p.out;
  bf16_t* XN = (bf16_t*)(p.ws + WS_XN); bf16_t* Hb = (bf16_t*)(p.ws + WS_QKV);
  pg8::StaticOrder S;
  volatile LAS unsigned* xst = (volatile LAS unsigned*)(lds3 + 131072);
  if (threadIdx.x == 0) { xst[0] = 0u; xst[1] = 0u; }
  unsigned* xbar = (unsigned*)(p.ws + WS_BAR);
  XcdBarrier xb; xb.bar = xbar; xb.x = 0u; xb.st = xst;
#pragma unroll 1
  for (int ph = ph_lo; ph < ph_hi; ++ph) {
    if (ph == 0) { phase_setup(p, shm); }
    else {
      const int l = (ph - 1) / 11, k = (ph - 1) % 11;
      const float* modl = (const float*)(p.ws + WS_MOD) + (size_t)l * 9 * 9216;
      if (k == 3 || k == 8) continue;
      if (k == 0) {
        phase_convert(p, l, shm);
        if (l == 0) phase_norm(X, p.in[6], modl, 0, XN);
      } else if (k == 1 || k == 9) {
        pg8::Gemm g{XN, (const bf16_t*)(p.ws + (k == 9 ? WB_FFIN1 : WB_FFIN0)), T_TOK, NFF2, DM};
        S.init(T_TOK, NFF2, gridDim.x, blockIdx.x); pg8::EpiSwiGLU E{Hb}; pg8::gemm_phase(lds3, g, S, E);
      } else if (k == 2 || k == 10 || k == 7) {
        const bool wo = (k == 7);
        pg8::Gemm g{wo ? XN : Hb, (const bf16_t*)(p.ws + (wo ? WB_WO : (k == 10 ? WB_FFOUT1 : WB_FFOUT0))), T_TOK, DM, wo ? DM : DFF};
        S.init(T_TOK, DM, gridDim.x, blockIdx.x); pg8::EpiResid E{X, modl + (wo ? 5 : (k == 10 ? 8 : 2)) * 1024, wo ? 1.0f : 0.5f}; pg8::gemm_phase(lds3, g, S, E);
        const unsigned epoch = (unsigned)(l * 3 + (k == 2 ? 0 : (k == 7 ? 1 : 2)) + 1);
        unsigned* pcnt = (unsigned*)(p.ws + WS_PCNT);
        if (k == 2) panel_norm(S, pcnt, epoch, X, p.in[6] + (size_t)(l * 3 + 1) * 1024, modl, 1, XN);
        else if (k == 7) panel_norm(S, pcnt, epoch, X, p.in[6] + (size_t)(l * 3 + 2) * 1024, modl, 2, XN);
        else if (l < 3) panel_norm(S, pcnt, epoch, X, p.in[6] + (size_t)((l + 1) * 3) * 1024, modl + 9 * 9216, 0, XN);
      } else if (k == 4) {
        pg8::Gemm g{XN, (const bf16_t*)(p.ws + WB_WIN), T_TOK, WINC, DM};
        S.init(T_TOK, WINC, gridDim.x, blockIdx.x); pg8::EpiQKV E{(bf16_t*)(p.ws + WS_QKV), (bf16_t*)(p.ws + WS_GATES)}; pg8::gemm_phase(lds3, g, S, E);
      } else if (k == 5) { phase_qknorm(p, l); }
      else { phase_attn(p, l, shm); }
    }
    if (ph + 1 < ph_hi) {
      if (ph == 0) { gsync(grid); xb = xcd_barrier_post(xbar, xst); }
      else xcd_barrier(xb);
    }
  }
}

#ifndef N_LAUNCH_MODE
#define N_LAUNCH_MODE 1
#endif
extern "C" void kernel_launch(void* const* d_in, const int* in_sizes, int n_in, void* d_out, int out_size, void* d_ws, size_t ws_size, hipStream_t stream) {
  static int grid = 0;
  if (grid == 0) {
    if (n_in != 24 || out_size != T_TOK * DM || ws_size < WS_END2) { fprintf(stderr, "kernel_launch: unexpected shapes (n_in %d out %d ws %zu need %zu)\n", n_in, out_size, ws_size, (size_t)WS_END2); grid = -1; return; }
    int dev = 0, cus = 0, per_cu = 0;
    (void)hipGetDevice(&dev); (void)hipDeviceGetAttribute(&cus, hipDeviceAttributeMultiprocessorCount, dev);
    if (hipFuncSetAttribute((const void*)mega_fwd, hipFuncAttributeMaxDynamicSharedMemorySize, LDS_BYTES) != hipSuccess) { fprintf(stderr, "kernel_launch: hipFuncSetAttribute failed\n"); grid = -1; return; }
    if (hipOccupancyMaxActiveBlocksPerMultiprocessor(&per_cu, (const void*)mega_fwd, 512, LDS_BYTES) != hipSuccess || per_cu < 1) { fprintf(stderr, "kernel_launch: occupancy query gave %d\n", per_cu); per_cu = 1; }
    (void)hipGetLastError();
    grid = cus;
  }
  if (grid < 0) return;
  Params p{};
  for (int i = 0; i < 24; ++i) p.in[i] = (const float*)d_in[i];
  p.out = (float*)d_out; p.ws = (unsigned char*)d_ws;
#if N_LAUNCH_MODE == 1
  int lo = 0, hi = N_PHASES;
  void* args[] = {&p, &lo, &hi};
  hipError_t e = hipLaunchCooperativeKernel((const void*)mega_fwd, dim3(grid), dim3(512), args, LDS_BYTES, stream);
  if (e != hipSuccess) fprintf(stderr, "kernel_launch: cooperative launch failed: %s (grid %d)\n", hipGetErrorString(e), grid);
#else
  for (int ph = 0; ph < N_PHASES; ++ph) hipLaunchKernelGGL(mega_fwd, dim3(grid), dim3(512), LDS_BYTES, stream, p, ph, ph + 1);
#endif
}
```
